# Optimizing an MI355X kernel written in HIP

```python
import math, functools
import jax, jax.numpy as jnp
from jax import lax
import numpy as np


D_MODEL = 1024
BATCH = 8
SEQ = 2048
DEPTH = 1
DEC_BATCH = 128
DEC_SEQ = 1
PAST_LEN = 16384
PAGE_SIZE = 128

N_META = 16
D_MIX = D_MODEL
HG_WIDTH = D_MIX // 2
HG_HEAD_DIM = 128
HG_HEADS = HG_WIDTH // HG_HEAD_DIM
HG_CHUNK = 64
SSM_WIDTH = D_MIX - HG_WIDTH
SSM_HEAD_DIM = 64
SSM_HEADS = SSM_WIDTH // SSM_HEAD_DIM
SSM_GROUPS = 2
SSM_STATE = 128
SSM_CHUNK = 128
CONV_WIDTH = 4
CONV_DIM = SSM_WIDTH + 2 * SSM_GROUPS * SSM_STATE
D_FF = 2816
D_IN_PROJ = 4 * HG_WIDTH + SSM_WIDTH + CONV_DIM + SSM_HEADS
SPLITS = (HG_WIDTH, 2 * HG_WIDTH, 3 * HG_WIDTH, 4 * HG_WIDTH,
          4 * HG_WIDTH + SSM_WIDTH, 4 * HG_WIDTH + SSM_WIDTH + CONV_DIM)
EPS = 1e-6

kernel_name = 'hymba_hgrn2_mamba2_macaron_step'


def rmsnorm(x, w):
    xf = x.astype(jnp.float32)
    y = xf * lax.rsqrt(jnp.mean(xf * xf, axis=-1, keepdims=True) + EPS)
    return (y * w.astype(jnp.float32)).astype(x.dtype)


def swiglu(x, wg, wu, wd):
    return (jax.nn.silu(x @ wg) * (x @ wu)) @ wd


def forget_lower_bound(lb_logits, layer):
    return jnp.cumsum(jax.nn.softmax(lb_logits.astype(jnp.float32), axis=0), axis=0)[layer]


def hgrn2_chunked(q, k, v, logf, s0, chunk):
    bsz, seqlen, nh, _ = q.shape
    dv = v.shape[-1]
    n = seqlen // chunk

    def to_chunks(t):
        return jnp.moveaxis(t.reshape((bsz, n, chunk) + t.shape[2:]), 1, 0)

    causal = jnp.tril(jnp.ones((chunk, chunk), dtype=bool))[None, :, :, None, None]

    def step(s, inp):
        qc, kc, vc, lc = inp
        b = jnp.cumsum(lc, axis=1)
        decay = jnp.exp(jnp.where(causal, b[:, :, None] - b[:, None, :], -jnp.inf))
        scores = jnp.einsum('bthk,bshk,btshk->bhts', qc, kc, decay)
        o = (jnp.einsum('bhts,bshv->bthv', scores, vc)
             + jnp.einsum('bthk,bhkv->bthv', qc * jnp.exp(b), s))
        b_last = b[:, -1]
        s = (s * jnp.exp(b_last)[..., None]
             + jnp.einsum('bshk,bshv->bhkv', kc * jnp.exp(b_last[:, None] - b), vc))
        return s, o

    s, o = lax.scan(step, s0, (to_chunks(q), to_chunks(k), to_chunks(v), to_chunks(logf)))
    return jnp.moveaxis(o, 0, 1).reshape(bsz, seqlen, nh, dv), s


def ssd_chunked(x, dt, bm, cm, h0, chunk, a_neg):
    bsz, seqlen, nh, hp = x.shape
    ng, ns = bm.shape[2], bm.shape[3]
    rep = nh // ng
    n = seqlen // chunk

    def to_chunks(t):
        return jnp.moveaxis(t.reshape((bsz, n, chunk) + t.shape[2:]), 1, 0)

    causal = jnp.tril(jnp.ones((chunk, chunk), dtype=bool))
    a_g = a_neg.reshape(ng, rep)

    def step(h, inp):
        xc, dtc, bc, cc = inp
        cum = jnp.cumsum(dtc * a_g, axis=1)
        cum_t = jnp.moveaxis(cum, 1, -1)
        seg = jnp.exp(jnp.where(causal, cum_t[..., :, None] - cum_t[..., None, :], -jnp.inf))
        cb = jnp.einsum('btgn,bsgn->bgts', cc, bc)
        y = jnp.einsum('bgts,bgrts,bsgr,bsgrp->btgrp', cb, seg, dtc, xc)
        y = y + jnp.einsum('btgn,bgrpn,btgr->btgrp', cc, h, jnp.exp(cum))
        last = cum[:, -1]
        h = (h * jnp.exp(last)[..., None, None]
             + jnp.einsum('bsgn,bsgr,bsgrp->bgrpn', bc, dtc * jnp.exp(last[:, None] - cum), xc))
        return h, y

    xg = x.reshape(bsz, seqlen, ng, rep, hp)
    dtg = dt.reshape(bsz, seqlen, ng, rep)
    h, y = lax.scan(step, h0.reshape(bsz, ng, rep, hp, ns),
                    (to_chunks(xg), to_chunks(dtg), to_chunks(bm), to_chunks(cm)))
    return jnp.moveaxis(y, 0, 1).reshape(bsz, seqlen, nh, hp), h.reshape(bsz, nh, hp, ns)


def run_segments(scan_fn, chunk, segs, state, *seqs):
    outs = []
    off = 0
    for n in segs:
        o, state = scan_fn(*[s[:, off:off + n] for s in seqs], state, math.gcd(n, chunk))
        outs.append(o)
        off += n
    return jnp.concatenate(outs, axis=1), state


def causal_conv(xbc, buf, w, b):
    xp = jnp.concatenate([buf, xbc], axis=1)
    seqlen = xbc.shape[1]
    out = b + xp[:, 0:seqlen] * w[0]
    for j in range(1, CONV_WIDTH):
        out = out + xp[:, j:j + seqlen] * w[j]
    return jax.nn.silu(out), xp[:, xp.shape[1] - (CONV_WIDTH - 1):]


def decoder_layer(h, segs, s_hg, s_ssm, s_conv, lb, n1, w1g, w1u, w1d, nm, w_in, hg_norm,
                  conv_w, conv_b, dt_bias, a_log, d_skip, ssm_norm, w_out, n2, w2g, w2u, w2d):
    f32 = jnp.float32
    bsz, seqlen, _ = h.shape
    h = h + 0.5 * swiglu(rmsnorm(h, n1), w1g, w1u, w1d)
    u = rmsnorm(h, nm) @ w_in
    q, fz, iv, g, z, xbc, dt_raw = jnp.split(u, SPLITS, axis=-1)

    fz = fz.astype(f32)
    logf = jnp.log(lb + (1.0 - lb) * jax.nn.sigmoid(fz))
    kk = (1.0 - lb) * jax.nn.sigmoid(-fz)
    hg_shape = (bsz, seqlen, HG_HEADS, HG_HEAD_DIM)
    o_hg, s_hg = run_segments(hgrn2_chunked, HG_CHUNK, segs, s_hg.astype(f32),
                              jax.nn.silu(q.astype(f32)).reshape(hg_shape), kk.reshape(hg_shape),
                              iv.astype(f32).reshape(hg_shape), logf.reshape(hg_shape))
    o_hg = o_hg * lax.rsqrt(jnp.mean(o_hg * o_hg, axis=-1, keepdims=True) + EPS)
    o_hg = o_hg.reshape(bsz, seqlen, HG_WIDTH) * hg_norm.astype(f32) * jax.nn.silu(g.astype(f32))

    xbc_act, conv_buf = causal_conv(xbc.astype(f32), s_conv.astype(f32), conv_w.astype(f32), conv_b.astype(f32))
    xs, bm, cm = jnp.split(xbc_act, (SSM_WIDTH, SSM_WIDTH + SSM_GROUPS * SSM_STATE), axis=-1)
    xs = xs.reshape(bsz, seqlen, SSM_HEADS, SSM_HEAD_DIM)
    bm = bm.reshape(bsz, seqlen, SSM_GROUPS, SSM_STATE)
    cm = cm.reshape(bsz, seqlen, SSM_GROUPS, SSM_STATE)
    dt = jax.nn.softplus(dt_raw.astype(f32) + dt_bias.astype(f32))
    a_neg = -jnp.exp(a_log.astype(f32))
    y, s_ssm = run_segments(functools.partial(ssd_chunked, a_neg=a_neg), SSM_CHUNK, segs,
                            s_ssm.astype(f32), xs, dt, bm, cm)
    y = y + d_skip.astype(f32)[:, None] * xs
    yz = (y.reshape(bsz, seqlen, SSM_WIDTH) * jax.nn.silu(z.astype(f32))).reshape(bsz, seqlen, SSM_GROUPS, -1)
    yz = yz * lax.rsqrt(jnp.mean(yz * yz, axis=-1, keepdims=True) + EPS)
    yz = yz.reshape(bsz, seqlen, SSM_WIDTH) * ssm_norm.astype(f32)

    mix = jnp.concatenate([o_hg, yz], axis=-1).astype(h.dtype) @ w_out
    h = h + mix
    h = h + 0.5 * swiglu(rmsnorm(h, n2), w2g, w2u, w2d)
    return h, s_hg, s_ssm, conv_buf


def setup_inputs(seed: int = 0) -> dict:
    key = jax.random.key(seed)
    ks = jax.random.split(key, 32)
    f32 = jnp.float32

    def nrm(k, shape, scale):
        return scale * jax.random.normal(k, shape, f32)

    L = DEPTH
    dt0 = jnp.exp(jax.random.uniform(ks[20], (L, SSM_HEADS), f32, math.log(1e-3), math.log(1e-1)))
    return {
        'x_prompt': nrm(ks[0], (BATCH, SEQ, D_MODEL), 1.0),
        'x_sample': nrm(ks[1], (DEC_BATCH, DEC_SEQ, D_MODEL), 1.0),
        'state_hgrn': nrm(ks[2], (L, DEC_BATCH, HG_HEADS, HG_HEAD_DIM, HG_HEAD_DIM), 0.3),
        'state_ssm': nrm(ks[3], (L, DEC_BATCH, SSM_HEADS, SSM_HEAD_DIM, SSM_STATE), 0.1),
        'state_conv': nrm(ks[4], (L, DEC_BATCH, CONV_WIDTH - 1, CONV_DIM), 1.0),
        'meta_tokens': nrm(ks[5], (N_META, D_MODEL), 1.0),
        'lb_logits': nrm(ks[6], (L + 1, HG_WIDTH), 0.5),
        'norm_ffn1': 1.0 + nrm(ks[7], (L, D_MODEL), 0.02),
        'w_ffn1_gate': nrm(ks[8], (L, D_MODEL, D_FF), D_MODEL ** -0.5),
        'w_ffn1_up': nrm(ks[9], (L, D_MODEL, D_FF), D_MODEL ** -0.5),
        'w_ffn1_down': nrm(ks[10], (L, D_FF, D_MODEL), D_FF ** -0.5),
        'norm_mix': 1.0 + nrm(ks[11], (L, D_MODEL), 0.02),
        'w_in': nrm(ks[12], (L, D_MODEL, D_IN_PROJ), D_MODEL ** -0.5),
        'hg_norm': 1.0 + nrm(ks[13], (L, HG_WIDTH), 0.02),
        'conv_w': nrm(ks[14], (L, CONV_WIDTH, CONV_DIM), CONV_WIDTH ** -0.5),
        'conv_b': nrm(ks[15], (L, CONV_DIM), 0.01),
        'dt_bias': dt0 + jnp.log(-jnp.expm1(-dt0)),
        'a_log': jnp.log(jax.random.uniform(ks[21], (L, SSM_HEADS), f32, 1.0, 16.0)),
        'd_skip': 1.0 + nrm(ks[16], (L, SSM_HEADS), 0.1),
        'ssm_norm': 1.0 + nrm(ks[17], (L, SSM_WIDTH), 0.02),
        'w_out': nrm(ks[18], (L, D_MIX, D_MODEL), D_MIX ** -0.5),
        'norm_ffn2': 1.0 + nrm(ks[19], (L, D_MODEL), 0.02),
        'w_ffn2_gate': nrm(ks[22], (L, D_MODEL, D_FF), D_MODEL ** -0.5),
        'w_ffn2_up': nrm(ks[23], (L, D_MODEL, D_FF), D_MODEL ** -0.5),
        'w_ffn2_down': nrm(ks[24], (L, D_FF, D_MODEL), D_FF ** -0.5),
        'norm_final': 1.0 + nrm(ks[25], (D_MODEL,), 0.02),
    }


def reference(x_prompt, x_sample, state_hgrn, state_ssm, state_conv, meta_tokens, lb_logits,
              norm_ffn1, w_ffn1_gate, w_ffn1_up, w_ffn1_down, norm_mix, w_in, hg_norm, conv_w, conv_b,
              dt_bias, a_log, d_skip, ssm_norm, w_out, norm_ffn2, w_ffn2_gate, w_ffn2_up, w_ffn2_down,
              norm_final):
    f32 = jnp.float32
    bp, seq_p, _ = x_prompt.shape
    seq_s = x_sample.shape[1]
    meta = jnp.broadcast_to(meta_tokens.astype(x_prompt.dtype)[None], (bp, N_META, D_MODEL))
    hp = jnp.concatenate([meta, x_prompt], axis=1)
    hs = x_sample
    hg_p, ssm_p, conv_p, hg_s, ssm_s, conv_s = [], [], [], [], [], []
    for l in range(DEPTH):
        lb = forget_lower_bound(lb_logits, l)
        w = (norm_ffn1[l], w_ffn1_gate[l], w_ffn1_up[l], w_ffn1_down[l], norm_mix[l], w_in[l], hg_norm[l],
             conv_w[l], conv_b[l], dt_bias[l], a_log[l], d_skip[l], ssm_norm[l], w_out[l],
             norm_ffn2[l], w_ffn2_gate[l], w_ffn2_up[l], w_ffn2_down[l])
        hp, a, b, c = decoder_layer(
            hp, (N_META, seq_p),
            jnp.zeros((bp, HG_HEADS, HG_HEAD_DIM, HG_HEAD_DIM), f32),
            jnp.zeros((bp, SSM_HEADS, SSM_HEAD_DIM, SSM_STATE), f32),
            jnp.zeros((bp, CONV_WIDTH - 1, CONV_DIM), f32),
            lb, *w)
        hg_p.append(a)
        ssm_p.append(b)
        conv_p.append(c)
        hs, a, b, c = decoder_layer(hs, (seq_s,), state_hgrn[l], state_ssm[l], state_conv[l], lb, *w)
        hg_s.append(a)
        ssm_s.append(b)
        conv_s.append(c)
    y_prompt = rmsnorm(hp[:, N_META:], norm_final)
    y_sample = rmsnorm(hs, norm_final)
    dt_out = x_prompt.dtype
    hgrn_prompt = jnp.stack(hg_p).astype(dt_out)
    ssm_prompt = jnp.stack(ssm_p).astype(dt_out)
    conv_prompt = jnp.stack(conv_p).astype(dt_out)
    hgrn_sample = jnp.stack(hg_s).astype(dt_out)
    ssm_sample = jnp.stack(ssm_s).astype(dt_out)
    conv_sample = jnp.stack(conv_s).astype(dt_out)
    return (y_prompt, y_sample, hgrn_prompt, ssm_prompt, conv_prompt, hgrn_sample, ssm_sample, conv_sample)
```

```cpp
#include <hip/hip_runtime.h>
#include <cstdio>
#include <cstdint>
namespace pg8 {
#define PG8_LAS __attribute__((address_space(3)))
typedef unsigned short bf16_t;
typedef short bf16x8 __attribute__((ext_vector_type(8)));
typedef float f32x4 __attribute__((ext_vector_type(4)));
typedef unsigned u32x4 __attribute__((ext_vector_type(4)));
constexpr int BM = 256, BK = 64, HALF = 128, HTB = HALF * BK * 2  , STAGE_BYTES = 8 * HTB, NXCD = 8, WGM = 8;

__host__ __device__ __forceinline__ int lds_byte(int r, int c) { const int st = (r >> 4) * 2 + (c >> 5), rr = r & 15, cc = c & 31, ob = rr * 64 + cc * 2; return st * 1024 + (ob ^ (((ob >> 9) & 1) << 5)); }
__host__ __device__ __forceinline__ void stage_rc(int b, int& R, int& C) { const int st = b / 1024, sb = b % 1024, swz = sb ^ (((sb >> 9) & 1) << 5); R = (st >> 1) * 16 + swz / 64; C = (st & 1) * 32 + (swz % 64) / 2; }
__host__ __device__ __forceinline__ int perm32(int rho) { const int n = rho >> 4, i = rho & 15; return 8 * (i >> 2) + 4 * n + (i & 3); }

struct Unit { int pm, pn, k0, nt, kind, slot; };
struct Gemm { const bf16_t* A; const bf16_t* Bt; int M, N, K, lda; };

struct MixOrder {
    int nM, nN, nwg, G, c, ppu, npieces, rounds, wgm;
    __host__ __device__ __forceinline__ void init(int nM_, int N, int K, int G_, int c_, int split, int wgm_) { wgm = wgm_; nM = nM_; nN = N / BM; nwg = nM * nN; G = G_; c = c_; ppu = K / (2 * BK); npieces = split ? nN * ppu : 0; rounds = (nwg + G - 1) / G; }
    __host__ __device__ __forceinline__ bool next(int i, Unit& u) const {
        if (i >= rounds) { const int p = (i - rounds) * G + c; if (p >= npieces) return false; u.pm = nM; u.pn = p / ppu; u.k0 = 2 * (p % ppu); u.nt = 2; u.kind = 1; u.slot = p; return true; }
        const long L = (long)i * G + c; if (L >= nwg) return false;
        int wgid = (int)L; { const int q = nwg / NXCD, r = nwg % NXCD, xcd = wgid % NXCD, off = wgid / NXCD; wgid = (xcd < r ? xcd * (q + 1) : r * (q + 1) + (xcd - r) * q) + off; }
        const int nig = wgm * nN, gid = wgid / nig, fm = gid * wgm, gsz = (nM - fm) < wgm ? (nM - fm) : wgm;
        u.pm = fm + ((wgid % nig) % gsz); u.pn = (wgid % nig) / gsz; u.k0 = 0; u.nt = 2 * ppu; u.kind = 0; u.slot = 0; return true;
    }
};

__device__ __forceinline__ unsigned cvt_pk_bf16(float lo, float hi) { unsigned r; asm volatile("v_cvt_pk_bf16_f32 %0, %1, %2" : "=v"(r) : "v"(lo), "v"(hi)); return r; }
typedef float f32x2 __attribute__((ext_vector_type(2)));
constexpr float EPSN = 1e-6f;
__device__ __forceinline__ float row_rstd(const float* SS, int row) {
    const f32x4* p = (const f32x4*)(SS + (size_t)row * 16);
    const f32x4 a = p[0], b = p[1], c = p[2], d = p[3];
    const float s = (((a[0] + a[1]) + (a[2] + a[3])) + ((b[0] + b[1]) + (b[2] + b[3]))) + (((c[0] + c[1]) + (c[2] + c[3])) + ((d[0] + d[1]) + (d[2] + d[3])));
    return __builtin_amdgcn_rsqf(s * (1.0f / 1024.0f) + EPSN);
}
__device__ __forceinline__ float silu_f(float x) { return x * __builtin_amdgcn_rcpf(1.0f + __expf(-x)); }
typedef unsigned u32x2 __attribute__((ext_vector_type(2)));

struct EpiSwiglu {
    static constexpr bool PERM = true, AFTER_DRAIN = false;
    bf16_t* H; const float* RSTD; int ldh, nkt;
    __device__ __forceinline__ void operator()(const f32x4 (&acc)[2][2][4][2], const Unit& u, int wr, int wc, int fr, int fq) const {
        const int row0 = u.pm * BM + wr * 64 + fr, col0 = u.pn * 128 + wc * 32 + 8 * fq;
        float rs8[8];
#pragma unroll
        for (int i = 0; i < 8; ++i) rs8[i] = RSTD[row0 + (i >> 2) * HALF + (i & 3) * 16];
#pragma unroll
        for (int ai = 0; ai < 2; ++ai)
#pragma unroll
            for (int m = 0; m < 4; ++m) {
                const int row = row0 + ai * HALF + m * 16;
                const float rs = rs8[ai * 4 + m];
                float h[8];
#pragma unroll
                for (int n = 0; n < 2; ++n)
#pragma unroll
                    for (int j = 0; j < 4; ++j) { const float g = acc[ai][0][m][n][j] * rs, up = acc[ai][1][m][n][j] * rs; h[n * 4 + j] = silu_f(g) * up; }
                u32x4 w; w.x = cvt_pk_bf16(h[0], h[1]); w.y = cvt_pk_bf16(h[2], h[3]); w.z = cvt_pk_bf16(h[4], h[5]); w.w = cvt_pk_bf16(h[6], h[7]);
                if (ldh) *(u32x4*)(H + (size_t)row * ldh + col0) = w;
                else *(u32x4*)(H + ((size_t)((row >> 8) * nkt + (col0 >> 6)) * 256 + (row & 255)) * 64 + (col0 & 63)) = w;
            }
    }
};

struct EpiResid {
    static constexpr bool PERM = false, AFTER_DRAIN = false;
    const float* R0; float* D0;
    const float* RX; float* DX;
    bf16_t* HB; float* SS; float scale; unsigned long long* gran;
    __device__ __forceinline__ void operator()(const f32x4 (&acc)[2][2][4][2], const Unit& u, int wr, int wc, int fr, int fq) const {
        const float* rb = u.pm < 64 ? R0 + (size_t)u.pm * BM * 1024 : RX;
        float* db = u.pm < 64 ? D0 + (size_t)u.pm * BM * 1024 : DX;
        const int col0 = u.pn * BM + wc * 32 + 4 * fq;
        f32x4 rn[2][2];
        { const size_t off0 = (size_t)(wr * 64 + fr) * 1024 + col0;
#pragma unroll
          for (int bj = 0; bj < 2; ++bj)
#pragma unroll
              for (int n = 0; n < 2; ++n) rn[bj][n] = *(const f32x4*)(rb + off0 + bj * HALF + n * 16); }
#pragma unroll
        for (int ai = 0; ai < 2; ++ai)
#pragma unroll
            for (int m = 0; m < 4; ++m) {
                int lrow = ai * HALF + wr * 64 + m * 16 + fr;
                asm volatile("" : "+v"(lrow));
                const size_t off = (size_t)lrow * 1024 + col0;
                f32x4 rc[2][2];
#pragma unroll
                for (int bj = 0; bj < 2; ++bj)
#pragma unroll
                    for (int n = 0; n < 2; ++n) rc[bj][n] = rn[bj][n];
                if (ai * 4 + m < 7) { const int nx = ai * 4 + m + 1; int lnx = (nx >> 2) * HALF + wr * 64 + (nx & 3) * 16 + fr; asm volatile("" : "+v"(lnx));
                    const size_t offn = (size_t)lnx * 1024 + col0;
#pragma unroll
                    for (int bj = 0; bj < 2; ++bj)
#pragma unroll
                        for (int n = 0; n < 2; ++n) rn[bj][n] = *(const f32x4*)(rb + offn + bj * HALF + n * 16); }
                float sq = 0.f;
#pragma unroll
                for (int bj = 0; bj < 2; ++bj)
#pragma unroll
                    for (int n = 0; n < 2; ++n) {
                        const f32x4 o = rc[bj][n] + acc[ai][bj][m][n] * scale;
                        *(f32x4*)(db + off + bj * HALF + n * 16) = o;
                        sq += (o[0] * o[0] + o[1] * o[1]) + (o[2] * o[2] + o[3] * o[3]);
                        if (HB) { u32x2 w; w.x = cvt_pk_bf16(o[0], o[1]); w.y = cvt_pk_bf16(o[2], o[3]); *(u32x2*)(HB + ((size_t)u.pm * BM + lrow) * 1024 + col0 + bj * HALF + n * 16) = w; }
                    }
                sq += __shfl_xor(sq, 16); sq += __shfl_xor(sq, 32);
                if (fq == 0) { if (gran) __hip_atomic_store(gran + ((size_t)u.pm * BM + lrow) * 16 + u.pn * 4 + wc, (1ull << 32) | (unsigned long long)__builtin_bit_cast(unsigned, sq), __ATOMIC_RELAXED, __HIP_MEMORY_SCOPE_AGENT);
                    else SS[((size_t)u.pm * BM + lrow) * 16 + u.pn * 4 + wc] = sq; }
                asm volatile("" ::: "memory");
            }
    }
};

struct EpiInproj {
    static constexpr bool PERM = true, AFTER_DRAIN = false;
    const float* RSTD; bf16_t* QZ; float* FZ; bf16_t* VB; bf16_t* GB; bf16_t* XBC; float* DT;
    const float* hgn; const float* dtb; float* convp; float* convs;
    __device__ __forceinline__ void operator()(const f32x4 (&acc)[2][2][4][2], const Unit& u, int wr, int wc, int fr, int fq) const {
        const int type = u.pn;
        const int row0 = u.pm * BM + wr * 64 + fr;
        float rs8[8];
#pragma unroll
        for (int i = 0; i < 8; ++i) rs8[i] = RSTD[row0 + (i >> 2) * HALF + (i & 3) * 16];
#pragma unroll
        for (int ai = 0; ai < 2; ++ai)
#pragma unroll
            for (int m = 0; m < 4; ++m) {
                const int row = row0 + ai * HALF + m * 16;
                const float rs = rs8[ai * 4 + m];
#pragma unroll
                for (int bj = 0; bj < 2; ++bj) {
                    const int c0 = 128 * bj + 32 * wc + 8 * fq;
                    float v[8];
#pragma unroll
                    for (int n = 0; n < 2; ++n)
#pragma unroll
                        for (int j = 0; j < 4; ++j) v[n * 4 + j] = acc[ai][bj][m][n][j] * rs;
                    if (type < 2 || (type >= 8 && type < 10)) {
                        const int col = (type < 2 ? 256 * type : 512 + 256 * (type - 8)) + c0;
#pragma unroll
                        for (int j = 0; j < 8; ++j) v[j] = silu_f(v[j]);
                        u32x4 w; w.x = cvt_pk_bf16(v[0], v[1]); w.y = cvt_pk_bf16(v[2], v[3]); w.z = cvt_pk_bf16(v[4], v[5]); w.w = cvt_pk_bf16(v[6], v[7]);
                        *(u32x4*)(QZ + (size_t)row * 1024 + col) = w;
                    } else if (type < 4) {
                        const int col = 256 * (type - 2) + c0;
                        *(f32x4*)(FZ + (size_t)row * 512 + col) = (f32x4){v[0], v[1], v[2], v[3]};
                        *(f32x4*)(FZ + (size_t)row * 512 + col + 4) = (f32x4){v[4], v[5], v[6], v[7]};
                    } else if (type < 6) {
                        const int col = 256 * (type - 4) + c0;
                        u32x4 w; w.x = cvt_pk_bf16(v[0], v[1]); w.y = cvt_pk_bf16(v[2], v[3]); w.z = cvt_pk_bf16(v[4], v[5]); w.w = cvt_pk_bf16(v[6], v[7]);
                        *(u32x4*)(VB + (size_t)row * 512 + col) = w;
                    } else if (type < 8) {
                        const int col = 256 * (type - 6) + c0;
                        const f32x4 n0 = *(const f32x4*)(hgn + col), n1 = *(const f32x4*)(hgn + col + 4);
#pragma unroll
                        for (int j = 0; j < 4; ++j) { v[j] = silu_f(v[j]) * n0[j]; v[4 + j] = silu_f(v[4 + j]) * n1[j]; }
                        u32x4 w; w.x = cvt_pk_bf16(v[0], v[1]); w.y = cvt_pk_bf16(v[2], v[3]); w.z = cvt_pk_bf16(v[4], v[5]); w.w = cvt_pk_bf16(v[6], v[7]);
                        *(u32x4*)(GB + (size_t)row * 512 + col) = w;
                    } else if (type < 14) {
                        const int col = 256 * (type - 10) + c0;
                        u32x4 w; w.x = cvt_pk_bf16(v[0], v[1]); w.y = cvt_pk_bf16(v[2], v[3]); w.z = cvt_pk_bf16(v[4], v[5]); w.w = cvt_pk_bf16(v[6], v[7]);
                        *(u32x4*)(XBC + (size_t)row * 1024 + col) = w;
                        float* cs = nullptr;
                        if (row < 16384) { const int t = row & 2047; if (t >= 2045) cs = convp + ((size_t)(row >> 11) * 3 + (t - 2045)) * 1024 + col; }
                        else if (row >= 16400 && row < 16528) cs = convs + ((size_t)(row - 16400) * 3 + 2) * 1024 + col;
                        if (cs) { *(f32x4*)cs = (f32x4){v[0], v[1], v[2], v[3]}; *(f32x4*)(cs + 4) = (f32x4){v[4], v[5], v[6], v[7]}; }
                    } else {
                        if (bj == 0 && wc == 0 && fq == 0) {
                            float d[8];
#pragma unroll
                            for (int j = 0; j < 8; ++j) { const float x = v[j] + dtb[j]; d[j] = x > 20.f ? x : log1pf(__expf(x)); }
                            *(f32x4*)(DT + (size_t)row * 8) = (f32x4){d[0], d[1], d[2], d[3]};
                            *(f32x4*)(DT + (size_t)row * 8 + 4) = (f32x4){d[4], d[5], d[6], d[7]};
                        }
                    }
                }
            }
    }
};
template <class Epi, class Sched, bool ALIGN_EPI = false, bool SP2 = false>
__device__ __forceinline__ void gemm_phase(PG8_LAS unsigned char* lds, const Gemm g, const Sched& S, const Epi& E, float* slab) {
    int tid_ = threadIdx.x; asm volatile("" : "+v"(tid_));
    const int tid = tid_, wid = __builtin_amdgcn_readfirstlane(tid >> 6), lane = tid & 63, wr = wid >> 2, wc = wid & 3, fr = lane & 15, fq = lane >> 4;
    const int K = g.K;
    unsigned voffA[2], voffB[2]; int aoff, boff;
#define PG8_LANE_OFFSETS(T_) do { _Pragma("unroll") for (int i = 0; i < 2; ++i) { int R, C; stage_rc((T_) * 16 + i * 8192, R, C); const int Rb = Epi::PERM ? ((R & ~31) + perm32(R & 31)) : R; \
        voffA[i] = (unsigned)(R * (g.lda ? g.lda : BK) + C) * 2u; voffB[i] = (unsigned)(Rb * K + C) * 2u; } \
        aoff = lds_byte((((T_) >> 8) & 1) * 64 + ((T_) & 15), (((T_) >> 4) & 3) * 8); boff = lds_byte((((T_) >> 6) & 3) * 32 + ((T_) & 15), (((T_) >> 4) & 3) * 8); } while (0)
    PG8_LANE_OFFSETS(tid);
    const size_t kstep = (size_t)(BK * 2), kstepA = g.lda ? (size_t)(BK * 2) : (size_t)(BM * BK * 2);
    const size_t hstep = (size_t)HALF * K * 2, hstepA = g.lda ? (size_t)HALF * g.lda * 2 : (size_t)(HALF * BK * 2);
    const size_t tstep = 2 * hstep, tstepA = g.lda ? 2 * hstepA : (size_t)(K / BK) * (BM * BK * 2);
    const unsigned ldsw = (unsigned)wid * 1024u;
#define PG8_SA(b, h) (((b) * 2 + (h)) * HTB)
#define PG8_SB(b, h) ((4 + (b) * 2 + (h)) * HTB)
#define PG8_STAGE(bufoff, gbase, voff) do { _Pragma("unroll") for (int _i = 0; _i < 2; ++_i) \
        __builtin_amdgcn_global_load_lds((const unsigned*)((const char*)(gbase) + (voff)[_i]), (PG8_LAS unsigned*)(lds + (bufoff) + ldsw + _i * 8192), 16, 0, 0); } while (0)
#define PG8_LDA(dst, b, h) do { _Pragma("unroll") for (int m = 0; m < 4; ++m) _Pragma("unroll") for (int k = 0; k < 2; ++k) dst[m][k] = *(const PG8_LAS bf16x8*)(lds + PG8_SA(b, h) + aoff + m * 2048 + k * 1024); } while (0)
#define PG8_LDB(dst, b, h) do { _Pragma("unroll") for (int n = 0; n < 2; ++n) _Pragma("unroll") for (int k = 0; k < 2; ++k) dst[n][k] = *(const PG8_LAS bf16x8*)(lds + PG8_SB(b, h) + boff + n * 2048 + k * 1024); } while (0)
#define PG8_MMA(ai, bj, At, Bt) do { __builtin_amdgcn_s_setprio(1); _Pragma("unroll") for (int m = 0; m < 4; ++m) _Pragma("unroll") for (int n = 0; n < 2; ++n) _Pragma("unroll") for (int k = 0; k < 2; ++k) \
        acc[ai][bj][m][n] = __builtin_amdgcn_mfma_f32_16x16x32_bf16(Bt[n][k], At[m][k], acc[ai][bj][m][n], 0, 0, 0); __builtin_amdgcn_s_setprio(0); } while (0)
#define PG8_WAIT_V(n) asm volatile("s_waitcnt vmcnt(" #n ")" ::: "memory")
#define PG8_WAIT_L(n) asm volatile("s_waitcnt lgkmcnt(" #n ")" ::: "memory")
#define PG8_BAR __builtin_amdgcn_s_barrier()
#define PG8_SCHED __builtin_amdgcn_sched_barrier(0)
    Unit cur, nxt; int ui = 0;
    if (!S.next(0, cur)) return;
    f32x4 acc[2][2][4][2];
#pragma unroll
    for (int a = 0; a < 2; ++a)
#pragma unroll
        for (int b = 0; b < 2; ++b)
#pragma unroll
            for (int m = 0; m < 4; ++m)
#pragma unroll
                for (int n = 0; n < 2; ++n) acc[a][b][m][n] = (f32x4){0.f, 0.f, 0.f, 0.f};
    bf16x8 At[4][2], B0[2][2], B1[2][2];
    const char* cA = (const char*)g.A + (size_t)cur.pm * tstepA + (size_t)cur.k0 * kstepA; const char* cB = (const char*)g.Bt + (size_t)cur.pn * tstep + (size_t)cur.k0 * kstep;
    if constexpr (SP2) {
        PG8_STAGE(PG8_SB(0, 0), cB, voffB); PG8_STAGE(PG8_SB(0, 1), cB + hstep, voffB); PG8_STAGE(PG8_SA(0, 0), cA, voffA); PG8_STAGE(PG8_SA(0, 1), cA + hstepA, voffA);
        if (wr == 1) PG8_BAR;
        PG8_WAIT_V(2); PG8_BAR;
        PG8_STAGE(PG8_SB(1, 0), cB + kstep, voffB); PG8_STAGE(PG8_SA(1, 0), cA + kstepA, voffA); PG8_STAGE(PG8_SB(1, 1), cB + hstep + kstep, voffB);
        PG8_WAIT_V(6); PG8_BAR;
    } else {
        PG8_STAGE(PG8_SB(0, 0), cB, voffB); PG8_STAGE(PG8_SA(0, 0), cA, voffA); PG8_STAGE(PG8_SB(0, 1), cB + hstep, voffB); PG8_STAGE(PG8_SA(0, 1), cA + hstepA, voffA);
        if (wr == 1) PG8_BAR;
        PG8_WAIT_V(4); PG8_BAR;
        PG8_STAGE(PG8_SB(1, 0), cB + kstep, voffB); PG8_STAGE(PG8_SA(1, 0), cA + kstepA, voffA); PG8_STAGE(PG8_SB(1, 1), cB + hstep + kstep, voffB);
        PG8_WAIT_V(6); PG8_BAR;
    }
    for (;;) {
        const bool has_next = S.next(ui + 1, nxt);
        const char* nA = has_next ? (const char*)g.A + (size_t)nxt.pm * tstepA + (size_t)nxt.k0 * kstepA : cA; const char* nB = has_next ? (const char*)g.Bt + (size_t)nxt.pn * tstep + (size_t)nxt.k0 * kstep : cB;
        const int nt = cur.nt;
        for (int t = 0; t < nt; t += 2) {
            const bool last = (t == nt - 2);
            const char* a1 = cA + (size_t)(t + 1) * kstepA;
            const char* a2 = last ? nA : cA + (size_t)(t + 2) * kstepA; const char* b2 = last ? nB : cB + (size_t)(t + 2) * kstep;
            const char* a3 = a2 + kstepA; const char* b3 = b2 + kstep;
            if constexpr (SP2) {
            PG8_LDB(B0, 0, 0); PG8_LDB(B1, 0, 1); PG8_SCHED; PG8_LDA(At, 0, 0); PG8_STAGE(PG8_SA(1, 1), a1 + hstepA, voffA);
            PG8_WAIT_V(8); PG8_WAIT_L(0); PG8_BAR; PG8_MMA(0, 0, At, B0); PG8_MMA(0, 1, At, B1); PG8_BAR; PG8_SCHED;
            PG8_LDA(At, 0, 1); PG8_STAGE(PG8_SB(0, 0), b2, voffB); PG8_STAGE(PG8_SB(0, 1), b2 + hstep, voffB); PG8_STAGE(PG8_SA(0, 0), a2, voffA);
            PG8_WAIT_V(8); PG8_WAIT_L(0); PG8_BAR; PG8_MMA(1, 0, At, B0); PG8_MMA(1, 1, At, B1); PG8_BAR; PG8_SCHED;
            PG8_LDB(B0, 1, 0); PG8_LDB(B1, 1, 1); PG8_SCHED; PG8_LDA(At, 1, 0); PG8_STAGE(PG8_SA(0, 1), a2 + hstepA, voffA);
            PG8_WAIT_V(8); PG8_WAIT_L(0); PG8_BAR; PG8_MMA(0, 0, At, B0); PG8_MMA(0, 1, At, B1); PG8_BAR; PG8_SCHED;
            PG8_LDA(At, 1, 1); PG8_STAGE(PG8_SB(1, 0), b3, voffB); PG8_STAGE(PG8_SB(1, 1), b3 + hstep, voffB); PG8_STAGE(PG8_SA(1, 0), a3, voffA);
            PG8_WAIT_V(8); PG8_WAIT_L(0); PG8_BAR; PG8_MMA(1, 0, At, B0); PG8_MMA(1, 1, At, B1); PG8_BAR; PG8_SCHED;
            } else {
            PG8_LDB(B0, 0, 0); PG8_SCHED; PG8_LDA(At, 0, 0); PG8_STAGE(PG8_SA(1, 1), a1 + hstepA, voffA);
            PG8_WAIT_L(8); PG8_BAR; PG8_WAIT_L(0); PG8_MMA(0, 0, At, B0); PG8_BAR; PG8_SCHED;
            PG8_LDB(B1, 0, 1); PG8_STAGE(PG8_SB(0, 0), b2, voffB);
            PG8_BAR; PG8_WAIT_L(0); PG8_MMA(0, 1, At, B1); PG8_BAR;
            PG8_LDA(At, 0, 1); PG8_STAGE(PG8_SA(0, 0), a2, voffA);
            PG8_BAR; PG8_WAIT_L(0); PG8_MMA(1, 0, At, B0); PG8_BAR; PG8_SCHED;
            PG8_STAGE(PG8_SB(0, 1), b2 + hstep, voffB);
            PG8_WAIT_V(6); PG8_BAR; PG8_MMA(1, 1, At, B1); PG8_BAR;
            PG8_LDB(B0, 1, 0); PG8_SCHED; PG8_LDA(At, 1, 0); PG8_STAGE(PG8_SA(0, 1), a2 + hstepA, voffA);
            PG8_WAIT_L(8); PG8_BAR; PG8_WAIT_L(0); PG8_MMA(0, 0, At, B0); PG8_BAR; PG8_SCHED;
            PG8_LDB(B1, 1, 1); PG8_STAGE(PG8_SB(1, 0), b3, voffB);
            PG8_BAR; PG8_WAIT_L(0); PG8_MMA(0, 1, At, B1); PG8_BAR;
            PG8_LDA(At, 1, 1); PG8_STAGE(PG8_SA(1, 0), a3, voffA);
            PG8_BAR; PG8_WAIT_L(0); PG8_MMA(1, 0, At, B0); PG8_BAR; PG8_SCHED;
            PG8_STAGE(PG8_SB(1, 1), b3 + hstep, voffB);
            PG8_WAIT_V(6); PG8_BAR; PG8_MMA(1, 1, At, B1); PG8_BAR;
            }
        }
        if constexpr (ALIGN_EPI) { if (wr == 0) PG8_BAR; }
        if (cur.kind == 1) {
            float* sb = slab + (size_t)cur.slot * 65536;
#pragma unroll
            for (int a = 0; a < 2; ++a)
#pragma unroll
                for (int m = 0; m < 4; ++m) {
                    int lrow = a * HALF + wr * 64 + m * 16 + fr; asm volatile("" : "+v"(lrow));
                    float* rp = sb + (size_t)lrow * 256 + wc * 32 + 4 * fq;
#pragma unroll
                    for (int b = 0; b < 2; ++b)
#pragma unroll
                        for (int n = 0; n < 2; ++n) *(f32x4*)(rp + b * HALF + n * 16) = acc[a][b][m][n];
                }
        } else {
            E(acc, cur, wr, wc, fr, fq);
        }
        if (!has_next) break;
#pragma unroll
        for (int a = 0; a < 2; ++a)
#pragma unroll
            for (int b = 0; b < 2; ++b)
#pragma unroll
                for (int m = 0; m < 4; ++m)
#pragma unroll
                    for (int n = 0; n < 2; ++n) acc[a][b][m][n] = (f32x4){0.f, 0.f, 0.f, 0.f};
        cur = nxt; cA = nA; cB = nB; ++ui;
        if constexpr (ALIGN_EPI) { if (wr == 1) PG8_BAR; }
    }
    PG8_WAIT_V(0);
    if constexpr (!ALIGN_EPI) { if (wr == 0) PG8_BAR; }
    PG8_BAR;
#undef PG8_LANE_OFFSETS
#undef PG8_SA
#undef PG8_SB
#undef PG8_STAGE
#undef PG8_LDA
#undef PG8_LDB
#undef PG8_MMA
#undef PG8_WAIT_V
#undef PG8_WAIT_L
#undef PG8_BAR
#undef PG8_SCHED
}
}
constexpr int NWAVES = 8;
constexpr int D = 1024, NBATCH = 8, SEQ = 2048, NMETA = 16, NSMP = 128, FF = 2816;
constexpr int MP = NBATCH * SEQ;
constexpr int ROW_META = MP, ROW_SMP = MP + NMETA;
constexpr int M = 16640;
constexpr int NIN = 3592, NINP = 3840;
constexpr int LDH = 0;
constexpr int CH = 64, NCH = SEQ / CH;
constexpr float EPS = 1e-6f;
constexpr size_t O_YP = 0, O_YS = O_YP + (size_t)MP * D, O_HGP = O_YS + (size_t)NSMP * D, O_SSP = O_HGP + (size_t)NBATCH * 4 * 128 * 128, O_CVP = O_SSP + (size_t)NBATCH * 8 * 64 * 128,
                 O_HGS = O_CVP + (size_t)NBATCH * 3 * 1024, O_SSS = O_HGS + (size_t)NSMP * 4 * 128 * 128, O_CVS = O_SSS + (size_t)NSMP * 8 * 64 * 128, O_END = O_CVS + (size_t)NSMP * 3 * 1024;
constexpr size_t KiB = 1024, MiB = 1u << 20;
constexpr size_t WS_CTL = 0, CTL_ZERO_BYTES = 1 * MiB;
constexpr size_t WS_WGU1 = 1 * MiB, WS_WD1 = 12 * MiB, WS_WIN = 17 * MiB + 512 * KiB, WS_WOUT = 25 * MiB, WS_WGU2 = 27 * MiB, WS_WD2 = 38 * MiB;
constexpr size_t WS_HB = 44 * MiB;
constexpr size_t WS_R = 77 * MiB;
constexpr size_t WS_H = WS_R;
constexpr size_t WS_QZ = 77 * MiB;
constexpr size_t WS_FZ = 110 * MiB;
constexpr size_t WS_VB = 143 * MiB;
constexpr size_t WS_GB = 160 * MiB;
constexpr size_t WS_XBC = 177 * MiB;
constexpr size_t WS_UM = 210 * MiB;
constexpr size_t WS_DT = 243 * MiB;
constexpr size_t WS_ER = 244 * MiB, WS_EL = 245 * MiB;
constexpr size_t WS_DCY = 246 * MiB;
constexpr size_t WS_LB = 246 * MiB + 512 * KiB;
constexpr size_t WS_HX0 = 247 * MiB, WS_HX = 248 * MiB;
constexpr size_t WS_SS1 = 249 * MiB, WS_SS2 = 250 * MiB + 256 * KiB, WS_SS3 = 251 * MiB + 512 * KiB, WS_SS4 = 252 * MiB + 768 * KiB;
constexpr size_t WS_END = 256 * MiB;
constexpr size_t UTH_ENT = 128 * 128;
constexpr size_t UM_ENT = 64 * 128;
static_assert(WS_HB + (size_t)M * 1024 * 2 <= WS_R && (1024 + 4) * UTH_ENT * 2 <= (size_t)M * 1024 * 2, "hb / UTH");
static_assert(WS_H + (size_t)M * FF * 2 <= WS_XBC && WS_QZ + (size_t)M * 2048 <= WS_FZ && WS_FZ + (size_t)M * 2048 <= WS_VB && WS_VB + (size_t)M * 1024 <= WS_GB && WS_GB + (size_t)M * 1024 <= WS_XBC, "map 1");
static_assert(WS_XBC + (size_t)M * 2048 <= WS_UM && WS_UM + (2048 + 8) * UM_ENT * 2 <= WS_DT && WS_DT + (size_t)M * 32 <= WS_ER && WS_SS4 + (size_t)M * 64 <= WS_END, "map 2");
constexpr int CW_BAR = 4096;
constexpr int RING_BYTES = 131072, LDSCTL_OFF = RING_BYTES, MISC_OFF = LDSCTL_OFF + 320, LDS_BYTES = 147456;

#define GAS __attribute__((address_space(1)))
#define LAS __attribute__((address_space(3)))
typedef unsigned short bf16;
typedef unsigned v4u __attribute__((ext_vector_type(4)));
typedef float f32x4 __attribute__((ext_vector_type(4)));
typedef float f32x16 __attribute__((ext_vector_type(16)));
typedef short bf16x8 __attribute__((ext_vector_type(8)));
typedef GAS unsigned gu32;
#define RLX_AGENT __ATOMIC_RELAXED, __HIP_MEMORY_SCOPE_AGENT
#define LDS_WAIT() asm volatile("s_waitcnt lgkmcnt(0)" ::: "memory")
#define VM_WAIT() asm volatile("s_waitcnt vmcnt(0)" ::: "memory")
typedef __bf16 bf16x2_t __attribute__((ext_vector_type(2)));
__device__ __forceinline__ unsigned pk2(float lo, float hi) { bf16x2_t v; v.x = (__bf16)lo; v.y = (__bf16)hi; return __builtin_bit_cast(unsigned, v); }
__device__ __forceinline__ unsigned f2bf(float f) { return (unsigned)__builtin_bit_cast(unsigned short, (__bf16)f); }
__device__ __forceinline__ float bf2f(unsigned short b) { return __builtin_bit_cast(float, (unsigned)b << 16); }
__device__ __forceinline__ float sigm(float x) { return __builtin_amdgcn_rcpf(1.0f + __expf(-x)); }
__device__ __forceinline__ float silu(float x) { return x * __builtin_amdgcn_rcpf(1.0f + __expf(-x)); }
#define XB_TMO      128
#define XB_XCNT(j)  (256  + 64 * (j))
#define XB_XSUB(j)  (1280 + 64 * (j))
#define XB_XGEN(j)  (2304 + 64 * (j))
#define XB_TOP      3328
#define XB_TOPGEN   3392
#define XCD_BAR_WORDS 3456
#define XB_SPIN_CAP (1u << 18)

__device__ __forceinline__ unsigned xb_ld(unsigned* p)              { return __hip_atomic_load(p, __ATOMIC_RELAXED, __HIP_MEMORY_SCOPE_AGENT); }
__device__ __forceinline__ unsigned xb_add(unsigned* p, unsigned v) { return __hip_atomic_fetch_add(p, v, __ATOMIC_RELAXED, __HIP_MEMORY_SCOPE_AGENT); }
__device__ __forceinline__ unsigned xb_xcc_id() { return (unsigned)__builtin_amdgcn_s_getreg((3 << 11) | 20) & 0xFu; }
#define XB_SPIN(cond, bar) do { unsigned _sp = 0; while (cond) { __builtin_amdgcn_s_sleep(1); \
    if ((++_sp & 255u) == 0u) { if (xb_ld(&(bar)[XB_TMO])) break; if (_sp > XB_SPIN_CAP) { atomicAdd(&(bar)[XB_TMO], 1u); break; } } } } while (0)

struct XcdBarrier {
    unsigned* bar; unsigned x;
    volatile LAS unsigned* st;
};

__device__ __forceinline__ XcdBarrier xcd_barrier_post(unsigned* bar, volatile LAS unsigned* st) {
    XcdBarrier b; b.bar = bar; b.x = xb_xcc_id(); b.st = st;
    if (threadIdx.x == 0) (void)xb_add(&bar[XB_XCNT(b.x)], 1u);
    return b;
}
__device__ __forceinline__ void xcd_barrier_complete(unsigned* bar, unsigned x, unsigned& nloc, unsigned& nx) {
    const unsigned G = gridDim.x * gridDim.y * gridDim.z;
    unsigned sum, cnt, mine, sp = 0u;
    for (;;) {
        sum = 0u; cnt = 0u; mine = 0u;
#pragma unroll
        for (unsigned j = 0; j < 16; ++j) { const unsigned c = xb_ld(&bar[XB_XCNT(j)]); sum += c; cnt += (c > 0u) ? 1u : 0u; mine = (j == x) ? c : mine; }
        if (sum == G) break;
        __builtin_amdgcn_s_sleep(1);
        if ((++sp & 255u) == 0u) { if (xb_ld(&bar[XB_TMO])) break; if (sp > XB_SPIN_CAP) { atomicAdd(&bar[XB_TMO], 1u); break; } }
    }
    nloc = mine > 0u ? mine : 1u; nx = cnt > 0u ? cnt : 1u;
}

__device__ __forceinline__ void xcd_barrier(const XcdBarrier& b) {
    asm volatile("s_waitcnt vmcnt(0)" ::: "memory");
    __syncthreads();
    if (threadIdx.x == 0) {
        unsigned* bar = b.bar;
        __builtin_amdgcn_s_waitcnt(0);
        unsigned nloc = b.st[0], nx = b.st[1];
        if (nloc == 0u) { xcd_barrier_complete(bar, b.x, nloc, nx); b.st[0] = nloc; b.st[1] = nx; }
        const unsigned old = xb_add(&bar[XB_XSUB(b.x)], 1u);
        const unsigned gen = old / nloc;
        if (old + 1u == (gen + 1u) * nloc) {
            __builtin_amdgcn_fence(__ATOMIC_RELEASE, "agent");
            asm volatile("s_waitcnt vmcnt(0)" ::: "memory");
            const unsigned og = xb_add(&bar[XB_TOP], 1u);
            const unsigned tg = og / nx;
            if (og + 1u == (tg + 1u) * nx) xb_add(&bar[XB_TOPGEN], 1u);
            else XB_SPIN(xb_ld(&bar[XB_TOPGEN]) == tg, bar);
            __builtin_amdgcn_fence(__ATOMIC_ACQUIRE, "agent");
            xb_add(&bar[XB_XGEN(b.x)], 1u);
            asm volatile("s_waitcnt vmcnt(0)" ::: "memory");
        } else {
            XB_SPIN(xb_ld(&bar[XB_XGEN(b.x)]) == gen, bar);
            __builtin_amdgcn_fence(__ATOMIC_ACQUIRE, "agent");
            asm volatile("s_waitcnt vmcnt(0)" ::: "memory");
        }
    }
    __syncthreads();
}
struct Frame {
    LAS unsigned char* lds;
    volatile LAS unsigned* MISC;
    gu32* ctl;
    int tid, lane, wave, vcu, G;
    GAS float* out; GAS unsigned char* ws;
};
#define WSP(T, off) ((T*)(F.ws + (off)))
#define OUTP(off) ((float*)(F.out + (off)))
constexpr int TAB_OFF = MISC_OFF + 256;
__device__ __forceinline__ const float* inp(const Frame& F, int k) {
    const unsigned long long v = ((const LAS unsigned long long*)(F.lds + TAB_OFF))[k];
    const unsigned lo = __builtin_amdgcn_readfirstlane((unsigned)v), hi = __builtin_amdgcn_readfirstlane((unsigned)(v >> 32));
    return (const float*)(const GAS float*)(((unsigned long long)hi << 32) | lo);
}
__device__ __forceinline__ float wave_sum(float v) {
#pragma unroll
    for (int o = 1; o < 64; o <<= 1) v += __shfl_xor(v, o);
    return v;
}
__device__ __forceinline__ float half_sum32(float v) {
#pragma unroll
    for (int o = 1; o < 32; o <<= 1) v += __shfl_xor(v, o);
    return v;
}
__device__ __forceinline__ float rowsum16(const float (&v)[16], int lane, int& rsel) {
    const bool b4 = (lane & 16) != 0, b3 = (lane & 8) != 0, b2 = (lane & 4) != 0, b1 = (lane & 2) != 0;
    float a[8], b[4], c2[2];
#pragma unroll
    for (int j = 0; j < 8; ++j) { const float t = __shfl_xor(b4 ? v[j] : v[j + 8], 16); a[j] = (b4 ? v[j + 8] : v[j]) + t; }
#pragma unroll
    for (int j = 0; j < 4; ++j) { const float t = __shfl_xor(b3 ? a[j] : a[j + 4], 8); b[j] = (b3 ? a[j + 4] : a[j]) + t; }
#pragma unroll
    for (int j = 0; j < 2; ++j) { const float t = __shfl_xor(b2 ? b[j] : b[j + 2], 4); c2[j] = (b2 ? b[j + 2] : b[j]) + t; }
    float d = (b1 ? c2[1] : c2[0]) + __shfl_xor(b1 ? c2[0] : c2[1], 2);
    d += __shfl_xor(d, 1);
    rsel = (b4 ? 8 : 0) + (b3 ? 4 : 0) + (b2 ? 2 : 0) + (b1 ? 1 : 0);
    return d;
}
__device__ __forceinline__ void tr_item(const float* W, int N, int K, int k0, int n0, const float* nw, bf16* dst, LAS float* scr, int lane) {
    float v[32];
    const int n = n0 + (lane & 31);
#pragma unroll
    for (int i = 0; i < 32; ++i) { const int kk = 2 * i + (lane >> 5); v[i] = (n < N) ? W[(size_t)(k0 + kk) * N + n] : 0.f; }
    if (nw) {
#pragma unroll
        for (int i = 0; i < 32; ++i) v[i] *= nw[k0 + 2 * i + (lane >> 5)];
    }
#pragma unroll
    for (int i = 0; i < 32; ++i) scr[(2 * i + (lane >> 5)) * 33 + (lane & 31)] = v[i];
    LDS_WAIT(); asm volatile("" ::: "memory");
    const int c = lane & 7;
#pragma unroll
    for (int j = 0; j < 4; ++j) { const int nn = (lane >> 3) + 8 * j; const LAS float* s = scr + (8 * c) * 33 + nn;
        v4u o; o.x = pk2(s[0 * 33], s[1 * 33]); o.y = pk2(s[2 * 33], s[3 * 33]); o.z = pk2(s[4 * 33], s[5 * 33]); o.w = pk2(s[6 * 33], s[7 * 33]);
        *(GAS v4u*)(dst + (size_t)nn * K + k0 + 8 * c) = o; }
    LDS_WAIT(); asm volatile("" ::: "memory");
}
__device__ __forceinline__ void p0_prologue(Frame& F) {
    LAS float* scr = (LAS float*)(F.lds + F.wave * 16384);
    const int gw = F.vcu * NWAVES + F.wave, NGW = F.G * NWAVES, lane = F.lane;
    constexpr int I_GU = 16 * 88, I_DN = 44 * 32, I_IN = 16 * 120, I_OUT = 16 * 32;
    constexpr int NITEMS = 6 * I_GU + I_IN + I_OUT;
    static_assert(I_DN == I_GU, "items");
    for (int it = gw; it < NITEMS; it += NGW) {
        int r = it;
        if (r < 6 * I_GU) {
            const int which = r / I_GU; r -= which * I_GU;
            const int ffn = which / 3, kind = which % 3;
            if (kind < 2) {
                const int kb = r / 88, nb = r % 88, n0 = 32 * nb, k0 = 64 * kb;
                const float* W = ffn ? (kind ? inp(F, 23) : inp(F, 22)) : (kind ? inp(F, 9) : inp(F, 8)); const float* nw = ffn ? inp(F, 21) : inp(F, 7);
                bf16* base = WSP(bf16, ffn ? WS_WGU2 : WS_WGU1);
                const int drow = 256 * (n0 >> 7) + (n0 & 127) + 128 * kind;
                tr_item(W, FF, 1024, k0, n0, nw, base + (size_t)drow * 1024, scr, lane);
            } else {
                const int kb = r / 32, nb = r % 32, n0 = 32 * nb, k0 = 64 * kb;
                const float* W = ffn ? inp(F, 24) : inp(F, 10);
                bf16* base = WSP(bf16, ffn ? WS_WD2 : WS_WD1);
                tr_item(W, 1024, FF, k0, n0, nullptr, base + (size_t)n0 * FF, scr, lane);
            }
            continue;
        }
        r -= 6 * I_GU;
        if (r < I_IN) { const int kb = r / 120, nb = r % 120, n0 = 32 * nb, k0 = 64 * kb;
            tr_item(inp(F, 12), NIN, 1024, k0, n0, inp(F, 11), WSP(bf16, WS_WIN) + (size_t)n0 * 1024, scr, lane); continue; }
        r -= I_IN;
        { const int kb = r / 32, nb = r % 32, n0 = 32 * nb, k0 = 64 * kb;
          tr_item(inp(F, 20), 1024, 1024, k0, n0, nullptr, WSP(bf16, WS_WOUT) + (size_t)n0 * 1024, scr, lane); }
    }
    bf16* HB = WSP(bf16, WS_HB); float* RS1 = WSP(float, WS_SS1); float* HX0 = WSP(float, WS_HX0);
    {
        const float* x0 = inp(F, 0); const float* xm = inp(F, 5); const float* xs = inp(F, 1);
#define ROWSRC(m) ((m) < MP ? x0 + (size_t)(m) * D : (m) < ROW_SMP ? xm + (size_t)((m) - ROW_META) * D : (m) < ROW_SMP + NSMP ? xs + (size_t)((m) - ROW_SMP) * D : nullptr)
        f32x4 nx[4];
        { const float* src = gw < M ? ROWSRC(gw) : nullptr;
#pragma unroll
          for (int j = 0; j < 4; ++j) nx[j] = src ? ((const GAS f32x4*)src)[lane + 64 * j] : (f32x4){0.f, 0.f, 0.f, 0.f}; }
        for (int m = gw; m < M; m += NGW) {
            f32x4 v[4]; float s = 0.f;
#pragma unroll
            for (int j = 0; j < 4; ++j) v[j] = nx[j];
            { const int mn = m + NGW; const float* src = mn < M ? ROWSRC(mn) : nullptr;
#pragma unroll
              for (int j = 0; j < 4; ++j) nx[j] = src ? ((const GAS f32x4*)src)[lane + 64 * j] : (f32x4){0.f, 0.f, 0.f, 0.f}; }
#pragma unroll
            for (int j = 0; j < 4; ++j) s += (v[j][0] * v[j][0] + v[j][1] * v[j][1]) + (v[j][2] * v[j][2] + v[j][3] * v[j][3]);
            s = wave_sum(s);
            GAS unsigned long long* o8 = (GAS unsigned long long*)(HB + (size_t)m * D) + lane;
#pragma unroll
            for (int j = 0; j < 4; ++j) o8[64 * j] = (unsigned long long)pk2(v[j][0], v[j][1]) | ((unsigned long long)pk2(v[j][2], v[j][3]) << 32);
            if (lane == 0) RS1[m] = 1.0f / sqrtf(s * (1.0f / 1024.0f) + EPS);
            if (m >= MP) {
#pragma unroll
                for (int j = 0; j < 4; ++j) ((GAS f32x4*)(HX0 + (size_t)(m - MP) * D))[lane + 64 * j] = v[j];
            }
        }
#undef ROWSRC
    }
    if (gw == 0) { float* LB = WSP(float, WS_LB); const float* l = inp(F, 6);
        for (int c = lane; c < 512; c += 64) LB[c] = 1.0f / (1.0f + __expf(l[512 + c] - l[c])); }
}
template <int ppu> __device__ __forceinline__ void fix_extra(Frame& F, int split, const float* slab, const float* RX, float* DX, bf16* HB, const float* SS, float* RSTD, float scale) {
    const int lane = F.lane;
    if (split) {
        LAS float* red = (LAS float*)F.lds;
        for (int lr = F.vcu; lr < 256; lr += F.G) {
            if (F.wave < 4) {
                const int j = F.wave;
                const float* sp = slab + (size_t)j * ppu * 65536 + (size_t)lr * 256 + 4 * lane; f32x4 sum = (f32x4){0.f, 0.f, 0.f, 0.f};
#pragma unroll
                for (int p = 0; p < ppu; ++p) sum = sum + *(const GAS f32x4*)(sp + (size_t)p * 65536);
                const f32x4 v = ((const GAS f32x4*)(RX + (size_t)lr * 1024))[lane + 64 * j] + sum * scale;
                const float ss = wave_sum((v[0] * v[0] + v[1] * v[1]) + (v[2] * v[2] + v[3] * v[3]));
                ((GAS f32x4*)(DX + (size_t)lr * 1024))[lane + 64 * j] = v;
                ((GAS unsigned long long*)(HB + (size_t)(MP + lr) * 1024))[lane + 64 * j] = (unsigned long long)pk2(v[0], v[1]) | ((unsigned long long)pk2(v[2], v[3]) << 32);
                if (lane == 0) red[j] = ss;
            }
            __syncthreads();
            if (F.tid == 0) RSTD[MP + lr] = 1.0f / sqrtf(((red[0] + red[1]) + (red[2] + red[3])) * (1.0f / 1024.0f) + EPS);
            __syncthreads();
        }
    }
    const int gt = F.vcu * (NWAVES * 64) + F.tid, NT = F.G * NWAVES * 64, nrows = split ? MP : M;
    for (int r = gt; r < nrows; r += NT) RSTD[r] = pg8::row_rstd(SS, r);
}
template <int ppu> __device__ __forceinline__ void p8_final(Frame& F, int split, const float* slab) {
    const int gw = F.vcu * NWAVES + F.wave, NGW = F.G * NWAVES, lane = F.lane;
    const float* SS4 = WSP(float, WS_SS4); const float* nf = inp(F, 25);
    f32x4 w[4];
#pragma unroll
    for (int j = 0; j < 4; ++j) w[j] = ((const GAS f32x4*)nf)[lane + 64 * j];
    for (int m = split ? MP + gw : gw; m < MP + NSMP; m += NGW) {
        if (m < MP) {
            float* p = OUTP(O_YP) + (size_t)m * D;
            const float rs = pg8::row_rstd(SS4, m);
#pragma unroll
            for (int j = 0; j < 4; ++j) { f32x4 v = ((const GAS f32x4*)p)[lane + 64 * j]; v = v * rs * w[j]; ((GAS f32x4*)p)[lane + 64 * j] = v; }
        } else {
            const int s = m - MP, lr = NMETA + s; const float* src = WSP(float, WS_HX) + (size_t)lr * D; float* dst = OUTP(O_YS) + (size_t)s * D;
            f32x4 v[4]; float ss = 0.f;
#pragma unroll
            for (int j = 0; j < 4; ++j) { v[j] = ((const GAS f32x4*)src)[lane + 64 * j];
                if (split) { const float* sp = slab + (size_t)j * ppu * 65536 + (size_t)lr * 256 + 4 * lane; f32x4 sum = (f32x4){0.f, 0.f, 0.f, 0.f};
#pragma unroll
                    for (int p = 0; p < ppu; ++p) sum = sum + *(const GAS f32x4*)(sp + (size_t)p * 65536);
                    v[j] = v[j] + sum * 0.5f; }
                ss += (v[j][0] * v[j][0] + v[j][1] * v[j][1]) + (v[j][2] * v[j][2] + v[j][3] * v[j][3]); }
            const float rs = split ? 1.0f / sqrtf(wave_sum(ss) * (1.0f / 1024.0f) + EPS) : pg8::row_rstd(SS4, ROW_SMP + s);
#pragma unroll
            for (int j = 0; j < 4; ++j) ((GAS f32x4*)dst)[lane + 64 * j] = v[j] * rs * w[j];
        }
    }
}
__device__ __forceinline__ int rowreg(int reg, int lane) { return (reg & 3) + 8 * (reg >> 2) + 4 * (lane >> 5); }
template <int K> __device__ __forceinline__ void mma32_ll(f32x16& acc, const LAS bf16* A, int lda, const LAS bf16* B, int ldb, int lane) {
    const LAS bf16* pa = A + (lane & 31) * lda + 8 * (lane >> 5); const LAS bf16* pb = B + (lane & 31) * ldb + 8 * (lane >> 5);
#pragma unroll
    for (int k0 = 0; k0 < K; k0 += 16) { const bf16x8 a = *(const LAS bf16x8*)(pa + k0); const bf16x8 b = *(const LAS bf16x8*)(pb + k0); acc = __builtin_amdgcn_mfma_f32_32x32x16_bf16(a, b, acc, 0, 0, 0); }
}
template <int K> __device__ __forceinline__ void mma32_lg(f32x16& acc, const LAS bf16* A, int lda, const bf16* Bg, int ldb, int lane) {
    const LAS bf16* pa = A + (lane & 31) * lda + 8 * (lane >> 5); const bf16* pb = Bg + (size_t)(lane & 31) * ldb + 8 * (lane >> 5);
#pragma unroll
    for (int kc = 0; kc < K; kc += 64) {
        bf16x8 b[4];
#pragma unroll
        for (int k = 0; k < 4; ++k) b[k] = *(const GAS bf16x8*)(pb + kc + 16 * k);
#pragma unroll
        for (int k = 0; k < 4; ++k) { const bf16x8 a = *(const LAS bf16x8*)(pa + kc + 16 * k); acc = __builtin_amdgcn_mfma_f32_32x32x16_bf16(a, b[k], acc, 0, 0, 0); }
        asm volatile("" ::: "memory");
    }
}
__device__ __forceinline__ void load_frags8(const bf16* Bg, int ldb, int lane, bf16x8 (&b)[8]) {
    const bf16* pb = Bg + (size_t)(lane & 31) * ldb + 8 * (lane >> 5);
#pragma unroll
    for (int k = 0; k < 8; ++k) b[k] = *(const GAS bf16x8*)(pb + 16 * k);
}
__device__ __forceinline__ void mma32_lf8(f32x16& acc, const LAS bf16* A, int lda, const bf16x8 (&b)[8], int lane) {
    const LAS bf16* pa = A + (lane & 31) * lda + 8 * (lane >> 5);
#pragma unroll
    for (int k = 0; k < 8; ++k) { const bf16x8 a = *(const LAS bf16x8*)(pa + 16 * k); acc = __builtin_amdgcn_mfma_f32_32x32x16_bf16(a, b[k], acc, 0, 0, 0); }
}
#define ZERO16 ((f32x16){0.f,0.f,0.f,0.f,0.f,0.f,0.f,0.f,0.f,0.f,0.f,0.f,0.f,0.f,0.f,0.f})

struct HgP { int rowbase, h, nvalid, ent, eidx; };
__device__ __forceinline__ HgP hg_params(int i) {
    HgP p;
    if (i < 1024) { const int b = i >> 7, h = (i >> 5) & 3, c = i & 31; p.rowbase = b * SEQ + c * CH; p.h = h; p.nvalid = CH; p.ent = (b * 4 + h) * 32 + c; p.eidx = b * 32 + c; }
    else { const int h = i - 1024; p.rowbase = ROW_META; p.h = h; p.nvalid = NMETA; p.ent = 1024 + h; p.eidx = 256; }
    return p;
}
struct HgRaw { f32x4 fz[4]; v4u vb[2]; v4u qz[2]; v4u gb[2]; };
template <int PASS> __device__ __forceinline__ void hg_load(Frame& F, const HgP& p, HgRaw& r) {
    const int tid = F.tid;
    const float* FZ = WSP(float, WS_FZ) + (size_t)p.rowbase * 512 + 128 * p.h;
#pragma unroll
    for (int i = 0; i < 4; ++i) { const int idx = tid + 512 * i; r.fz[i] = *(const GAS f32x4*)(FZ + (size_t)(idx >> 5) * 512 + (idx & 31) * 4); }
    const bf16* VB = WSP(bf16, WS_VB) + (size_t)p.rowbase * 512 + 128 * p.h;
#pragma unroll
    for (int i = 0; i < 2; ++i) { const int idx = tid + 512 * i; r.vb[i] = *(const GAS v4u*)(VB + (size_t)(idx >> 4) * 512 + (idx & 15) * 8); }
    if (PASS == 3) { const bf16* QZ = WSP(bf16, WS_QZ) + (size_t)p.rowbase * 1024 + 128 * p.h;
#pragma unroll
        for (int i = 0; i < 2; ++i) { const int idx = tid + 512 * i; r.qz[i] = *(const GAS v4u*)(QZ + (size_t)(idx >> 4) * 1024 + (idx & 15) * 8); }
        const bf16* GB = WSP(bf16, WS_GB) + (size_t)p.rowbase * 512 + 128 * p.h;
#pragma unroll
        for (int i = 0; i < 2; ++i) { const int idx = tid + 512 * i; r.gb[i] = *(const GAS v4u*)(GB + (size_t)(idx >> 4) * 512 + (idx & 15) * 8); } }
}
template <int PASS> __device__ __forceinline__ void hgrn_item(Frame& F, const HgP p, HgRaw& raw, bool has_next, const HgP pn) {
    LAS unsigned char* L = F.lds;
    LAS float* TOT = (LAS float*)L;
    LAS float* FZL = (LAS float*)(L + 2048);
    LAS bf16* VL = (LAS bf16*)(L + 35840);
    LAS bf16* QN = (LAS bf16*)(L + 53248);
    LAS bf16* KN = (LAS bf16*)(L + 70656);
    LAS bf16* VT = (LAS bf16*)(L + 88064);
    LAS bf16* KT = (LAS bf16*)(L + 106496);
    LAS bf16* PP = (LAS bf16*)(L + 106496);
    LAS float* PART = (LAS float*)(L + 124928);
    LAS float* RS = (LAS float*)(L + 125952);
    const int tid = F.tid, lane = F.lane, w = F.wave, c = tid & 127, rg = tid >> 7;
    const int rowbase = p.rowbase, h = p.h;
#pragma unroll
    for (int i = 0; i < 4; ++i) { const int idx = tid + 512 * i; *(LAS f32x4*)(FZL + (idx >> 5) * 132 + (idx & 31) * 4) = raw.fz[i]; }
#pragma unroll
    for (int i = 0; i < 2; ++i) { const int idx = tid + 512 * i; *(LAS v4u*)(VL + (idx >> 4) * 136 + (idx & 15) * 8) = raw.vb[i]; if (PASS == 3) *(LAS v4u*)(QN + (idx >> 4) * 136 + (idx & 15) * 8) = raw.qz[i]; }
    v4u gbr[2]; if (PASS == 3) { gbr[0] = raw.gb[0]; gbr[1] = raw.gb[1]; }
    if (has_next) hg_load<PASS>(F, pn, raw);
    const float lbc = WSP(float, WS_LB)[128 * h + c];
    __syncthreads();
    float bl[16], kk[16], run = 0.f;
#pragma unroll
    for (int i = 0; i < 16; ++i) {
        const int t = rg * 16 + i; const float fz = FZL[t * 132 + c];
        const float sg = sigm(fz), f = lbc + (1.0f - lbc) * sg; float lf = __logf(f), k = (1.0f - lbc) * (1.0f - sg);
        if (t >= p.nvalid) { lf = 0.f; k = 0.f; }
        run += lf; bl[i] = run; kk[i] = k;
    }
    TOT[rg * 128 + c] = run;
    __syncthreads();
    const float t0 = TOT[c], t1 = TOT[128 + c], t2 = TOT[256 + c], t3 = TOT[384 + c];
    const float pre = rg == 0 ? 0.f : rg == 1 ? t0 : rg == 2 ? t0 + t1 : (t0 + t1) + t2;
    const float r = t0 + t1, blast = (t0 + t1) + (t2 + t3);
    unsigned pvv[8];
#pragma unroll
    for (int i = 0; i < 16; i += 2) pvv[i >> 1] = (unsigned)VL[(rg * 16 + i) * 136 + c] | ((unsigned)VL[(rg * 16 + i + 1) * 136 + c] << 16);
    *(LAS v4u*)(VT + c * 72 + rg * 16) = (v4u){pvv[0], pvv[1], pvv[2], pvv[3]}; *(LAS v4u*)(VT + c * 72 + rg * 16 + 8) = (v4u){pvv[4], pvv[5], pvv[6], pvv[7]};
    if (PASS == 1) {
        unsigned pkk[8];
#pragma unroll
        for (int i = 0; i < 16; i += 2) pkk[i >> 1] = pk2(kk[i] * __expf(r - (pre + bl[i])), kk[i + 1] * __expf(r - (pre + bl[i + 1])));
        *(LAS v4u*)(KT + c * 72 + rg * 16) = (v4u){pkk[0], pkk[1], pkk[2], pkk[3]}; *(LAS v4u*)(KT + c * 72 + rg * 16 + 8) = (v4u){pkk[4], pkk[5], pkk[6], pkk[7]};
        if (rg == 0) { WSP(float, WS_ER)[(size_t)p.eidx * 512 + 128 * h + c] = __expf(r); WSP(float, WS_EL)[(size_t)p.eidx * 512 + 128 * h + c] = __expf(blast - r); }
        __syncthreads();
        bf16* UT = WSP(bf16, WS_HB) + (size_t)p.ent * UTH_ENT;
        LAS bf16* OUT = (LAS bf16*)(L + 2048);
        const int vt = w >> 1;
#pragma unroll
        for (int q = 0; q < 2; ++q) {
            const int kt = (w & 1) * 2 + q;
            f32x16 acc = ZERO16;
            mma32_ll<64>(acc, VT + vt * 32 * 72, 72, KT + kt * 32 * 72, 72, lane);
#pragma unroll
            for (int reg = 0; reg < 16; ++reg) OUT[(vt * 32 + rowreg(reg, lane)) * 136 + kt * 32 + (lane & 31)] = (bf16)f2bf(acc[reg]);
        }
        __syncthreads();
#pragma unroll
        for (int i = 0; i < 4; ++i) { const int idx = tid + 512 * i, row = idx >> 4, pc = idx & 15; *(GAS v4u*)(UT + (size_t)row * 128 + pc * 8) = *(const LAS v4u*)(OUT + row * 136 + pc * 8); }
        __syncthreads();
    } else {
#pragma unroll
        for (int i = 0; i < 2; ++i) { const int idx = tid + 512 * i; *(LAS v4u*)((LAS bf16*)(L + 2048) + (idx >> 4) * 136 + (idx & 15) * 8) = gbr[i]; }
#pragma unroll
        for (int i = 0; i < 16; ++i) {
            const int t = rg * 16 + i; const float b = pre + bl[i];
            QN[t * 136 + c] = (bf16)f2bf(bf2f(QN[t * 136 + c]) * __expf(b - r));
            KN[t * 136 + c] = (bf16)f2bf(kk[i] * __expf(r - b));
        }
        __syncthreads();
        bf16x8 sfr[8];
        load_frags8(WSP(bf16, WS_HB) + (size_t)p.ent * UTH_ENT + (size_t)(w & 3) * 32 * 128, 128, lane, sfr);
        if (w < 4) {
            const int tm = w >> 1, sn = w & 1;
            f32x16 acc = ZERO16;
            if (!(tm == 0 && sn == 1)) mma32_ll<128>(acc, QN + tm * 32 * 136, 136, KN + sn * 32 * 136, 136, lane);
#pragma unroll
            for (int reg = 0; reg < 16; ++reg) { const int t = tm * 32 + rowreg(reg, lane), s = sn * 32 + (lane & 31);
                PP[t * 72 + s] = (s <= t) ? (bf16)f2bf(acc[reg]) : (bf16)0; }
        }
        __syncthreads();
        const int tm = w >> 2, vn = w & 3;
        f32x16 acc = ZERO16;
        mma32_ll<64>(acc, PP + tm * 32 * 72, 72, VT + vn * 32 * 72, 72, lane);
        mma32_lf8(acc, QN + tm * 32 * 136, 136, sfr, lane);
        { float sqv[16]; int rsel;
#pragma unroll
          for (int reg = 0; reg < 16; ++reg) sqv[reg] = acc[reg] * acc[reg];
          const float sq = rowsum16(sqv, lane, rsel); if ((lane & 1) == 0) PART[(tm * 32 + rowreg(rsel, lane)) * 4 + vn] = sq; }
        __syncthreads();
        if (tid < 64) RS[tid] = 1.0f / sqrtf(((PART[tid * 4] + PART[tid * 4 + 1]) + (PART[tid * 4 + 2] + PART[tid * 4 + 3])) * (1.0f / 128.0f) + EPS);
        __syncthreads();
        bf16* QZ = WSP(bf16, WS_QZ);
        LAS bf16* OUT = (LAS bf16*)(L + 2048);
#pragma unroll
        for (int reg = 0; reg < 16; ++reg) { const int t = tm * 32 + rowreg(reg, lane), v = vn * 32 + (lane & 31);
            OUT[t * 136 + v] = (bf16)f2bf(acc[reg] * RS[t] * bf2f(OUT[t * 136 + v])); }
        __syncthreads();
#pragma unroll
        for (int i = 0; i < 2; ++i) { const int idx = tid + 512 * i, row = idx >> 4, pc = idx & 15; *(GAS v4u*)(QZ + (size_t)(rowbase + row) * 1024 + 128 * h + pc * 8) = *(const LAS v4u*)(OUT + row * 136 + pc * 8); }
        __syncthreads();
    }
}

struct MbP { int rowbase, g, nvalid, ent0, estride; const bf16* prev; };
__device__ __forceinline__ bool mb_valid(int o, bool with_meta) { return o < 512 || (with_meta && o >= 516 && o < 518); }
__device__ __forceinline__ MbP mb_params(Frame& F, int j) {
    MbP p; const bf16* XBC = WSP(bf16, WS_XBC);
    if (j < 512) { const int b = j >> 6, g = (j >> 5) & 1, c = j & 31, rb = b * SEQ + c * CH; p.rowbase = rb; p.g = g; p.nvalid = CH; p.ent0 = (b * 8 + 4 * g) * 32 + c; p.estride = 32;
        p.prev = c > 0 ? XBC + (size_t)(rb - 3) * 1024 : XBC + (size_t)(ROW_META + 13) * 1024; }
    else { const int g = j - 516; p.rowbase = ROW_META; p.g = g; p.nvalid = NMETA; p.ent0 = 2048 + 4 * g; p.estride = 1; p.prev = nullptr; }
    return p;
}
struct MbRaw { v4u rx[4]; v4u halo; float dt; };
__device__ __forceinline__ int mb_bccol(int g, int pc) { return pc < 16 ? 512 + 128 * g + pc * 8 : 768 + 128 * g + (pc - 16) * 8; }
template <int PASS> __device__ __forceinline__ void mb_load(Frame& F, const MbP& p, MbRaw& r) {
    const int tid = F.tid; const bf16* X = WSP(bf16, WS_XBC) + (size_t)p.rowbase * 1024;
#pragma unroll
    for (int i = 0; i < 4; ++i) { const int idx = tid + 512 * i, row = idx >> 5, pc = idx & 31;
        r.rx[i] = *(const GAS v4u*)(X + (size_t)row * 1024 + 256 * p.g + pc * 8); }
    r.halo = (v4u){0u, 0u, 0u, 0u};
    if (p.prev && tid < 192) { const int hr = tid >> 6, pc = tid & 63; r.halo = *(const GAS v4u*)(p.prev + (size_t)hr * 1024 + (pc < 32 ? 256 * p.g + pc * 8 : mb_bccol(p.g, pc - 32))); }
    r.dt = 0.f;
    if (tid < 256) { const int t = tid & 63; if (t < p.nvalid) r.dt = WSP(float, WS_DT)[(size_t)(p.rowbase + t) * 8 + 4 * p.g + (tid >> 6)]; }
}
template <int PASS> __device__ __forceinline__ void mamba_item(Frame& F, const MbP p, MbRaw& raw, bool has_next, const MbP pn) {
    LAS unsigned char* L = F.lds;
    LAS float* CUM = (LAS float*)L;
    LAS float* DTV = (LAS float*)(L + 1024);
    LAS bf16* XT = (LAS bf16*)(L + 2048);
    LAS bf16* BT = (LAS bf16*)(L + 38912);
    LAS bf16* BN = (LAS bf16*)(L + 38912);
    LAS bf16* CN = (LAS bf16*)(L + 56320);
    LAS bf16* RAW = (LAS bf16*)(L + 73728);
    const int tid = F.tid, lane = F.lane, w = F.wave, g = p.g, rowbase = p.rowbase;
    if (w < 4) {
        const int head = 4 * g + w;
        const float dt = raw.dt;
        const float A = -__expf(inp(F, 17)[head]);
        float cum = dt * A;
#pragma unroll
        for (int o = 1; o < 64; o <<= 1) { const float n = __shfl_up(cum, o); if (lane >= o) cum += n; }
        const float last = __builtin_bit_cast(float, __builtin_amdgcn_readlane(__builtin_bit_cast(int, cum), 63));
        if (PASS == 1) { CUM[w * 64 + lane] = dt * __expf(last - cum); if (lane == 0) WSP(float, WS_DCY)[p.ent0 + w * p.estride] = __expf(last); }
        else { CUM[w * 64 + lane] = cum; DTV[w * 64 + lane] = dt; }
    }
#pragma unroll
    for (int i = 0; i < 4; ++i) { const int idx = tid + 512 * i; *(LAS v4u*)(RAW + ((idx >> 5) + 3) * 256 + (idx & 31) * 8) = raw.rx[i]; }
    if (tid < 192 && (tid & 63) < 32) *(LAS v4u*)(RAW + (tid >> 6) * 256 + (tid & 63) * 8) = raw.halo;
    __syncthreads();
    v4u rbc[4];
    {   const bf16* X = WSP(bf16, WS_XBC) + (size_t)rowbase * 1024;
#pragma unroll
        for (int i = 0; i < 4; ++i) { const int idx = tid + 512 * i, row = idx >> 5, pc = idx & 31;
            rbc[i] = (PASS == 3 || pc < 16) ? *(const GAS v4u*)(X + (size_t)row * 1024 + mb_bccol(g, pc)) : (v4u){0u, 0u, 0u, 0u}; } }
    const int ch = tid & 255, half = tid >> 8;
    const float* cw = inp(F, 14); const float* cbp = inp(F, 15);
    {
        const int col = 256 * g + ch;
        const float w0 = cw[col], w1 = cw[1024 + col], w2 = cw[2048 + col], w3 = cw[3072 + col], cb = cbp[col];
        float r0 = bf2f(RAW[(half * 32 + 0) * 256 + ch]), r1 = bf2f(RAW[(half * 32 + 1) * 256 + ch]), r2 = bf2f(RAW[(half * 32 + 2) * 256 + ch]);
        unsigned pk[16];
#pragma unroll
        for (int i = 0; i < 32; i += 2) {
            const int t = half * 32 + i;
            const float r3 = bf2f(RAW[(t + 3) * 256 + ch]), r4 = bf2f(RAW[(t + 4) * 256 + ch]);
            float a0 = silu(cb + w0 * r0 + w1 * r1 + w2 * r2 + w3 * r3), a1 = silu(cb + w0 * r1 + w1 * r2 + w2 * r3 + w3 * r4);
            if (PASS == 1) { a0 *= CUM[(ch >> 6) * 64 + t]; a1 *= CUM[(ch >> 6) * 64 + t + 1]; }
            pk[i >> 1] = pk2(a0, a1); r0 = r2; r1 = r3; r2 = r4;
        }
        LAS v4u* d = (LAS v4u*)(XT + ch * 72 + half * 32);
        d[0] = (v4u){pk[0], pk[1], pk[2], pk[3]}; d[1] = (v4u){pk[4], pk[5], pk[6], pk[7]}; d[2] = (v4u){pk[8], pk[9], pk[10], pk[11]}; d[3] = (v4u){pk[12], pk[13], pk[14], pk[15]};
    }
    __syncthreads();
#pragma unroll
    for (int i = 0; i < 4; ++i) { const int idx = tid + 512 * i; *(LAS v4u*)(RAW + ((idx >> 5) + 3) * 256 + (idx & 31) * 8) = rbc[i]; }
    if (tid < 192 && (tid & 63) >= 32) *(LAS v4u*)(RAW + (tid >> 6) * 256 + ((tid & 63) - 32) * 8) = raw.halo;
    if (has_next) mb_load<PASS>(F, pn, raw);
    __syncthreads();
    if (PASS == 3 || ch < 128) {
        const int col = ch < 128 ? 512 + 128 * g + ch : 768 + 128 * g + (ch - 128);
        const float w0 = cw[col], w1 = cw[1024 + col], w2 = cw[2048 + col], w3 = cw[3072 + col], cb = cbp[col];
        float r0 = bf2f(RAW[(half * 32 + 0) * 256 + ch]), r1 = bf2f(RAW[(half * 32 + 1) * 256 + ch]), r2 = bf2f(RAW[(half * 32 + 2) * 256 + ch]);
        unsigned pk[16];
#pragma unroll
        for (int i = 0; i < 32; i += 2) {
            const int t = half * 32 + i;
            const float r3 = bf2f(RAW[(t + 3) * 256 + ch]), r4 = bf2f(RAW[(t + 4) * 256 + ch]);
            const float a0 = silu(cb + w0 * r0 + w1 * r1 + w2 * r2 + w3 * r3), a1 = silu(cb + w0 * r1 + w1 * r2 + w2 * r3 + w3 * r4);
            if (PASS == 1) pk[i >> 1] = pk2(a0, a1);
            else { LAS bf16* dst = ch < 128 ? BN + ch : CN + (ch - 128); dst[t * 136] = (bf16)f2bf(a0); dst[(t + 1) * 136] = (bf16)f2bf(a1); }
            r0 = r2; r1 = r3; r2 = r4;
        }
        if (PASS == 1) { LAS v4u* d = (LAS v4u*)(BT + ch * 72 + half * 32);
            d[0] = (v4u){pk[0], pk[1], pk[2], pk[3]}; d[1] = (v4u){pk[4], pk[5], pk[6], pk[7]}; d[2] = (v4u){pk[8], pk[9], pk[10], pk[11]}; d[3] = (v4u){pk[12], pk[13], pk[14], pk[15]}; }
    }
    __syncthreads();
    bf16* UM = WSP(bf16, WS_UM);
    if (PASS == 1) {
        LAS bf16* OUT = (LAS bf16*)(L + 73728);
#pragma unroll
        for (int r = 0; r < 2; ++r) {
            const int hl = w >> 2, hd = 2 * r + hl, pt = (w >> 1) & 1;
#pragma unroll
            for (int q = 0; q < 2; ++q) {
                const int nt = (w & 1) * 2 + q;
                f32x16 acc = ZERO16;
                mma32_ll<64>(acc, XT + (hd * 64 + pt * 32) * 72, 72, BT + nt * 32 * 72, 72, lane);
#pragma unroll
                for (int reg = 0; reg < 16; ++reg) OUT[(hl * 64 + pt * 32 + rowreg(reg, lane)) * 136 + nt * 32 + (lane & 31)] = (bf16)f2bf(acc[reg]);
            }
            __syncthreads();
#pragma unroll
            for (int i = 0; i < 4; ++i) { const int idx = tid + 512 * i, hh = idx >> 10, row = (idx >> 4) & 63, pc = idx & 15;
                *(GAS v4u*)(UM + (size_t)(p.ent0 + (2 * r + hh) * p.estride) * UM_ENT + (size_t)row * 128 + pc * 8) = *(const LAS v4u*)(OUT + (hh * 64 + row) * 136 + pc * 8); }
            __syncthreads();
        }
    } else {
        LAS float* CB = (LAS float*)(L + 73728);
        LAS bf16* WW = (LAS bf16*)(L + 90624);
        LAS float* PART = (LAS float*)(L + 127488);
        LAS float* RS = (LAS float*)(L + 129536);
        bf16x8 hfr[8];
        load_frags8(UM + (size_t)(p.ent0 + (w >> 1) * p.estride) * UM_ENT + (size_t)(w & 1) * 32 * 128, 128, lane, hfr);
        v4u zr[4];
        { const bf16* Zg = WSP(bf16, WS_QZ) + (size_t)rowbase * 1024 + 512 + 256 * g;
#pragma unroll
          for (int i = 0; i < 4; ++i) { const int idx = tid + 512 * i; zr[i] = *(const GAS v4u*)(Zg + (size_t)(idx >> 5) * 1024 + (idx & 31) * 8); } }
        if (w < 4) {
            const int tm = w >> 1, sn = w & 1;
            if (!(tm == 0 && sn == 1)) {
                f32x16 acc = ZERO16;
                mma32_ll<128>(acc, CN + tm * 32 * 136, 136, BN + sn * 32 * 136, 136, lane);
#pragma unroll
                for (int reg = 0; reg < 16; ++reg) CB[(tm * 32 + rowreg(reg, lane)) * 66 + sn * 32 + (lane & 31)] = acc[reg];
            }
        }
        __syncthreads();
        {
            const int hd = tid >> 7, rem = tid & 127, t = rem >> 1, s0 = (rem & 1) * 32;
            const float ct = CUM[hd * 64 + t];
            unsigned pw[16];
#pragma unroll
            for (int j = 0; j < 32; j += 2) {
                const int s = s0 + j;
                const float a = (s <= t) ? CB[t * 66 + s] * __expf(ct - CUM[hd * 64 + s]) * DTV[hd * 64 + s] : 0.f;
                const float b = (s + 1 <= t) ? CB[t * 66 + s + 1] * __expf(ct - CUM[hd * 64 + s + 1]) * DTV[hd * 64 + s + 1] : 0.f;
                pw[j >> 1] = pk2(a, b);
            }
            __syncthreads();
#pragma unroll
            for (int i = 0; i < 4; ++i) { const int idx = tid + 512 * i, zt = idx >> 5, pc = idx & 31;
                *(LAS v4u*)((zt < 32 ? (LAS bf16*)(L + 38912) + zt * 264 : (LAS bf16*)(L + 73728) + (zt - 32) * 264) + pc * 8) = zr[i]; }
            LAS v4u* d = (LAS v4u*)(WW + (hd * 64 + t) * 72 + s0);
            d[0] = (v4u){pw[0], pw[1], pw[2], pw[3]}; d[1] = (v4u){pw[4], pw[5], pw[6], pw[7]}; d[2] = (v4u){pw[8], pw[9], pw[10], pw[11]}; d[3] = (v4u){pw[12], pw[13], pw[14], pw[15]};
        }
        __syncthreads();
        const int hd = w >> 1, pnn = w & 1, head = 4 * g + hd;
        const float Dk = inp(F, 18)[head];
        bf16* QZ = WSP(bf16, WS_QZ);
        const int chn = hd * 64 + pnn * 32 + (lane & 31);
        unsigned yzp[2][8];
#pragma unroll
        for (int tm = 0; tm < 2; ++tm) {
            const LAS bf16* ZL = tm == 0 ? (const LAS bf16*)(L + 38912) : (const LAS bf16*)(L + 73728);
            float sqv[16];
            f32x16 acc = ZERO16;
            mma32_lf8(acc, CN + tm * 32 * 136, 136, hfr, lane);
#pragma unroll
            for (int reg = 0; reg < 16; ++reg) acc[reg] *= __expf(CUM[hd * 64 + tm * 32 + rowreg(reg, lane)]);
            mma32_ll<64>(acc, WW + (hd * 64 + tm * 32) * 72, 72, XT + (hd * 64 + pnn * 32) * 72, 72, lane);
#pragma unroll
            for (int reg = 0; reg < 16; ++reg) {
                const int t = tm * 32 + rowreg(reg, lane);
                const float y = acc[reg] + Dk * bf2f(XT[chn * 72 + t]);
                const float v = y * bf2f(ZL[rowreg(reg, lane) * 264 + chn]);
                if (reg & 1) yzp[tm][reg >> 1] |= f2bf(v) << 16; else yzp[tm][reg >> 1] = f2bf(v);
                sqv[reg] = v * v;
            }
            { int rsel; const float sq = rowsum16(sqv, lane, rsel); if ((lane & 1) == 0) PART[(tm * 32 + rowreg(rsel, lane)) * 8 + w] = sq; }
            asm volatile("" ::: "memory");
        }
        __syncthreads();
        if (tid < 64) { float s = 0.f;
#pragma unroll
            for (int j = 0; j < 8; ++j) s += PART[tid * 8 + j];
            RS[tid] = 1.0f / sqrtf(s * (1.0f / 256.0f) + EPS); }
        __syncthreads();
        const float nw = inp(F, 19)[256 * g + chn];
        LAS bf16* OUT = (LAS bf16*)(L + 2048);
#pragma unroll
        for (int tm = 0; tm < 2; ++tm)
#pragma unroll
            for (int reg = 0; reg < 16; ++reg) { const int t = tm * 32 + rowreg(reg, lane);
                const float v = bf2f((unsigned short)((reg & 1) ? (yzp[tm][reg >> 1] >> 16) : (yzp[tm][reg >> 1] & 0xffffu)));
                OUT[t * 264 + chn] = (bf16)f2bf(v * RS[t] * nw); }
        __syncthreads();
#pragma unroll
        for (int i = 0; i < 4; ++i) { const int idx = tid + 512 * i, row = idx >> 5, pc = idx & 31; *(GAS v4u*)(QZ + (size_t)(rowbase + row) * 1024 + 512 + 256 * g + pc * 8) = *(const LAS v4u*)(OUT + row * 264 + pc * 8); }
        __syncthreads();
    }
}
__device__ __forceinline__ void unpack8(const v4u u, float (&f)[8]) {
    f[0] = bf2f((unsigned short)(u.x & 0xffffu)); f[1] = bf2f((unsigned short)(u.x >> 16)); f[2] = bf2f((unsigned short)(u.y & 0xffffu)); f[3] = bf2f((unsigned short)(u.y >> 16));
    f[4] = bf2f((unsigned short)(u.z & 0xffffu)); f[5] = bf2f((unsigned short)(u.z >> 16)); f[6] = bf2f((unsigned short)(u.w & 0xffffu)); f[7] = bf2f((unsigned short)(u.w >> 16));
}
__device__ __forceinline__ void p4b_scan(Frame& F) {
    const int gt = F.vcu * (NWAVES * 64) + F.tid, NT = F.G * NWAVES * 64;
    const float* ER = WSP(float, WS_ER); const float* EL = WSP(float, WS_EL); const float* DCY = WSP(float, WS_DCY);
    for (int idx = gt; idx < 131072; idx += NT) {
        float S[8];
#pragma unroll
        for (int j = 0; j < 8; ++j) S[j] = 0.f;
        if (idx < 65536) {
            const int bh = idx >> 11, rem = idx & 2047, v = rem >> 4, kd8 = (rem & 15) * 8, b = bh >> 2, h = bh & 3;
            bf16* UTH = WSP(bf16, WS_HB) + (size_t)v * 128 + kd8;
            {
                float uu[8]; unpack8(*(const GAS v4u*)(UTH + (size_t)(1024 + h) * UTH_ENT), uu);
                const float* el = EL + (size_t)256 * 512 + 128 * h + kd8;
#pragma unroll
                for (int j = 0; j < 8; ++j) S[j] = el[j] * uu[j];
            }
            for (int c0 = 0; c0 < NCH; c0 += 8) {
                v4u u[8]; f32x4 er[8][2], el[8][2];
#pragma unroll
                for (int q = 0; q < 8; ++q) { const size_t e = (size_t)(b * 32 + c0 + q);
                    u[q] = *(const GAS v4u*)(UTH + (size_t)(bh * 32 + c0 + q) * UTH_ENT);
                    er[q][0] = *(const GAS f32x4*)(ER + e * 512 + 128 * h + kd8); er[q][1] = *(const GAS f32x4*)(ER + e * 512 + 128 * h + kd8 + 4);
                    el[q][0] = *(const GAS f32x4*)(EL + e * 512 + 128 * h + kd8); el[q][1] = *(const GAS f32x4*)(EL + e * 512 + 128 * h + kd8 + 4); }
#pragma unroll
                for (int q = 0; q < 8; ++q) { float uu[8], sp[8]; unpack8(u[q], uu);
#pragma unroll
                    for (int j = 0; j < 8; ++j) { sp[j] = er[q][j >> 2][j & 3] * S[j]; S[j] = el[q][j >> 2][j & 3] * (sp[j] + uu[j]); }
                    *(GAS v4u*)(UTH + (size_t)(bh * 32 + c0 + q) * UTH_ENT) = (v4u){pk2(sp[0], sp[1]), pk2(sp[2], sp[3]), pk2(sp[4], sp[5]), pk2(sp[6], sp[7])}; }
            }
            float* o = OUTP(O_HGP) + ((size_t)bh * 128 + kd8) * 128 + v;
#pragma unroll
            for (int j = 0; j < 8; ++j) o[(size_t)j * 128] = S[j];
        } else {
            const int i2 = idx - 65536, bhd = i2 >> 10, rem = i2 & 1023, p_ = rem >> 4, n8 = (rem & 15) * 8, head = bhd & 7;
            bf16* UM = WSP(bf16, WS_UM) + (size_t)p_ * 128 + n8;
            {   float uu[8]; unpack8(*(const GAS v4u*)(UM + (size_t)(2048 + head) * UM_ENT), uu);
#pragma unroll
                for (int j = 0; j < 8; ++j) S[j] = uu[j]; }
            for (int c0 = 0; c0 < NCH; c0 += 8) {
                v4u u[8]; float d[8];
#pragma unroll
                for (int q = 0; q < 8; ++q) { u[q] = *(const GAS v4u*)(UM + (size_t)(bhd * 32 + c0 + q) * UM_ENT); d[q] = DCY[bhd * 32 + c0 + q]; }
#pragma unroll
                for (int q = 0; q < 8; ++q) { float uu[8], sp[8]; unpack8(u[q], uu);
#pragma unroll
                    for (int j = 0; j < 8; ++j) { sp[j] = S[j]; S[j] = d[q] * S[j] + uu[j]; }
                    *(GAS v4u*)(UM + (size_t)(bhd * 32 + c0 + q) * UM_ENT) = (v4u){pk2(sp[0], sp[1]), pk2(sp[2], sp[3]), pk2(sp[4], sp[5]), pk2(sp[6], sp[7])}; }
            }
            float* o = OUTP(O_SSP) + ((size_t)bhd * 64 + p_) * 128 + n8;
            *(GAS f32x4*)o = (f32x4){S[0], S[1], S[2], S[3]}; *(GAS f32x4*)(o + 4) = (f32x4){S[4], S[5], S[6], S[7]};
        }
    }
}
__device__ __forceinline__ void hgrn_decode(Frame& F, int smp, int h) {
    LAS float* OS = (LAS float*)F.lds;
    LAS float* RED = (LAS float*)(F.lds + 8192);
    const int tid = F.tid, row = ROW_SMP + smp, v4 = (tid & 31) * 4, kg = tid >> 5;
    const float* FZ = WSP(float, WS_FZ); const bf16* VB = WSP(bf16, WS_VB); bf16* QZ = WSP(bf16, WS_QZ); const float* LB = WSP(float, WS_LB);
    const float* Sin = inp(F, 2) + (size_t)(smp * 4 + h) * 16384; float* Sout = OUTP(O_HGS) + (size_t)(smp * 4 + h) * 16384;
    f32x4 vv; { const unsigned long long raw = *(const GAS unsigned long long*)(VB + (size_t)row * 512 + 128 * h + v4);
        vv = (f32x4){bf2f((unsigned short)raw), bf2f((unsigned short)(raw >> 16)), bf2f((unsigned short)(raw >> 32)), bf2f((unsigned short)(raw >> 48))}; }
    f32x4 o = (f32x4){0.f, 0.f, 0.f, 0.f};
    f32x4 st[8]; float fzv[8], lbv[8], qv[8];
#pragma unroll
    for (int j = 0; j < 8; ++j) { const int kd = kg * 8 + j;
        st[j] = *(const GAS f32x4*)(Sin + (size_t)kd * 128 + v4);
        fzv[j] = FZ[(size_t)row * 512 + 128 * h + kd]; lbv[j] = LB[128 * h + kd]; qv[j] = bf2f(QZ[(size_t)row * 1024 + 128 * h + kd]); }
#pragma unroll
    for (int j = 0; j < 8; ++j) {
        const int kd = kg * 8 + j;
        const float sg = sigm(fzv[j]), f = lbv[j] + (1.0f - lbv[j]) * sg, k = (1.0f - lbv[j]) * (1.0f - sg);
        const f32x4 sn = st[j] * f + vv * k;
        *(GAS f32x4*)(Sout + (size_t)kd * 128 + v4) = sn;
        o = o + sn * qv[j];
    }
    *(LAS f32x4*)(OS + kg * 128 + v4) = o;
    __syncthreads();
    float ov = 0.f;
    if (tid < 128) {
#pragma unroll
        for (int j = 0; j < 16; ++j) ov += OS[j * 128 + tid];
        const float sq = wave_sum(ov * ov); if (F.lane == 0) RED[F.wave] = sq;
    }
    __syncthreads();
    if (tid < 128) {
        const float rs = 1.0f / sqrtf((RED[0] + RED[1]) * (1.0f / 128.0f) + EPS);
        const float g = bf2f(WSP(bf16, WS_GB)[(size_t)row * 512 + 128 * h + tid]);
        QZ[(size_t)row * 1024 + 128 * h + tid] = (bf16)f2bf(ov * rs * g);
    }
    __syncthreads();
}
__device__ __forceinline__ void mamba_decode(Frame& F, int smp, int g) {
    LAS float* XS = (LAS float*)F.lds;
    LAS float* YS = (LAS float*)(F.lds + 2048);
    LAS float* RED = (LAS float*)(F.lds + 3072);
    const int tid = F.tid, row = ROW_SMP + smp;
    const bf16* XBC = WSP(bf16, WS_XBC); bf16* QZ = WSP(bf16, WS_QZ);
    {
        const int ch = tid, col = ch < 256 ? 256 * g + ch : ch < 384 ? 512 + 128 * g + (ch - 256) : 768 + 128 * g + (ch - 384);
        const float* cw = inp(F, 14); const float* sc = inp(F, 4) + (size_t)smp * 3 * 1024;
        const float s0 = sc[col], s1 = sc[1024 + col], s2 = sc[2048 + col], cur = bf2f(XBC[(size_t)row * 1024 + col]);
        XS[ch] = silu(inp(F, 15)[col] + cw[col] * s0 + cw[1024 + col] * s1 + cw[2048 + col] * s2 + cw[3072 + col] * cur);
        float* cs = OUTP(O_CVS) + (size_t)smp * 3 * 1024; cs[col] = s1; cs[1024 + col] = s2;
    }
    __syncthreads();
    {
        const int hd = tid >> 7, r = tid & 127, n4 = (r & 31) * 4, pg = r >> 5, head = 4 * g + hd;
        const float dt = WSP(float, WS_DT)[(size_t)row * 8 + head], dA = __expf(-dt * __expf(inp(F, 17)[head])), Dk = inp(F, 18)[head];
        const f32x4 Bv = *(const LAS f32x4*)(XS + 256 + n4), Cv = *(const LAS f32x4*)(XS + 384 + n4);
        const float* Sin = inp(F, 3) + (size_t)(smp * 8 + head) * 8192; float* Sout = OUTP(O_SSS) + (size_t)(smp * 8 + head) * 8192;
        float yv[16]; f32x4 st[16];
#pragma unroll
        for (int j = 0; j < 16; ++j) st[j] = *(const GAS f32x4*)(Sin + (size_t)(pg * 16 + j) * 128 + n4);
#pragma unroll
        for (int j = 0; j < 16; ++j) {
            const int p = pg * 16 + j; const float x = XS[hd * 64 + p];
            const f32x4 sn = st[j] * dA + Bv * (dt * x);
            *(GAS f32x4*)(Sout + (size_t)p * 128 + n4) = sn;
            yv[j] = (sn[0] * Cv[0] + sn[1] * Cv[1]) + (sn[2] * Cv[2] + sn[3] * Cv[3]);
        }
        { int rsel; const float y = rowsum16(yv, F.lane, rsel); if ((r & 1) == 0) { const int p = pg * 16 + rsel; YS[hd * 64 + p] = y + Dk * XS[hd * 64 + p]; } }
    }
    __syncthreads();
    float yz = 0.f;
    if (tid < 256) {
        yz = YS[tid] * bf2f(QZ[(size_t)row * 1024 + 512 + 256 * g + tid]);
        const float sq = wave_sum(yz * yz); if (F.lane == 0) RED[F.wave] = sq;
    }
    __syncthreads();
    if (tid < 256) {
        const float rs = 1.0f / sqrtf(((RED[0] + RED[1]) + (RED[2] + RED[3])) * (1.0f / 256.0f) + EPS);
        QZ[(size_t)row * 1024 + 512 + 256 * g + tid] = (bf16)f2bf(yz * rs * inp(F, 19)[256 * g + tid]);
    }
    __syncthreads();
}
__device__ __forceinline__ void p4a(Frame& F, bool decode) {
    if (decode) {
        for (int j = F.vcu; j < 512; j += F.G) hgrn_decode(F, j >> 2, j & 3);
        for (int j = F.vcu; j < 256; j += F.G) mamba_decode(F, j >> 1, j & 1);
    }
    {   HgRaw raw; int i = F.vcu; if (i < 1028) { const HgP p0 = hg_params(i); hg_load<1>(F, p0, raw); }
        for (; i < 1028; i += F.G) { const int in = i + F.G; hgrn_item<1>(F, hg_params(i), raw, in < 1028, hg_params(in < 1028 ? in : i)); } }
    {   MbRaw raw; int j = F.vcu; if (mb_valid(j, true)) { const MbP p0 = mb_params(F, j); mb_load<1>(F, p0, raw); }
        for (; mb_valid(j, true); j += F.G) { const int jn = j + F.G; const bool hn = mb_valid(jn, true); mamba_item<1>(F, mb_params(F, j), raw, hn, mb_params(F, hn ? jn : j)); } }
}
__device__ __forceinline__ void p4c(Frame& F) {
    {   HgRaw raw; int i = F.vcu; if (i < 1024) { const HgP p0 = hg_params(i); hg_load<3>(F, p0, raw); }
        for (; i < 1024; i += F.G) { const int in = i + F.G; hgrn_item<3>(F, hg_params(i), raw, in < 1024, hg_params(in < 1024 ? in : i)); } }
    {   MbRaw raw; int j = F.vcu; if (j < 512) { const MbP p0 = mb_params(F, j); mb_load<3>(F, p0, raw); }
        for (; j < 512; j += F.G) { const int jn = j + F.G; mamba_item<3>(F, mb_params(F, j), raw, jn < 512, mb_params(F, jn < 512 ? jn : j)); } }
}
#ifndef MK_PER_PHASE
#define MK_PER_PHASE 0
#endif
#ifndef GP_ALIGN
#define GP_ALIGN true
#endif
#ifndef GP_SP2
#define GP_SP2 true
#endif
#ifndef GP_SP2_FINAL
#define GP_SP2_FINAL false
#endif
#ifndef WGM_GU
#define WGM_GU 4
#endif
#ifndef WGM_IN
#define WGM_IN 4
#endif
#ifndef WGM_DN
#define WGM_DN 4
#endif
constexpr int N_PHASES = 13;
struct Args { const float* in[26]; float* out; unsigned char* ws; int ph_lo, ph_hi; };
static_assert(sizeof(Args) == 26 * 8 + 8 + 8 + 8, "Args has no padding");
template <bool SPLIT> __global__ void __launch_bounds__(NWAVES * 64, 2) hymba_fwd(Args args) {
    extern __shared__ __attribute__((aligned(16))) unsigned char lds[];
    Frame F;
    F.lds = (LAS unsigned char*)lds;
    F.MISC = (volatile LAS unsigned*)(F.lds + MISC_OFF);
    F.tid = threadIdx.x; F.lane = F.tid & 63; F.wave = __builtin_amdgcn_readfirstlane(F.tid >> 6);
    F.G = gridDim.x; { const int bx = blockIdx.x; F.vcu = (F.G % 8 == 0) ? (bx % 8) * (F.G / 8) + bx / 8 : bx; }
    F.ws = (GAS unsigned char*)args.ws; F.out = (GAS float*)args.out; F.ctl = (gu32*)(args.ws + WS_CTL);
    for (int u = F.tid; u < (LDS_BYTES - LDSCTL_OFF) / 4; u += NWAVES * 64) ((LAS unsigned*)(F.lds + LDSCTL_OFF))[u] = 0u;
    __syncthreads();
    if (F.tid < 26) ((LAS unsigned long long*)(F.lds + TAB_OFF))[F.tid] = (unsigned long long)args.in[F.tid];
    __syncthreads();
    XcdBarrier bar; bar.bar = (unsigned*)(F.ctl + CW_BAR); bar.x = 0; bar.st = nullptr;
    if (!MK_PER_PHASE) bar = xcd_barrier_post((unsigned*)(F.ctl + CW_BAR), F.MISC + 8);
    const int lo = args.ph_lo, hi = args.ph_hi;
#ifndef PH_MASK
#define PH_MASK 0x1fff
#endif
#define IN(k) (((PH_MASK >> (k)) & 1) && lo <= (k) && (k) < hi)
#ifndef PH_REPEAT
#define PH_REPEAT 0
#endif
#define SEAM(k) do { if (IN(k) && IN((k) + 1)) xcd_barrier(bar); } while (0)
#define PHASE_LOCAL() asm volatile("" : "+s"(F.ws), "+s"(F.out), "+v"(F.tid), "+v"(F.lane), "+s"(F.wave), "+s"(F.vcu), "+s"(F.G))
#define REP(k) for (int rep_ = 0; rep_ < 1 + ((PH_REPEAT >> (k)) & 1); ++rep_)
#define HB WSP(bf16, WS_HB)
#define HH WSP(bf16, WS_H)
#define QZ WSP(bf16, WS_QZ)
#define SS1 WSP(float, WS_SS1)
#define SS2 WSP(float, WS_SS2)
#define SS3 WSP(float, WS_SS3)
#define SS4 WSP(float, WS_SS4)
#define RS2 (WSP(float, WS_SS1) + 32768)
#define RS3 (WSP(float, WS_SS1) + 65536)
#define YP (OUTP(O_YP))
#define HX0 WSP(float, WS_HX0)
#define HX WSP(float, WS_HX)

    constexpr int split = SPLIT ? 1 : 0;
#define SLABS WSP(float, WS_XBC)
    if (IN(0)) REP(0) { if (rep_ == 1) xcd_barrier(bar); PHASE_LOCAL(); p0_prologue(F); } SEAM(0);
    if (IN(1)) REP(1) { if (rep_ == 1) xcd_barrier(bar); PHASE_LOCAL();
        pg8::Gemm g{HB, WSP(bf16, WS_WGU1), M, 2 * FF, D, D}; pg8::MixOrder S; S.init(65, 2 * FF, D, F.G, (int)blockIdx.x, 0, WGM_GU);
        pg8::EpiSwiglu E{HH, SS1, LDH, FF / 64};
        pg8::gemm_phase<pg8::EpiSwiglu, pg8::MixOrder, GP_ALIGN, GP_SP2>(F.lds, g, S, E, nullptr);
    } SEAM(1);
    if (IN(2)) REP(2) { if (rep_ == 1) xcd_barrier(bar); PHASE_LOCAL();
        pg8::Gemm g{HH, WSP(bf16, WS_WD1), M, D, FF, LDH}; pg8::MixOrder S; S.init(split ? 64 : 65, D, FF, F.G, (int)blockIdx.x, split, WGM_DN);
        pg8::EpiResid E{inp(F, 0), YP, HX0, HX, HB, SS2, 0.5f, nullptr};
        pg8::gemm_phase<pg8::EpiResid, pg8::MixOrder, GP_ALIGN, GP_SP2>(F.lds, g, S, E, SLABS);
    } SEAM(2);
    if (IN(3)) REP(3) { if (rep_ == 1) xcd_barrier(bar); PHASE_LOCAL(); fix_extra<FF / 128>(F, split, SLABS, HX0, HX, HB, SS2, RS2, 0.5f); } SEAM(3);
    if (IN(4)) REP(4) { if (rep_ == 1) xcd_barrier(bar); PHASE_LOCAL();
        pg8::Gemm g{HB, WSP(bf16, WS_WIN), M, NINP, D, D}; pg8::MixOrder S; S.init(65, NINP, D, F.G, (int)blockIdx.x, 0, WGM_IN);
        pg8::EpiInproj E{RS2, QZ, WSP(float, WS_FZ), WSP(bf16, WS_VB), WSP(bf16, WS_GB), WSP(bf16, WS_XBC), WSP(float, WS_DT), inp(F, 13), inp(F, 16), OUTP(O_CVP), OUTP(O_CVS)};
        pg8::gemm_phase<pg8::EpiInproj, pg8::MixOrder, GP_ALIGN, GP_SP2>(F.lds, g, S, E, nullptr);
    } SEAM(4);
    if (IN(5)) REP(5) { if (rep_ == 1) xcd_barrier(bar); PHASE_LOCAL(); p4a(F, rep_ == 0); } SEAM(5);
    if (IN(6)) REP(6) { if (rep_ == 1) xcd_barrier(bar); PHASE_LOCAL(); p4b_scan(F); } SEAM(6);
    if (IN(7)) REP(7) { if (rep_ == 1) xcd_barrier(bar); PHASE_LOCAL(); p4c(F); } SEAM(7);
    if (IN(8)) REP(8) { if (rep_ == 1) xcd_barrier(bar); PHASE_LOCAL();
        pg8::Gemm g{QZ, WSP(bf16, WS_WOUT), M, D, D, D}; pg8::MixOrder S; S.init(split ? 64 : 65, D, D, F.G, (int)blockIdx.x, split, WGM_DN);
        pg8::EpiResid E{YP, YP, HX, HX, HB, SS3, 1.0f, nullptr};
        pg8::gemm_phase<pg8::EpiResid, pg8::MixOrder, GP_ALIGN, GP_SP2>(F.lds, g, S, E, SLABS);
    } SEAM(8);
    if (IN(9)) REP(9) { if (rep_ == 1) xcd_barrier(bar); PHASE_LOCAL(); fix_extra<D / 128>(F, split, SLABS, HX, HX, HB, SS3, RS3, 1.0f);
        if (split) { GAS v4u* z = (GAS v4u*)(F.ws + WS_UM); for (int i = F.vcu * (NWAVES * 64) + F.tid; i < 131072; i += F.G * NWAVES * 64) z[i] = (v4u){0u, 0u, 0u, 0u}; } }
    if (IN(10)) REP(10) { if (rep_ == 1) xcd_barrier(bar); PHASE_LOCAL();
        pg8::Gemm g{HB, WSP(bf16, WS_WGU2), M, 2 * FF, D, D}; pg8::MixOrder S; S.init(65, 2 * FF, D, F.G, (int)blockIdx.x, 0, WGM_GU);
        pg8::EpiSwiglu E{HH, RS3, LDH, FF / 64};
        pg8::gemm_phase<pg8::EpiSwiglu, pg8::MixOrder, GP_ALIGN, GP_SP2>(F.lds, g, S, E, nullptr);
    } SEAM(10);
    if (IN(11)) REP(11) { if (rep_ == 1) xcd_barrier(bar); PHASE_LOCAL();
        pg8::Gemm g{HH, WSP(bf16, WS_WD2), M, D, FF, LDH}; pg8::MixOrder S; S.init(split ? 64 : 65, D, FF, F.G, (int)blockIdx.x, split, WGM_DN);
        pg8::EpiResid E{YP, YP, HX, HX, nullptr, SS4, 0.5f, split ? (unsigned long long*)(F.ws + WS_UM) : nullptr};
        pg8::gemm_phase<pg8::EpiResid, pg8::MixOrder, GP_ALIGN, GP_SP2>(F.lds, g, S, E, SLABS);
        if constexpr (SPLIT) {
            pg8::Unit u; S.next(0, u);
            VM_WAIT(); __syncthreads();
            unsigned long long* gp = (unsigned long long*)(F.ws + WS_UM) + (size_t)u.pm * 256 * 16;
            float* yb = YP + (size_t)u.pm * 256 * 1024 + u.pn * 256 + 4 * F.lane;
            const f32x4 w = *(const GAS f32x4*)(inp(F, 25) + u.pn * 256 + 4 * F.lane);
            float tot[8];
            { unsigned long long x[8]; unsigned spins = 0;
              for (;;) { bool ok = true;
#pragma unroll
                  for (int j = 0; j < 8; ++j) { x[j] = __hip_atomic_load(gp + (size_t)F.wave * 512 + F.lane + 64 * j, __ATOMIC_RELAXED, __HIP_MEMORY_SCOPE_AGENT); ok = ok && ((unsigned)(x[j] >> 32) == 1u); }
                  if (__all(ok) || ++spins > (1u << 18)) break; __builtin_amdgcn_s_sleep(4); }
#pragma unroll
              for (int j = 0; j < 8; ++j) { float v = __builtin_bit_cast(float, (unsigned)x[j]); v += __shfl_xor(v, 1); v += __shfl_xor(v, 2); v += __shfl_xor(v, 4); v += __shfl_xor(v, 8); tot[j] = v; } }
            f32x4 o[32];
#pragma unroll
            for (int i = 0; i < 32; ++i) o[i] = *(const GAS f32x4*)(yb + (size_t)(F.wave * 32 + i) * 1024);
#pragma unroll
            for (int r = 0; r < 32; ++r) { const float rs = __builtin_amdgcn_rsqf(__builtin_bit_cast(float, __builtin_amdgcn_readlane(__builtin_bit_cast(int, tot[r >> 2]), (r & 3) * 16)) * (1.0f / 1024.0f) + EPS);
                *(GAS f32x4*)(yb + (size_t)(F.wave * 32 + r) * 1024) = o[r] * rs * w; }
        }
    } SEAM(11);
    if (IN(12)) REP(12) { if (rep_ == 1) xcd_barrier(bar); PHASE_LOCAL(); p8_final<FF / 128>(F, split, SLABS); }
#undef SLABS
#undef IN
#undef SEAM
#undef HB
#undef HH
#undef QZ
#undef SS1
#undef SS2
#undef SS3
#undef SS4
#undef RS2
#undef RS3
#undef YP
#undef HX0
#undef HX
}

extern "C" void kernel_launch(void* const* d_in, const int* in_sizes, int n_in, void* d_out, int out_size, void* d_ws, size_t ws_size, hipStream_t stream) {
    static int grid = 0;
    if (grid == 0) {
        if (n_in != 26 || in_sizes[0] != MP * D || (size_t)out_size != O_END || ws_size < WS_END) {
            fprintf(stderr, "kernel_launch: unexpected shapes: n_in %d in0 %d out %d ws %zu; nothing launched\n", n_in, n_in > 0 ? in_sizes[0] : -1, out_size, ws_size); grid = -1; return; }
        int dev = 0, cus = 0, per_cu = 0;
        if (hipGetDevice(&dev) != hipSuccess || hipDeviceGetAttribute(&cus, hipDeviceAttributeMultiprocessorCount, dev) != hipSuccess) { fprintf(stderr, "kernel_launch: device query failed\n"); grid = -1; return; }
        if (hipFuncSetAttribute((const void*)hymba_fwd<true>, hipFuncAttributeMaxDynamicSharedMemorySize, LDS_BYTES) != hipSuccess || hipFuncSetAttribute((const void*)hymba_fwd<false>, hipFuncAttributeMaxDynamicSharedMemorySize, LDS_BYTES) != hipSuccess) { fprintf(stderr, "kernel_launch: hipFuncSetAttribute failed\n"); grid = -1; return; }
        if (hipOccupancyMaxActiveBlocksPerMultiprocessor(&per_cu, cus == 256 ? (const void*)hymba_fwd<true> : (const void*)hymba_fwd<false>, NWAVES * 64, LDS_BYTES) != hipSuccess || per_cu < 1)
            fprintf(stderr, "kernel_launch: note: occupancy query reports %d workgroups per CU\n", per_cu);
        (void)hipGetLastError();
        grid = cus;
    }
    if (grid < 0) return;
    if (hipMemsetAsync((char*)d_ws + WS_CTL, 0, CTL_ZERO_BYTES, stream) != hipSuccess) { fprintf(stderr, "kernel_launch: memset failed\n"); return; }
    Args a{};
    for (int i = 0; i < 26; ++i) a.in[i] = (const float*)d_in[i];
    a.out = (float*)d_out; a.ws = (unsigned char*)d_ws;
#if MK_PER_PHASE
    for (int p = 0; p < N_PHASES; ++p) { a.ph_lo = p; a.ph_hi = p + 1; if (grid == 256) hipLaunchKernelGGL(hymba_fwd<true>, dim3(grid), dim3(NWAVES * 64), LDS_BYTES, stream, a); else hipLaunchKernelGGL(hymba_fwd<false>, dim3(grid), dim3(NWAVES * 64), LDS_BYTES, stream, a); }
#else
    a.ph_lo = 0; a.ph_hi = N_PHASES;
    if (grid == 256) hipLaunchKernelGGL(hymba_fwd<true>, dim3(grid), dim3(NWAVES * 64), LDS_BYTES, stream, a);
    else hipLaunchKernelGGL(hymba_fwd<false>, dim3(grid), dim3(NWAVES * 64), LDS_BYTES, stream, a);
#endif
    const hipError_t le = hipPeekAtLastError();
    if (le != hipSuccess) fprintf(stderr, "kernel_launch: launch failed: %s\n", hipGetErrorName(le));
}
```

```cpp
#include <hip/hip_runtime.h>
#include <cstdio>
#include <cstdint>
namespace pg8 {
#define PG8_LAS __attribute__((address_space(3)))
typedef unsigned short bf16_t;
typedef short bf16x8 __attribute__((ext_vector_type(8)));
typedef float f32x4 __attribute__((ext_vector_type(4)));
typedef unsigned u32x4 __attribute__((ext_vector_type(4)));
constexpr int BM = 256, BK = 64, HALF = 128, HTB = HALF * BK * 2  , STAGE_BYTES = 8 * HTB, NXCD = 8, WGM = 8;

__host__ __device__ __forceinline__ int lds_byte(int r, int c) { const int st = (r >> 4) * 2 + (c >> 5), rr = r & 15, cc = c & 31, ob = rr * 64 + cc * 2; return st * 1024 + (ob ^ (((ob >> 9) & 1) << 5)); }
__host__ __device__ __forceinline__ void stage_rc(int b, int& R, int& C) { const int st = b / 1024, sb = b % 1024, swz = sb ^ (((sb >> 9) & 1) << 5); R = (st >> 1) * 16 + swz / 64; C = (st & 1) * 32 + (swz % 64) / 2; }
__host__ __device__ __forceinline__ int perm32(int rho) { const int n = rho >> 4, i = rho & 15; return 8 * (i >> 2) + 4 * n + (i & 3); }

struct Unit { int pm, pn, k0, nt, kind, slot; };
struct Gemm { const bf16_t* A; const bf16_t* Bt; int M, N, K, lda; };

struct MixOrder {
    int nM, nN, nwg, G, c, ppu, npieces, rounds, wgm;
    __host__ __device__ __forceinline__ void init(int nM_, int N, int K, int G_, int c_, int split, int wgm_) { wgm = wgm_; nM = nM_; nN = N / BM; nwg = nM * nN; G = G_; c = c_; ppu = K / (2 * BK); npieces = split ? nN * ppu : 0; rounds = (nwg + G - 1) / G; }
    __host__ __device__ __forceinline__ bool next(int i, Unit& u) const {
        if (i >= rounds) { const int p = (i - rounds) * G + c; if (p >= npieces) return false; u.pm = nM; u.pn = p / ppu; u.k0 = 2 * (p % ppu); u.nt = 2; u.kind = 1; u.slot = p; return true; }
        const long L = (long)i * G + c; if (L >= nwg) return false;
        int wgid = (int)L; { const int q = nwg / NXCD, r = nwg % NXCD, xcd = wgid % NXCD, off = wgid / NXCD; wgid = (xcd < r ? xcd * (q + 1) : r * (q + 1) + (xcd - r) * q) + off; }
        const int nig = wgm * nN, gid = wgid / nig, fm = gid * wgm, gsz = (nM - fm) < wgm ? (nM - fm) : wgm;
        u.pm = fm + ((wgid % nig) % gsz); u.pn = (wgid % nig) / gsz; u.k0 = 0; u.nt = 2 * ppu; u.kind = 0; u.slot = 0; return true;
    }
};

__device__ __forceinline__ unsigned cvt_pk_bf16(float lo, float hi) { unsigned r; asm volatile("v_cvt_pk_bf16_f32 %0, %1, %2" : "=v"(r) : "v"(lo), "v"(hi)); return r; }
typedef float f32x2 __attribute__((ext_vector_type(2)));
constexpr float EPSN = 1e-6f;
__device__ __forceinline__ float row_rstd(const float* SS, int row) {
    const f32x4* p = (const f32x4*)(SS + (size_t)row * 16);
    const f32x4 a = p[0], b = p[1], c = p[2], d = p[3];
    const float s = (((a[0] + a[1]) + (a[2] + a[3])) + ((b[0] + b[1]) + (b[2] + b[3]))) + (((c[0] + c[1]) + (c[2] + c[3])) + ((d[0] + d[1]) + (d[2] + d[3])));
    return __builtin_amdgcn_rsqf(s * (1.0f / 1024.0f) + EPSN);
}
__device__ __forceinline__ float silu_f(float x) { return x * __builtin_amdgcn_rcpf(1.0f + __expf(-x)); }
typedef unsigned u32x2 __attribute__((ext_vector_type(2)));

struct EpiSwiglu {
    static constexpr bool PERM = true, AFTER_DRAIN = false;
    bf16_t* H; const float* RSTD; int ldh, nkt;
    __device__ __forceinline__ void operator()(const f32x4 (&acc)[2][2][4][2], const Unit& u, int wr, int wc, int fr, int fq) const {
        const int row0 = u.pm * BM + wr * 64 + fr, col0 = u.pn * 128 + wc * 32 + 8 * fq;
        float rs8[8];
#pragma unroll
        for (int i = 0; i < 8; ++i) rs8[i] = RSTD[row0 + (i >> 2) * HALF + (i & 3) * 16];
#pragma unroll
        for (int ai = 0; ai < 2; ++ai)
#pragma unroll
            for (int m = 0; m < 4; ++m) {
                const int row = row0 + ai * HALF + m * 16;
                const float rs = rs8[ai * 4 + m];
                float h[8];
#pragma unroll
                for (int n = 0; n < 2; ++n)
#pragma unroll
                    for (int j = 0; j < 4; ++j) { const float g = acc[ai][0][m][n][j] * rs, up = acc[ai][1][m][n][j] * rs; h[n * 4 + j] = silu_f(g) * up; }
                u32x4 w; w.x = cvt_pk_bf16(h[0], h[1]); w.y = cvt_pk_bf16(h[2], h[3]); w.z = cvt_pk_bf16(h[4], h[5]); w.w = cvt_pk_bf16(h[6], h[7]);
                if (ldh) *(u32x4*)(H + (size_t)row * ldh + col0) = w;
                else *(u32x4*)(H + ((size_t)((row >> 8) * nkt + (col0 >> 6)) * 256 + (row & 255)) * 64 + (col0 & 63)) = w;
            }
    }
};

struct EpiResid {
    static constexpr bool PERM = false, AFTER_DRAIN = false;
    const bf16_t* RB; float* D0;
    const float* RX; float* DX;
    bf16_t* HB; float* SS; float scale; unsigned long long* gran;
    __device__ __forceinline__ void operator()(const f32x4 (&acc)[2][2][4][2], const Unit& u, int wr, int wc, int fr, int fq) const {
        const int col0 = u.pn * BM + wc * 32 + 4 * fq;
        if (u.pm < 64) {
            const bf16_t* rb = RB + (size_t)u.pm * BM * 1024; float* db = D0 ? D0 + (size_t)u.pm * BM * 1024 : nullptr;
            u32x2 rn[2][2];
            { const size_t off0 = (size_t)(wr * 64 + fr) * 1024 + col0;
#pragma unroll
              for (int bj = 0; bj < 2; ++bj)
#pragma unroll
                  for (int n = 0; n < 2; ++n) rn[bj][n] = *(const u32x2*)(rb + off0 + bj * HALF + n * 16); }
#pragma unroll
            for (int ai = 0; ai < 2; ++ai)
#pragma unroll
                for (int m = 0; m < 4; ++m) {
                    int lrow = ai * HALF + wr * 64 + m * 16 + fr;
                    asm volatile("" : "+v"(lrow));
                    const size_t off = (size_t)lrow * 1024 + col0;
                    u32x2 rc[2][2];
#pragma unroll
                    for (int bj = 0; bj < 2; ++bj)
#pragma unroll
                        for (int n = 0; n < 2; ++n) rc[bj][n] = rn[bj][n];
                    if (ai * 4 + m < 7) { const int nx = ai * 4 + m + 1; int lnx = (nx >> 2) * HALF + wr * 64 + (nx & 3) * 16 + fr; asm volatile("" : "+v"(lnx));
                        const size_t offn = (size_t)lnx * 1024 + col0;
#pragma unroll
                        for (int bj = 0; bj < 2; ++bj)
#pragma unroll
                            for (int n = 0; n < 2; ++n) rn[bj][n] = *(const u32x2*)(rb + offn + bj * HALF + n * 16); }
                    float sq = 0.f;
#pragma unroll
                    for (int bj = 0; bj < 2; ++bj)
#pragma unroll
                        for (int n = 0; n < 2; ++n) {
                            const u32x2 rr = rc[bj][n];
                            const f32x4 r = (f32x4){__builtin_bit_cast(float, rr.x << 16), __builtin_bit_cast(float, rr.x & 0xffff0000u), __builtin_bit_cast(float, rr.y << 16), __builtin_bit_cast(float, rr.y & 0xffff0000u)};
                            const f32x4 o = r + acc[ai][bj][m][n] * scale;
                            if (db) *(f32x4*)(db + off + bj * HALF + n * 16) = o;
                            sq += (o[0] * o[0] + o[1] * o[1]) + (o[2] * o[2] + o[3] * o[3]);
                            if (HB) { u32x2 w; w.x = cvt_pk_bf16(o[0], o[1]); w.y = cvt_pk_bf16(o[2], o[3]); *(u32x2*)(HB + ((size_t)u.pm * BM + lrow) * 1024 + col0 + bj * HALF + n * 16) = w; }
                        }
                    sq += __shfl_xor(sq, 16); sq += __shfl_xor(sq, 32);
                    if (fq == 0) { if (gran) __hip_atomic_store(gran + ((size_t)u.pm * BM + lrow) * 16 + u.pn * 4 + wc, (1ull << 32) | (unsigned long long)__builtin_bit_cast(unsigned, sq), __ATOMIC_RELAXED, __HIP_MEMORY_SCOPE_AGENT);
                        else SS[((size_t)u.pm * BM + lrow) * 16 + u.pn * 4 + wc] = sq; }
                    asm volatile("" ::: "memory");
                }
        } else {
#pragma unroll
            for (int ai = 0; ai < 2; ++ai)
#pragma unroll
                for (int m = 0; m < 4; ++m) {
                    int lrow = ai * HALF + wr * 64 + m * 16 + fr;
                    asm volatile("" : "+v"(lrow));
                    const size_t off = (size_t)lrow * 1024 + col0;
                    float sq = 0.f;
#pragma unroll
                    for (int bj = 0; bj < 2; ++bj)
#pragma unroll
                        for (int n = 0; n < 2; ++n) {
                            const f32x4 o = *(const f32x4*)(RX + off + bj * HALF + n * 16) + acc[ai][bj][m][n] * scale;
                            *(f32x4*)(DX + off + bj * HALF + n * 16) = o;
                            sq += (o[0] * o[0] + o[1] * o[1]) + (o[2] * o[2] + o[3] * o[3]);
                            if (HB) { u32x2 w; w.x = cvt_pk_bf16(o[0], o[1]); w.y = cvt_pk_bf16(o[2], o[3]); *(u32x2*)(HB + ((size_t)u.pm * BM + lrow) * 1024 + col0 + bj * HALF + n * 16) = w; }
                        }
                    sq += __shfl_xor(sq, 16); sq += __shfl_xor(sq, 32);
                    if (fq == 0) SS[((size_t)u.pm * BM + lrow) * 16 + u.pn * 4 + wc] = sq;
                    asm volatile("" ::: "memory");
                }
        }
    }
};

struct EpiInproj {
    static constexpr bool PERM = true, AFTER_DRAIN = false;
    const float* RSTD; bf16_t* QZ; float* FZ; bf16_t* VB; bf16_t* GB; bf16_t* XBC; float* DT;
    const float* hgn; const float* dtb; float* convp; float* convs;
    __device__ __forceinline__ void operator()(const f32x4 (&acc)[2][2][4][2], const Unit& u, int wr, int wc, int fr, int fq) const {
        const int type = u.pn;
        const int row0 = u.pm * BM + wr * 64 + fr;
        float rs8[8];
#pragma unroll
        for (int i = 0; i < 8; ++i) rs8[i] = RSTD[row0 + (i >> 2) * HALF + (i & 3) * 16];
#pragma unroll
        for (int ai = 0; ai < 2; ++ai)
#pragma unroll
            for (int m = 0; m < 4; ++m) {
                const int row = row0 + ai * HALF + m * 16;
                const float rs = rs8[ai * 4 + m];
#pragma unroll
                for (int bj = 0; bj < 2; ++bj) {
                    const int c0 = 128 * bj + 32 * wc + 8 * fq;
                    float v[8];
#pragma unroll
                    for (int n = 0; n < 2; ++n)
#pragma unroll
                        for (int j = 0; j < 4; ++j) v[n * 4 + j] = acc[ai][bj][m][n][j] * rs;
                    if (type < 2 || (type >= 8 && type < 10)) {
                        const int col = (type < 2 ? 256 * type : 512 + 256 * (type - 8)) + c0;
#pragma unroll
                        for (int j = 0; j < 8; ++j) v[j] = silu_f(v[j]);
                        u32x4 w; w.x = cvt_pk_bf16(v[0], v[1]); w.y = cvt_pk_bf16(v[2], v[3]); w.z = cvt_pk_bf16(v[4], v[5]); w.w = cvt_pk_bf16(v[6], v[7]);
                        *(u32x4*)(QZ + (size_t)row * 1024 + col) = w;
                    } else if (type < 4) {
                        const int col = 256 * (type - 2) + c0;
                        *(f32x4*)(FZ + (size_t)row * 512 + col) = (f32x4){v[0], v[1], v[2], v[3]};
                        *(f32x4*)(FZ + (size_t)row * 512 + col + 4) = (f32x4){v[4], v[5], v[6], v[7]};
                    } else if (type < 6) {
                        const int col = 256 * (type - 4) + c0;
                        u32x4 w; w.x = cvt_pk_bf16(v[0], v[1]); w.y = cvt_pk_bf16(v[2], v[3]); w.z = cvt_pk_bf16(v[4], v[5]); w.w = cvt_pk_bf16(v[6], v[7]);
                        *(u32x4*)(VB + (size_t)row * 512 + col) = w;
                    } else if (type < 8) {
                        const int col = 256 * (type - 6) + c0;
                        const f32x4 n0 = *(const f32x4*)(hgn + col), n1 = *(const f32x4*)(hgn + col + 4);
#pragma unroll
                        for (int j = 0; j < 4; ++j) { v[j] = silu_f(v[j]) * n0[j]; v[4 + j] = silu_f(v[4 + j]) * n1[j]; }
                        u32x4 w; w.x = cvt_pk_bf16(v[0], v[1]); w.y = cvt_pk_bf16(v[2], v[3]); w.z = cvt_pk_bf16(v[4], v[5]); w.w = cvt_pk_bf16(v[6], v[7]);
                        *(u32x4*)(GB + (size_t)row * 512 + col) = w;
                    } else if (type < 14) {
                        const int col = 256 * (type - 10) + c0;
                        u32x4 w; w.x = cvt_pk_bf16(v[0], v[1]); w.y = cvt_pk_bf16(v[2], v[3]); w.z = cvt_pk_bf16(v[4], v[5]); w.w = cvt_pk_bf16(v[6], v[7]);
                        *(u32x4*)(XBC + (size_t)row * 1024 + col) = w;
                        float* cs = nullptr;
                        if (row < 16384) { const int t = row & 2047; if (t >= 2045) cs = convp + ((size_t)(row >> 11) * 3 + (t - 2045)) * 1024 + col; }
                        else if (row >= 16400 && row < 16528) cs = convs + ((size_t)(row - 16400) * 3 + 2) * 1024 + col;
                        if (cs) { *(f32x4*)cs = (f32x4){v[0], v[1], v[2], v[3]}; *(f32x4*)(cs + 4) = (f32x4){v[4], v[5], v[6], v[7]}; }
                    } else {
                        if (bj == 0 && wc == 0 && fq == 0) {
                            float d[8];
#pragma unroll
                            for (int j = 0; j < 8; ++j) { const float x = v[j] + dtb[j]; d[j] = x > 20.f ? x : log1pf(__expf(x)); }
                            *(f32x4*)(DT + (size_t)row * 8) = (f32x4){d[0], d[1], d[2], d[3]};
                            *(f32x4*)(DT + (size_t)row * 8 + 4) = (f32x4){d[4], d[5], d[6], d[7]};
                        }
                    }
                }
            }
    }
};
template <class Epi, class Sched, bool ALIGN_EPI = false, bool SP2 = false>
__device__ __forceinline__ void gemm_phase(PG8_LAS unsigned char* lds, const Gemm g, const Sched& S, const Epi& E, float* slab) {
    int tid_ = threadIdx.x; asm volatile("" : "+v"(tid_));
    const int tid = tid_, wid = __builtin_amdgcn_readfirstlane(tid >> 6), lane = tid & 63, wr = wid >> 2, wc = wid & 3, fr = lane & 15, fq = lane >> 4;
    const int K = g.K;
    unsigned voffA[2], voffB[2]; int aoff, boff;
#define PG8_LANE_OFFSETS(T_) do { _Pragma("unroll") for (int i = 0; i < 2; ++i) { int R, C; stage_rc((T_) * 16 + i * 8192, R, C); const int Rb = Epi::PERM ? ((R & ~31) + perm32(R & 31)) : R; \
        voffA[i] = (unsigned)(R * (g.lda ? g.lda : BK) + C) * 2u; voffB[i] = (unsigned)(Rb * K + C) * 2u; } \
        aoff = lds_byte((((T_) >> 8) & 1) * 64 + ((T_) & 15), (((T_) >> 4) & 3) * 8); boff = lds_byte((((T_) >> 6) & 3) * 32 + ((T_) & 15), (((T_) >> 4) & 3) * 8); } while (0)
    PG8_LANE_OFFSETS(tid);
    const size_t kstep = (size_t)(BK * 2), kstepA = g.lda ? (size_t)(BK * 2) : (size_t)(BM * BK * 2);
    const size_t hstep = (size_t)HALF * K * 2, hstepA = g.lda ? (size_t)HALF * g.lda * 2 : (size_t)(HALF * BK * 2);
    const size_t tstep = 2 * hstep, tstepA = g.lda ? 2 * hstepA : (size_t)(K / BK) * (BM * BK * 2);
    const unsigned ldsw = (unsigned)wid * 1024u;
#define PG8_SA(b, h) (((b) * 2 + (h)) * HTB)
#define PG8_SB(b, h) ((4 + (b) * 2 + (h)) * HTB)
#define PG8_STAGE(bufoff, gbase, voff) do { _Pragma("unroll") for (int _i = 0; _i < 2; ++_i) \
        __builtin_amdgcn_global_load_lds((const unsigned*)((const char*)(gbase) + (voff)[_i]), (PG8_LAS unsigned*)(lds + (bufoff) + ldsw + _i * 8192), 16, 0, 0); } while (0)
#define PG8_LDA(dst, b, h) do { _Pragma("unroll") for (int m = 0; m < 4; ++m) _Pragma("unroll") for (int k = 0; k < 2; ++k) dst[m][k] = *(const PG8_LAS bf16x8*)(lds + PG8_SA(b, h) + aoff + m * 2048 + k * 1024); } while (0)
#define PG8_LDB(dst, b, h) do { _Pragma("unroll") for (int n = 0; n < 2; ++n) _Pragma("unroll") for (int k = 0; k < 2; ++k) dst[n][k] = *(const PG8_LAS bf16x8*)(lds + PG8_SB(b, h) + boff + n * 2048 + k * 1024); } while (0)
#define PG8_MMA(ai, bj, At, Bt) do { __builtin_amdgcn_s_setprio(1); _Pragma("unroll") for (int m = 0; m < 4; ++m) _Pragma("unroll") for (int n = 0; n < 2; ++n) _Pragma("unroll") for (int k = 0; k < 2; ++k) \
        acc[ai][bj][m][n] = __builtin_amdgcn_mfma_f32_16x16x32_bf16(Bt[n][k], At[m][k], acc[ai][bj][m][n], 0, 0, 0); __builtin_amdgcn_s_setprio(0); } while (0)
#define PG8_WAIT_V(n) asm volatile("s_waitcnt vmcnt(" #n ")" ::: "memory")
#define PG8_WAIT_L(n) asm volatile("s_waitcnt lgkmcnt(" #n ")" ::: "memory")
#define PG8_BAR __builtin_amdgcn_s_barrier()
#define PG8_SCHED __builtin_amdgcn_sched_barrier(0)
    Unit cur, nxt; int ui = 0;
    if (!S.next(0, cur)) return;
    f32x4 acc[2][2][4][2];
#pragma unroll
    for (int a = 0; a < 2; ++a)
#pragma unroll
        for (int b = 0; b < 2; ++b)
#pragma unroll
            for (int m = 0; m < 4; ++m)
#pragma unroll
                for (int n = 0; n < 2; ++n) acc[a][b][m][n] = (f32x4){0.f, 0.f, 0.f, 0.f};
    bf16x8 At[4][2], B0[2][2], B1[2][2];
    const char* cA = (const char*)g.A + (size_t)cur.pm * tstepA + (size_t)cur.k0 * kstepA; const char* cB = (const char*)g.Bt + (size_t)cur.pn * tstep + (size_t)cur.k0 * kstep;
    if constexpr (SP2) {
        PG8_STAGE(PG8_SB(0, 0), cB, voffB); PG8_STAGE(PG8_SB(0, 1), cB + hstep, voffB); PG8_STAGE(PG8_SA(0, 0), cA, voffA); PG8_STAGE(PG8_SA(0, 1), cA + hstepA, voffA);
        if (wr == 1) PG8_BAR;
        PG8_WAIT_V(2); PG8_BAR;
        PG8_STAGE(PG8_SB(1, 0), cB + kstep, voffB); PG8_STAGE(PG8_SA(1, 0), cA + kstepA, voffA); PG8_STAGE(PG8_SB(1, 1), cB + hstep + kstep, voffB);
        PG8_WAIT_V(6); PG8_BAR;
    } else {
        PG8_STAGE(PG8_SB(0, 0), cB, voffB); PG8_STAGE(PG8_SA(0, 0), cA, voffA); PG8_STAGE(PG8_SB(0, 1), cB + hstep, voffB); PG8_STAGE(PG8_SA(0, 1), cA + hstepA, voffA);
        if (wr == 1) PG8_BAR;
        PG8_WAIT_V(4); PG8_BAR;
        PG8_STAGE(PG8_SB(1, 0), cB + kstep, voffB); PG8_STAGE(PG8_SA(1, 0), cA + kstepA, voffA); PG8_STAGE(PG8_SB(1, 1), cB + hstep + kstep, voffB);
        PG8_WAIT_V(6); PG8_BAR;
    }
    for (;;) {
        const bool has_next = S.next(ui + 1, nxt);
        const char* nA = has_next ? (const char*)g.A + (size_t)nxt.pm * tstepA + (size_t)nxt.k0 * kstepA : cA; const char* nB = has_next ? (const char*)g.Bt + (size_t)nxt.pn * tstep + (size_t)nxt.k0 * kstep : cB;
        const int nt = cur.nt;
        for (int t = 0; t < nt; t += 2) {
            const bool last = (t == nt - 2);
            const char* a1 = cA + (size_t)(t + 1) * kstepA;
            const char* a2 = last ? nA : cA + (size_t)(t + 2) * kstepA; const char* b2 = last ? nB : cB + (size_t)(t + 2) * kstep;
            const char* a3 = a2 + kstepA; const char* b3 = b2 + kstep;
            if constexpr (SP2) {
            PG8_LDB(B0, 0, 0); PG8_LDB(B1, 0, 1); PG8_SCHED; PG8_LDA(At, 0, 0); PG8_STAGE(PG8_SA(1, 1), a1 + hstepA, voffA);
            PG8_WAIT_V(8); PG8_WAIT_L(0); PG8_BAR; PG8_MMA(0, 0, At, B0); PG8_MMA(0, 1, At, B1); PG8_BAR; PG8_SCHED;
            PG8_LDA(At, 0, 1); PG8_STAGE(PG8_SB(0, 0), b2, voffB); PG8_STAGE(PG8_SB(0, 1), b2 + hstep, voffB); PG8_STAGE(PG8_SA(0, 0), a2, voffA);
            PG8_WAIT_V(8); PG8_WAIT_L(0); PG8_BAR; PG8_MMA(1, 0, At, B0); PG8_MMA(1, 1, At, B1); PG8_BAR; PG8_SCHED;
            PG8_LDB(B0, 1, 0); PG8_LDB(B1, 1, 1); PG8_SCHED; PG8_LDA(At, 1, 0); PG8_STAGE(PG8_SA(0, 1), a2 + hstepA, voffA);
            PG8_WAIT_V(8); PG8_WAIT_L(0); PG8_BAR; PG8_MMA(0, 0, At, B0); PG8_MMA(0, 1, At, B1); PG8_BAR; PG8_SCHED;
            PG8_LDA(At, 1, 1); PG8_STAGE(PG8_SB(1, 0), b3, voffB); PG8_STAGE(PG8_SB(1, 1), b3 + hstep, voffB); PG8_STAGE(PG8_SA(1, 0), a3, voffA);
            PG8_WAIT_V(8); PG8_WAIT_L(0); PG8_BAR; PG8_MMA(1, 0, At, B0); PG8_MMA(1, 1, At, B1); PG8_BAR; PG8_SCHED;
            } else {
            PG8_LDB(B0, 0, 0); PG8_SCHED; PG8_LDA(At, 0, 0); PG8_STAGE(PG8_SA(1, 1), a1 + hstepA, voffA);
            PG8_WAIT_L(8); PG8_BAR; PG8_WAIT_L(0); PG8_MMA(0, 0, At, B0); PG8_BAR; PG8_SCHED;
            PG8_LDB(B1, 0, 1); PG8_STAGE(PG8_SB(0, 0), b2, voffB);
            PG8_BAR; PG8_WAIT_L(0); PG8_MMA(0, 1, At, B1); PG8_BAR;
            PG8_LDA(At, 0, 1); PG8_STAGE(PG8_SA(0, 0), a2, voffA);
            PG8_BAR; PG8_WAIT_L(0); PG8_MMA(1, 0, At, B0); PG8_BAR; PG8_SCHED;
            PG8_STAGE(PG8_SB(0, 1), b2 + hstep, voffB);
            PG8_WAIT_V(6); PG8_BAR; PG8_MMA(1, 1, At, B1); PG8_BAR;
            PG8_LDB(B0, 1, 0); PG8_SCHED; PG8_LDA(At, 1, 0); PG8_STAGE(PG8_SA(0, 1), a2 + hstepA, voffA);
            PG8_WAIT_L(8); PG8_BAR; PG8_WAIT_L(0); PG8_MMA(0, 0, At, B0); PG8_BAR; PG8_SCHED;
            PG8_LDB(B1, 1, 1); PG8_STAGE(PG8_SB(1, 0), b3, voffB);
            PG8_BAR; PG8_WAIT_L(0); PG8_MMA(0, 1, At, B1); PG8_BAR;
            PG8_LDA(At, 1, 1); PG8_STAGE(PG8_SA(1, 0), a3, voffA);
            PG8_BAR; PG8_WAIT_L(0); PG8_MMA(1, 0, At, B0); PG8_BAR; PG8_SCHED;
            PG8_STAGE(PG8_SB(1, 1), b3 + hstep, voffB);
            PG8_WAIT_V(6); PG8_BAR; PG8_MMA(1, 1, At, B1); PG8_BAR;
            }
        }
        if constexpr (ALIGN_EPI) { if (wr == 0) PG8_BAR; }
        if (cur.kind == 1) {
            float* sb = slab + (size_t)cur.slot * 65536;
#pragma unroll
            for (int a = 0; a < 2; ++a)
#pragma unroll
                for (int m = 0; m < 4; ++m) {
                    int lrow = a * HALF + wr * 64 + m * 16 + fr; asm volatile("" : "+v"(lrow));
                    float* rp = sb + (size_t)lrow * 256 + wc * 32 + 4 * fq;
#pragma unroll
                    for (int b = 0; b < 2; ++b)
#pragma unroll
                        for (int n = 0; n < 2; ++n) *(f32x4*)(rp + b * HALF + n * 16) = acc[a][b][m][n];
                }
        } else {
            E(acc, cur, wr, wc, fr, fq);
        }
        if (!has_next) break;
#pragma unroll
        for (int a = 0; a < 2; ++a)
#pragma unroll
            for (int b = 0; b < 2; ++b)
#pragma unroll
                for (int m = 0; m < 4; ++m)
#pragma unroll
                    for (int n = 0; n < 2; ++n) acc[a][b][m][n] = (f32x4){0.f, 0.f, 0.f, 0.f};
        cur = nxt; cA = nA; cB = nB; ++ui;
        if constexpr (ALIGN_EPI) { if (wr == 1) PG8_BAR; }
    }
    PG8_WAIT_V(0);
    if constexpr (!ALIGN_EPI) { if (wr == 0) PG8_BAR; }
    PG8_BAR;
#undef PG8_LANE_OFFSETS
#undef PG8_SA
#undef PG8_SB
#undef PG8_STAGE
#undef PG8_LDA
#undef PG8_LDB
#undef PG8_MMA
#undef PG8_WAIT_V
#undef PG8_WAIT_L
#undef PG8_BAR
#undef PG8_SCHED
}
}
constexpr int NWAVES = 8;
constexpr int D = 1024, NBATCH = 8, SEQ = 2048, NMETA = 16, NSMP = 128, FF = 2816;
constexpr int MP = NBATCH * SEQ;
constexpr int ROW_META = MP, ROW_SMP = MP + NMETA;
constexpr int M = 16640;
constexpr int NIN = 3592, NINP = 3840;
constexpr int LDH = 0;
constexpr int CH = 64, NCH = SEQ / CH;
constexpr float EPS = 1e-6f;
constexpr size_t O_YP = 0, O_YS = O_YP + (size_t)MP * D, O_HGP = O_YS + (size_t)NSMP * D, O_SSP = O_HGP + (size_t)NBATCH * 4 * 128 * 128, O_CVP = O_SSP + (size_t)NBATCH * 8 * 64 * 128,
                 O_HGS = O_CVP + (size_t)NBATCH * 3 * 1024, O_SSS = O_HGS + (size_t)NSMP * 4 * 128 * 128, O_CVS = O_SSS + (size_t)NSMP * 8 * 64 * 128, O_END = O_CVS + (size_t)NSMP * 3 * 1024;
constexpr size_t KiB = 1024, MiB = 1u << 20;
constexpr size_t WS_CTL = 0, CTL_ZERO_BYTES = 1 * MiB;
constexpr size_t WS_WGU1 = 1 * MiB, WS_WD1 = 12 * MiB, WS_WIN = 17 * MiB + 512 * KiB, WS_WOUT = 25 * MiB, WS_WGU2 = 27 * MiB, WS_WD2 = 38 * MiB;
constexpr size_t WS_HB = 44 * MiB;
constexpr size_t WS_R = 77 * MiB;
constexpr size_t WS_H = WS_R;
constexpr size_t WS_QZ = 77 * MiB;
constexpr size_t WS_FZ = 110 * MiB;
constexpr size_t WS_VB = 143 * MiB;
constexpr size_t WS_GB = 160 * MiB;
constexpr size_t WS_XBC = 177 * MiB;
constexpr size_t WS_UM = 210 * MiB;
constexpr size_t WS_DT = 243 * MiB;
constexpr size_t WS_ER = 244 * MiB, WS_EL = 245 * MiB;
constexpr size_t WS_DCY = 246 * MiB;
constexpr size_t WS_LB = 246 * MiB + 512 * KiB;
constexpr size_t WS_HX0 = 247 * MiB, WS_HX = 248 * MiB;
constexpr size_t WS_SS1 = 249 * MiB, WS_SS2 = 250 * MiB + 256 * KiB, WS_SS3 = 251 * MiB + 512 * KiB, WS_SS4 = 252 * MiB + 768 * KiB;
constexpr size_t WS_END = 256 * MiB;
constexpr size_t UTH_ENT = 128 * 128;
constexpr size_t UM_ENT = 64 * 128;
static_assert(WS_HB + (size_t)M * 1024 * 2 <= WS_R && (1024 + 4) * UTH_ENT * 2 <= (size_t)MP * D * 4, "hb / UTH (in the y_prompt output region)");
static_assert(WS_H + (size_t)M * FF * 2 <= WS_XBC && WS_QZ + (size_t)M * 2048 <= WS_FZ && WS_FZ + (size_t)M * 2048 <= WS_VB && WS_VB + (size_t)M * 1024 <= WS_GB && WS_GB + (size_t)M * 1024 <= WS_XBC, "map 1");
static_assert(WS_XBC + (size_t)M * 2048 <= WS_UM && WS_UM + (2048 + 8) * UM_ENT * 2 <= WS_DT && WS_DT + (size_t)M * 32 <= WS_ER && WS_SS4 + (size_t)M * 64 <= WS_END, "map 2");
constexpr int CW_BAR = 4096;
constexpr int RING_BYTES = 131072, LDSCTL_OFF = RING_BYTES, MISC_OFF = LDSCTL_OFF + 320, LDS_BYTES = 147456;

#define GAS __attribute__((address_space(1)))
#define LAS __attribute__((address_space(3)))
typedef unsigned short bf16;
typedef unsigned v4u __attribute__((ext_vector_type(4)));
typedef float f32x4 __attribute__((ext_vector_type(4)));
typedef float f32x16 __attribute__((ext_vector_type(16)));
typedef short bf16x8 __attribute__((ext_vector_type(8)));
typedef GAS unsigned gu32;
#define RLX_AGENT __ATOMIC_RELAXED, __HIP_MEMORY_SCOPE_AGENT
#define LDS_WAIT() asm volatile("s_waitcnt lgkmcnt(0)" ::: "memory")
#define VM_WAIT() asm volatile("s_waitcnt vmcnt(0)" ::: "memory")
typedef __bf16 bf16x2_t __attribute__((ext_vector_type(2)));
__device__ __forceinline__ unsigned pk2(float lo, float hi) { bf16x2_t v; v.x = (__bf16)lo; v.y = (__bf16)hi; return __builtin_bit_cast(unsigned, v); }
__device__ __forceinline__ unsigned f2bf(float f) { return (unsigned)__builtin_bit_cast(unsigned short, (__bf16)f); }
__device__ __forceinline__ float bf2f(unsigned short b) { return __builtin_bit_cast(float, (unsigned)b << 16); }
__device__ __forceinline__ float sigm(float x) { return __builtin_amdgcn_rcpf(1.0f + __expf(-x)); }
__device__ __forceinline__ float silu(float x) { return x * __builtin_amdgcn_rcpf(1.0f + __expf(-x)); }
#define XB_TMO      128
#define XB_XCNT(j)  (256  + 64 * (j))
#define XB_XSUB(j)  (1280 + 64 * (j))
#define XB_XGEN(j)  (2304 + 64 * (j))
#define XB_TOP      3328
#define XB_TOPGEN   3392
#define XCD_BAR_WORDS 3456
#define XB_SPIN_CAP (1u << 18)

__device__ __forceinline__ unsigned xb_ld(unsigned* p)              { return __hip_atomic_load(p, __ATOMIC_RELAXED, __HIP_MEMORY_SCOPE_AGENT); }
__device__ __forceinline__ unsigned xb_add(unsigned* p, unsigned v) { return __hip_atomic_fetch_add(p, v, __ATOMIC_RELAXED, __HIP_MEMORY_SCOPE_AGENT); }
__device__ __forceinline__ unsigned xb_xcc_id() { return (unsigned)__builtin_amdgcn_s_getreg((3 << 11) | 20) & 0xFu; }
#define XB_SPIN(cond, bar) do { unsigned _sp = 0; while (cond) { __builtin_amdgcn_s_sleep(1); \
    if ((++_sp & 255u) == 0u) { if (xb_ld(&(bar)[XB_TMO])) break; if (_sp > XB_SPIN_CAP) { atomicAdd(&(bar)[XB_TMO], 1u); break; } } } } while (0)

struct XcdBarrier {
    unsigned* bar; unsigned x;
    volatile LAS unsigned* st;
};

__device__ __forceinline__ XcdBarrier xcd_barrier_post(unsigned* bar, volatile LAS unsigned* st) {
    XcdBarrier b; b.bar = bar; b.x = xb_xcc_id(); b.st = st;
    if (threadIdx.x == 0) (void)xb_add(&bar[XB_XCNT(b.x)], 1u);
    return b;
}
__device__ __forceinline__ void xcd_barrier_complete(unsigned* bar, unsigned x, unsigned& nloc, unsigned& nx) {
    const unsigned G = gridDim.x * gridDim.y * gridDim.z;
    unsigned sum, cnt, mine, sp = 0u;
    for (;;) {
        sum = 0u; cnt = 0u; mine = 0u;
#pragma unroll
        for (unsigned j = 0; j < 16; ++j) { const unsigned c = xb_ld(&bar[XB_XCNT(j)]); sum += c; cnt += (c > 0u) ? 1u : 0u; mine = (j == x) ? c : mine; }
        if (sum == G) break;
        __builtin_amdgcn_s_sleep(1);
        if ((++sp & 255u) == 0u) { if (xb_ld(&bar[XB_TMO])) break; if (sp > XB_SPIN_CAP) { atomicAdd(&bar[XB_TMO], 1u); break; } }
    }
    nloc = mine > 0u ? mine : 1u; nx = cnt > 0u ? cnt : 1u;
}

__device__ __forceinline__ void xcd_barrier(const XcdBarrier& b) {
    asm volatile("s_waitcnt vmcnt(0)" ::: "memory");
    __syncthreads();
    if (threadIdx.x == 0) {
        unsigned* bar = b.bar;
        __builtin_amdgcn_s_waitcnt(0);
        unsigned nloc = b.st[0], nx = b.st[1];
        if (nloc == 0u) { xcd_barrier_complete(bar, b.x, nloc, nx); b.st[0] = nloc; b.st[1] = nx; }
        const unsigned old = xb_add(&bar[XB_XSUB(b.x)], 1u);
        const unsigned gen = old / nloc;
        if (old + 1u == (gen + 1u) * nloc) {
            __builtin_amdgcn_fence(__ATOMIC_RELEASE, "agent");
            asm volatile("s_waitcnt vmcnt(0)" ::: "memory");
            const unsigned og = xb_add(&bar[XB_TOP], 1u);
            const unsigned tg = og / nx;
            if (og + 1u == (tg + 1u) * nx) xb_add(&bar[XB_TOPGEN], 1u);
            else XB_SPIN(xb_ld(&bar[XB_TOPGEN]) == tg, bar);
            __builtin_amdgcn_fence(__ATOMIC_ACQUIRE, "agent");
            xb_add(&bar[XB_XGEN(b.x)], 1u);
            asm volatile("s_waitcnt vmcnt(0)" ::: "memory");
        } else {
            XB_SPIN(xb_ld(&bar[XB_XGEN(b.x)]) == gen, bar);
            __builtin_amdgcn_fence(__ATOMIC_ACQUIRE, "agent");
            asm volatile("s_waitcnt vmcnt(0)" ::: "memory");
        }
    }
    __syncthreads();
}
struct Frame {
    LAS unsigned char* lds;
    volatile LAS unsigned* MISC;
    gu32* ctl;
    int tid, lane, wave, vcu, G;
    GAS float* out; GAS unsigned char* ws;
};
#define WSP(T, off) ((T*)(F.ws + (off)))
#define OUTP(off) ((float*)(F.out + (off)))
#define UTHP ((bf16*)OUTP(O_YP))
constexpr int TAB_OFF = MISC_OFF + 256;
__device__ __forceinline__ const float* inp(const Frame& F, int k) {
    const unsigned long long v = ((const LAS unsigned long long*)(F.lds + TAB_OFF))[k];
    const unsigned lo = __builtin_amdgcn_readfirstlane((unsigned)v), hi = __builtin_amdgcn_readfirstlane((unsigned)(v >> 32));
    return (const float*)(const GAS float*)(((unsigned long long)hi << 32) | lo);
}
__device__ __forceinline__ float wave_sum(float v) {
#pragma unroll
    for (int o = 1; o < 64; o <<= 1) v += __shfl_xor(v, o);
    return v;
}
__device__ __forceinline__ float half_sum32(float v) {
#pragma unroll
    for (int o = 1; o < 32; o <<= 1) v += __shfl_xor(v, o);
    return v;
}
__device__ __forceinline__ float rowsum16(const float (&v)[16], int lane, int& rsel) {
    const bool b4 = (lane & 16) != 0, b3 = (lane & 8) != 0, b2 = (lane & 4) != 0, b1 = (lane & 2) != 0;
    float a[8], b[4], c2[2];
#pragma unroll
    for (int j = 0; j < 8; ++j) { const float t = __shfl_xor(b4 ? v[j] : v[j + 8], 16); a[j] = (b4 ? v[j + 8] : v[j]) + t; }
#pragma unroll
    for (int j = 0; j < 4; ++j) { const float t = __shfl_xor(b3 ? a[j] : a[j + 4], 8); b[j] = (b3 ? a[j + 4] : a[j]) + t; }
#pragma unroll
    for (int j = 0; j < 2; ++j) { const float t = __shfl_xor(b2 ? b[j] : b[j + 2], 4); c2[j] = (b2 ? b[j + 2] : b[j]) + t; }
    float d = (b1 ? c2[1] : c2[0]) + __shfl_xor(b1 ? c2[0] : c2[1], 2);
    d += __shfl_xor(d, 1);
    rsel = (b4 ? 8 : 0) + (b3 ? 4 : 0) + (b2 ? 2 : 0) + (b1 ? 1 : 0);
    return d;
}
__device__ __forceinline__ void tr_item(const float* W, int N, int K, int k0, int n0, const float* nw, bf16* dst, LAS float* scr, int lane) {
    float v[32];
    const int n = n0 + (lane & 31);
#pragma unroll
    for (int i = 0; i < 32; ++i) { const int kk = 2 * i + (lane >> 5); v[i] = (n < N) ? W[(size_t)(k0 + kk) * N + n] : 0.f; }
    if (nw) {
#pragma unroll
        for (int i = 0; i < 32; ++i) v[i] *= nw[k0 + 2 * i + (lane >> 5)];
    }
#pragma unroll
    for (int i = 0; i < 32; ++i) scr[(2 * i + (lane >> 5)) * 33 + (lane & 31)] = v[i];
    LDS_WAIT(); asm volatile("" ::: "memory");
    const int c = lane & 7;
#pragma unroll
    for (int j = 0; j < 4; ++j) { const int nn = (lane >> 3) + 8 * j; const LAS float* s = scr + (8 * c) * 33 + nn;
        v4u o; o.x = pk2(s[0 * 33], s[1 * 33]); o.y = pk2(s[2 * 33], s[3 * 33]); o.z = pk2(s[4 * 33], s[5 * 33]); o.w = pk2(s[6 * 33], s[7 * 33]);
        *(GAS v4u*)(dst + (size_t)nn * K + k0 + 8 * c) = o; }
    LDS_WAIT(); asm volatile("" ::: "memory");
}
__device__ __forceinline__ void p0_prologue(Frame& F) {
    LAS float* scr = (LAS float*)(F.lds + F.wave * 16384);
    const int gw = F.vcu * NWAVES + F.wave, NGW = F.G * NWAVES, lane = F.lane;
    constexpr int I_GU = 16 * 88, I_DN = 44 * 32, I_IN = 16 * 120, I_OUT = 16 * 32;
    constexpr int NITEMS = 6 * I_GU + I_IN + I_OUT;
    static_assert(I_DN == I_GU, "items");
    for (int it = gw; it < NITEMS; it += NGW) {
        int r = it;
        if (r < 6 * I_GU) {
            const int which = r / I_GU; r -= which * I_GU;
            const int ffn = which / 3, kind = which % 3;
            if (kind < 2) {
                const int kb = r / 88, nb = r % 88, n0 = 32 * nb, k0 = 64 * kb;
                const float* W = ffn ? (kind ? inp(F, 23) : inp(F, 22)) : (kind ? inp(F, 9) : inp(F, 8)); const float* nw = ffn ? inp(F, 21) : inp(F, 7);
                bf16* base = WSP(bf16, ffn ? WS_WGU2 : WS_WGU1);
                const int drow = 256 * (n0 >> 7) + (n0 & 127) + 128 * kind;
                tr_item(W, FF, 1024, k0, n0, nw, base + (size_t)drow * 1024, scr, lane);
            } else {
                const int kb = r / 32, nb = r % 32, n0 = 32 * nb, k0 = 64 * kb;
                const float* W = ffn ? inp(F, 24) : inp(F, 10);
                bf16* base = WSP(bf16, ffn ? WS_WD2 : WS_WD1);
                tr_item(W, 1024, FF, k0, n0, nullptr, base + (size_t)n0 * FF, scr, lane);
            }
            continue;
        }
        r -= 6 * I_GU;
        if (r < I_IN) { const int kb = r / 120, nb = r % 120, n0 = 32 * nb, k0 = 64 * kb;
            tr_item(inp(F, 12), NIN, 1024, k0, n0, inp(F, 11), WSP(bf16, WS_WIN) + (size_t)n0 * 1024, scr, lane); continue; }
        r -= I_IN;
        { const int kb = r / 32, nb = r % 32, n0 = 32 * nb, k0 = 64 * kb;
          tr_item(inp(F, 20), 1024, 1024, k0, n0, nullptr, WSP(bf16, WS_WOUT) + (size_t)n0 * 1024, scr, lane); }
    }
    bf16* HB = WSP(bf16, WS_HB); float* RS1 = WSP(float, WS_SS1); float* HX0 = WSP(float, WS_HX0);
    {
        const float* x0 = inp(F, 0); const float* xm = inp(F, 5); const float* xs = inp(F, 1);
#define ROWSRC(m) ((m) < MP ? x0 + (size_t)(m) * D : (m) < ROW_SMP ? xm + (size_t)((m) - ROW_META) * D : (m) < ROW_SMP + NSMP ? xs + (size_t)((m) - ROW_SMP) * D : nullptr)
        f32x4 nx[4];
        { const float* src = gw < M ? ROWSRC(gw) : nullptr;
#pragma unroll
          for (int j = 0; j < 4; ++j) nx[j] = src ? ((const GAS f32x4*)src)[lane + 64 * j] : (f32x4){0.f, 0.f, 0.f, 0.f}; }
        for (int m = gw; m < M; m += NGW) {
            f32x4 v[4]; float s = 0.f;
#pragma unroll
            for (int j = 0; j < 4; ++j) v[j] = nx[j];
            { const int mn = m + NGW; const float* src = mn < M ? ROWSRC(mn) : nullptr;
#pragma unroll
              for (int j = 0; j < 4; ++j) nx[j] = src ? ((const GAS f32x4*)src)[lane + 64 * j] : (f32x4){0.f, 0.f, 0.f, 0.f}; }
#pragma unroll
            for (int j = 0; j < 4; ++j) s += (v[j][0] * v[j][0] + v[j][1] * v[j][1]) + (v[j][2] * v[j][2] + v[j][3] * v[j][3]);
            s = wave_sum(s);
            GAS unsigned long long* o8 = (GAS unsigned long long*)(HB + (size_t)m * D) + lane;
#pragma unroll
            for (int j = 0; j < 4; ++j) o8[64 * j] = (unsigned long long)pk2(v[j][0], v[j][1]) | ((unsigned long long)pk2(v[j][2], v[j][3]) << 32);
            if (lane == 0) RS1[m] = 1.0f / sqrtf(s * (1.0f / 1024.0f) + EPS);
            if (m >= MP) {
#pragma unroll
                for (int j = 0; j < 4; ++j) ((GAS f32x4*)(HX0 + (size_t)(m - MP) * D))[lane + 64 * j] = v[j];
            }
        }
#undef ROWSRC
    }
    if (gw == 0) { float* LB = WSP(float, WS_LB); const float* l = inp(F, 6);
        for (int c = lane; c < 512; c += 64) LB[c] = 1.0f / (1.0f + __expf(l[512 + c] - l[c])); }
}
template <int ppu> __device__ __forceinline__ void fix_extra(Frame& F, int split, const float* slab, const float* RX, float* DX, bf16* HB, const float* SS, float* RSTD, float scale) {
    const int lane = F.lane;
    if (split) {
        LAS float* red = (LAS float*)F.lds;
        for (int lr = F.vcu; lr < 256; lr += F.G) {
            if (F.wave < 4) {
                const int j = F.wave;
                const float* sp = slab + (size_t)j * ppu * 65536 + (size_t)lr * 256 + 4 * lane; f32x4 sum = (f32x4){0.f, 0.f, 0.f, 0.f};
#pragma unroll
                for (int p = 0; p < ppu; ++p) sum = sum + *(const GAS f32x4*)(sp + (size_t)p * 65536);
                const f32x4 v = ((const GAS f32x4*)(RX + (size_t)lr * 1024))[lane + 64 * j] + sum * scale;
                const float ss = wave_sum((v[0] * v[0] + v[1] * v[1]) + (v[2] * v[2] + v[3] * v[3]));
                ((GAS f32x4*)(DX + (size_t)lr * 1024))[lane + 64 * j] = v;
                ((GAS unsigned long long*)(HB + (size_t)(MP + lr) * 1024))[lane + 64 * j] = (unsigned long long)pk2(v[0], v[1]) | ((unsigned long long)pk2(v[2], v[3]) << 32);
                if (lane == 0) red[j] = ss;
            }
            __syncthreads();
            if (F.tid == 0) RSTD[MP + lr] = 1.0f / sqrtf(((red[0] + red[1]) + (red[2] + red[3])) * (1.0f / 1024.0f) + EPS);
            __syncthreads();
        }
    }
    const int gt = F.vcu * (NWAVES * 64) + F.tid, NT = F.G * NWAVES * 64, nrows = split ? MP : M;
    for (int r = gt; r < nrows; r += NT) RSTD[r] = pg8::row_rstd(SS, r);
}
template <int ppu> __device__ __forceinline__ void p8_final(Frame& F, int split, const float* slab) {
    const int gw = F.vcu * NWAVES + F.wave, NGW = F.G * NWAVES, lane = F.lane;
    const float* SS4 = WSP(float, WS_SS4); const float* nf = inp(F, 25);
    f32x4 w[4];
#pragma unroll
    for (int j = 0; j < 4; ++j) w[j] = ((const GAS f32x4*)nf)[lane + 64 * j];
    for (int m = split ? MP + gw : gw; m < MP + NSMP; m += NGW) {
        if (m < MP) {
            float* p = OUTP(O_YP) + (size_t)m * D;
            const float rs = pg8::row_rstd(SS4, m);
#pragma unroll
            for (int j = 0; j < 4; ++j) { f32x4 v = ((const GAS f32x4*)p)[lane + 64 * j]; v = v * rs * w[j]; ((GAS f32x4*)p)[lane + 64 * j] = v; }
        } else {
            const int s = m - MP, lr = NMETA + s; const float* src = WSP(float, WS_HX) + (size_t)lr * D; float* dst = OUTP(O_YS) + (size_t)s * D;
            f32x4 v[4]; float ss = 0.f;
#pragma unroll
            for (int j = 0; j < 4; ++j) { v[j] = ((const GAS f32x4*)src)[lane + 64 * j];
                if (split) { const float* sp = slab + (size_t)j * ppu * 65536 + (size_t)lr * 256 + 4 * lane; f32x4 sum = (f32x4){0.f, 0.f, 0.f, 0.f};
#pragma unroll
                    for (int p = 0; p < ppu; ++p) sum = sum + *(const GAS f32x4*)(sp + (size_t)p * 65536);
                    v[j] = v[j] + sum * 0.5f; }
                ss += (v[j][0] * v[j][0] + v[j][1] * v[j][1]) + (v[j][2] * v[j][2] + v[j][3] * v[j][3]); }
            const float rs = split ? 1.0f / sqrtf(wave_sum(ss) * (1.0f / 1024.0f) + EPS) : pg8::row_rstd(SS4, ROW_SMP + s);
#pragma unroll
            for (int j = 0; j < 4; ++j) ((GAS f32x4*)dst)[lane + 64 * j] = v[j] * rs * w[j];
        }
    }
}
__device__ __forceinline__ int rowreg(int reg, int lane) { return (reg & 3) + 8 * (reg >> 2) + 4 * (lane >> 5); }
template <int K> __device__ __forceinline__ void mma32_ll(f32x16& acc, const LAS bf16* A, int lda, const LAS bf16* B, int ldb, int lane) {
    const LAS bf16* pa = A + (lane & 31) * lda + 8 * (lane >> 5); const LAS bf16* pb = B + (lane & 31) * ldb + 8 * (lane >> 5);
#pragma unroll
    for (int k0 = 0; k0 < K; k0 += 16) { const bf16x8 a = *(const LAS bf16x8*)(pa + k0); const bf16x8 b = *(const LAS bf16x8*)(pb + k0); acc = __builtin_amdgcn_mfma_f32_32x32x16_bf16(a, b, acc, 0, 0, 0); }
}
template <int K> __device__ __forceinline__ void mma32_lg(f32x16& acc, const LAS bf16* A, int lda, const bf16* Bg, int ldb, int lane) {
    const LAS bf16* pa = A + (lane & 31) * lda + 8 * (lane >> 5); const bf16* pb = Bg + (size_t)(lane & 31) * ldb + 8 * (lane >> 5);
#pragma unroll
    for (int kc = 0; kc < K; kc += 64) {
        bf16x8 b[4];
#pragma unroll
        for (int k = 0; k < 4; ++k) b[k] = *(const GAS bf16x8*)(pb + kc + 16 * k);
#pragma unroll
        for (int k = 0; k < 4; ++k) { const bf16x8 a = *(const LAS bf16x8*)(pa + kc + 16 * k); acc = __builtin_amdgcn_mfma_f32_32x32x16_bf16(a, b[k], acc, 0, 0, 0); }
        asm volatile("" ::: "memory");
    }
}
__device__ __forceinline__ void load_frags8(const bf16* Bg, int ldb, int lane, bf16x8 (&b)[8]) {
    const bf16* pb = Bg + (size_t)(lane & 31) * ldb + 8 * (lane >> 5);
#pragma unroll
    for (int k = 0; k < 8; ++k) b[k] = *(const GAS bf16x8*)(pb + 16 * k);
}
__device__ __forceinline__ void mma32_lf8(f32x16& acc, const LAS bf16* A, int lda, const bf16x8 (&b)[8], int lane) {
    const LAS bf16* pa = A + (lane & 31) * lda + 8 * (lane >> 5);
#pragma unroll
    for (int k = 0; k < 8; ++k) { const bf16x8 a = *(const LAS bf16x8*)(pa + 16 * k); acc = __builtin_amdgcn_mfma_f32_32x32x16_bf16(a, b[k], acc, 0, 0, 0); }
}
#define ZERO16 ((f32x16){0.f,0.f,0.f,0.f,0.f,0.f,0.f,0.f,0.f,0.f,0.f,0.f,0.f,0.f,0.f,0.f})

struct HgP { int rowbase, h, nvalid, ent, eidx; };
__device__ __forceinline__ HgP hg_params(int i) {
    HgP p;
    if (i < 1024) { const int b = i >> 7, h = (i >> 5) & 3, c = i & 31; p.rowbase = b * SEQ + c * CH; p.h = h; p.nvalid = CH; p.ent = (b * 4 + h) * 32 + c; p.eidx = b * 32 + c; }
    else { const int h = i - 1024; p.rowbase = ROW_META; p.h = h; p.nvalid = NMETA; p.ent = 1024 + h; p.eidx = 256; }
    return p;
}
struct HgRaw { f32x4 fz[4]; v4u vb[2]; v4u qz[2]; v4u gb[2]; };
template <int PASS> __device__ __forceinline__ void hg_load(Frame& F, const HgP& p, HgRaw& r) {
    const int tid = F.tid;
    const float* FZ = WSP(float, WS_FZ) + (size_t)p.rowbase * 512 + 128 * p.h;
#pragma unroll
    for (int i = 0; i < 4; ++i) { const int idx = tid + 512 * i; r.fz[i] = *(const GAS f32x4*)(FZ + (size_t)(idx >> 5) * 512 + (idx & 31) * 4); }
    const bf16* VB = WSP(bf16, WS_VB) + (size_t)p.rowbase * 512 + 128 * p.h;
#pragma unroll
    for (int i = 0; i < 2; ++i) { const int idx = tid + 512 * i; r.vb[i] = *(const GAS v4u*)(VB + (size_t)(idx >> 4) * 512 + (idx & 15) * 8); }
    if (PASS == 3) { const bf16* QZ = WSP(bf16, WS_QZ) + (size_t)p.rowbase * 1024 + 128 * p.h;
#pragma unroll
        for (int i = 0; i < 2; ++i) { const int idx = tid + 512 * i; r.qz[i] = *(const GAS v4u*)(QZ + (size_t)(idx >> 4) * 1024 + (idx & 15) * 8); }
        const bf16* GB = WSP(bf16, WS_GB) + (size_t)p.rowbase * 512 + 128 * p.h;
#pragma unroll
        for (int i = 0; i < 2; ++i) { const int idx = tid + 512 * i; r.gb[i] = *(const GAS v4u*)(GB + (size_t)(idx >> 4) * 512 + (idx & 15) * 8); } }
}
template <int PASS> __device__ __forceinline__ void hgrn_item(Frame& F, const HgP p, HgRaw& raw, bool has_next, const HgP pn) {
    LAS unsigned char* L = F.lds;
    LAS float* TOT = (LAS float*)L;
    LAS float* FZL = (LAS float*)(L + 2048);
    LAS bf16* VL = (LAS bf16*)(L + 35840);
    LAS bf16* QN = (LAS bf16*)(L + 53248);
    LAS bf16* KN = (LAS bf16*)(L + 70656);
    LAS bf16* VT = (LAS bf16*)(L + 88064);
    LAS bf16* KT = (LAS bf16*)(L + 106496);
    LAS bf16* PP = (LAS bf16*)(L + 106496);
    LAS float* PART = (LAS float*)(L + 124928);
    LAS float* RS = (LAS float*)(L + 125952);
    const int tid = F.tid, lane = F.lane, w = F.wave, c = tid & 127, rg = tid >> 7;
    const int rowbase = p.rowbase, h = p.h;
#pragma unroll
    for (int i = 0; i < 4; ++i) { const int idx = tid + 512 * i; *(LAS f32x4*)(FZL + (idx >> 5) * 132 + (idx & 31) * 4) = raw.fz[i]; }
#pragma unroll
    for (int i = 0; i < 2; ++i) { const int idx = tid + 512 * i; *(LAS v4u*)(VL + (idx >> 4) * 136 + (idx & 15) * 8) = raw.vb[i]; if (PASS == 3) *(LAS v4u*)(QN + (idx >> 4) * 136 + (idx & 15) * 8) = raw.qz[i]; }
    v4u gbr[2]; if (PASS == 3) { gbr[0] = raw.gb[0]; gbr[1] = raw.gb[1]; }
    if (has_next) hg_load<PASS>(F, pn, raw);
    const float lbc = WSP(float, WS_LB)[128 * h + c];
    __syncthreads();
    float bl[16], kk[16], run = 0.f;
#pragma unroll
    for (int i = 0; i < 16; ++i) {
        const int t = rg * 16 + i; const float fz = FZL[t * 132 + c];
        const float sg = sigm(fz), f = lbc + (1.0f - lbc) * sg; float lf = __logf(f), k = (1.0f - lbc) * (1.0f - sg);
        if (t >= p.nvalid) { lf = 0.f; k = 0.f; }
        run += lf; bl[i] = run; kk[i] = k;
    }
    TOT[rg * 128 + c] = run;
    __syncthreads();
    const float t0 = TOT[c], t1 = TOT[128 + c], t2 = TOT[256 + c], t3 = TOT[384 + c];
    const float pre = rg == 0 ? 0.f : rg == 1 ? t0 : rg == 2 ? t0 + t1 : (t0 + t1) + t2;
    const float r = t0 + t1, blast = (t0 + t1) + (t2 + t3);
    unsigned pvv[8];
#pragma unroll
    for (int i = 0; i < 16; i += 2) pvv[i >> 1] = (unsigned)VL[(rg * 16 + i) * 136 + c] | ((unsigned)VL[(rg * 16 + i + 1) * 136 + c] << 16);
    *(LAS v4u*)(VT + c * 72 + rg * 16) = (v4u){pvv[0], pvv[1], pvv[2], pvv[3]}; *(LAS v4u*)(VT + c * 72 + rg * 16 + 8) = (v4u){pvv[4], pvv[5], pvv[6], pvv[7]};
    if (PASS == 1) {
        unsigned pkk[8];
#pragma unroll
        for (int i = 0; i < 16; i += 2) pkk[i >> 1] = pk2(kk[i] * __expf(r - (pre + bl[i])), kk[i + 1] * __expf(r - (pre + bl[i + 1])));
        *(LAS v4u*)(KT + c * 72 + rg * 16) = (v4u){pkk[0], pkk[1], pkk[2], pkk[3]}; *(LAS v4u*)(KT + c * 72 + rg * 16 + 8) = (v4u){pkk[4], pkk[5], pkk[6], pkk[7]};
        if (rg == 0) { WSP(float, WS_ER)[(size_t)p.eidx * 512 + 128 * h + c] = __expf(r); WSP(float, WS_EL)[(size_t)p.eidx * 512 + 128 * h + c] = __expf(blast - r); }
        __syncthreads();
        bf16* UT = UTHP + (size_t)p.ent * UTH_ENT;
        LAS bf16* OUT = (LAS bf16*)(L + 2048);
        const int vt = w >> 1;
#pragma unroll
        for (int q = 0; q < 2; ++q) {
            const int kt = (w & 1) * 2 + q;
            f32x16 acc = ZERO16;
            mma32_ll<64>(acc, VT + vt * 32 * 72, 72, KT + kt * 32 * 72, 72, lane);
#pragma unroll
            for (int reg = 0; reg < 16; ++reg) OUT[(vt * 32 + rowreg(reg, lane)) * 136 + kt * 32 + (lane & 31)] = (bf16)f2bf(acc[reg]);
        }
        __syncthreads();
#pragma unroll
        for (int i = 0; i < 4; ++i) { const int idx = tid + 512 * i, row = idx >> 4, pc = idx & 15; *(GAS v4u*)(UT + (size_t)row * 128 + pc * 8) = *(const LAS v4u*)(OUT + row * 136 + pc * 8); }
        __syncthreads();
    } else {
#pragma unroll
        for (int i = 0; i < 2; ++i) { const int idx = tid + 512 * i; *(LAS v4u*)((LAS bf16*)(L + 2048) + (idx >> 4) * 136 + (idx & 15) * 8) = gbr[i]; }
#pragma unroll
        for (int i = 0; i < 16; ++i) {
            const int t = rg * 16 + i; const float b = pre + bl[i];
            QN[t * 136 + c] = (bf16)f2bf(bf2f(QN[t * 136 + c]) * __expf(b - r));
            KN[t * 136 + c] = (bf16)f2bf(kk[i] * __expf(r - b));
        }
        __syncthreads();
        bf16x8 sfr[8];
        load_frags8(UTHP + (size_t)p.ent * UTH_ENT + (size_t)(w & 3) * 32 * 128, 128, lane, sfr);
        if (w < 4) {
            const int tm = w >> 1, sn = w & 1;
            f32x16 acc = ZERO16;
            if (!(tm == 0 && sn == 1)) mma32_ll<128>(acc, QN + tm * 32 * 136, 136, KN + sn * 32 * 136, 136, lane);
#pragma unroll
            for (int reg = 0; reg < 16; ++reg) { const int t = tm * 32 + rowreg(reg, lane), s = sn * 32 + (lane & 31);
                PP[t * 72 + s] = (s <= t) ? (bf16)f2bf(acc[reg]) : (bf16)0; }
        }
        __syncthreads();
        const int tm = w >> 2, vn = w & 3;
        f32x16 acc = ZERO16;
        mma32_ll<64>(acc, PP + tm * 32 * 72, 72, VT + vn * 32 * 72, 72, lane);
        mma32_lf8(acc, QN + tm * 32 * 136, 136, sfr, lane);
        { float sqv[16]; int rsel;
#pragma unroll
          for (int reg = 0; reg < 16; ++reg) sqv[reg] = acc[reg] * acc[reg];
          const float sq = rowsum16(sqv, lane, rsel); if ((lane & 1) == 0) PART[(tm * 32 + rowreg(rsel, lane)) * 4 + vn] = sq; }
        __syncthreads();
        if (tid < 64) RS[tid] = 1.0f / sqrtf(((PART[tid * 4] + PART[tid * 4 + 1]) + (PART[tid * 4 + 2] + PART[tid * 4 + 3])) * (1.0f / 128.0f) + EPS);
        __syncthreads();
        bf16* QZ = WSP(bf16, WS_QZ);
        LAS bf16* OUT = (LAS bf16*)(L + 2048);
#pragma unroll
        for (int reg = 0; reg < 16; ++reg) { const int t = tm * 32 + rowreg(reg, lane), v = vn * 32 + (lane & 31);
            OUT[t * 136 + v] = (bf16)f2bf(acc[reg] * RS[t] * bf2f(OUT[t * 136 + v])); }
        __syncthreads();
#pragma unroll
        for (int i = 0; i < 2; ++i) { const int idx = tid + 512 * i, row = idx >> 4, pc = idx & 15; *(GAS v4u*)(QZ + (size_t)(rowbase + row) * 1024 + 128 * h + pc * 8) = *(const LAS v4u*)(OUT + row * 136 + pc * 8); }
        __syncthreads();
    }
}

struct MbP { int rowbase, g, nvalid, ent0, estride; const bf16* prev; };
__device__ __forceinline__ bool mb_valid(int o, bool with_meta) { return o < 512 || (with_meta && o >= 516 && o < 518); }
__device__ __forceinline__ MbP mb_params(Frame& F, int j) {
    MbP p; const bf16* XBC = WSP(bf16, WS_XBC);
    if (j < 512) { const int b = j >> 6, g = (j >> 5) & 1, c = j & 31, rb = b * SEQ + c * CH; p.rowbase = rb; p.g = g; p.nvalid = CH; p.ent0 = (b * 8 + 4 * g) * 32 + c; p.estride = 32;
        p.prev = c > 0 ? XBC + (size_t)(rb - 3) * 1024 : XBC + (size_t)(ROW_META + 13) * 1024; }
    else { const int g = j - 516; p.rowbase = ROW_META; p.g = g; p.nvalid = NMETA; p.ent0 = 2048 + 4 * g; p.estride = 1; p.prev = nullptr; }
    return p;
}
struct MbRaw { v4u rx[4]; v4u halo; float dt; };
__device__ __forceinline__ int mb_bccol(int g, int pc) { return pc < 16 ? 512 + 128 * g + pc * 8 : 768 + 128 * g + (pc - 16) * 8; }
template <int PASS> __device__ __forceinline__ void mb_load(Frame& F, const MbP& p, MbRaw& r) {
    const int tid = F.tid; const bf16* X = WSP(bf16, WS_XBC) + (size_t)p.rowbase * 1024;
#pragma unroll
    for (int i = 0; i < 4; ++i) { const int idx = tid + 512 * i, row = idx >> 5, pc = idx & 31;
        r.rx[i] = *(const GAS v4u*)(X + (size_t)row * 1024 + 256 * p.g + pc * 8); }
    r.halo = (v4u){0u, 0u, 0u, 0u};
    if (p.prev && tid < 192) { const int hr = tid >> 6, pc = tid & 63; r.halo = *(const GAS v4u*)(p.prev + (size_t)hr * 1024 + (pc < 32 ? 256 * p.g + pc * 8 : mb_bccol(p.g, pc - 32))); }
    r.dt = 0.f;
    if (tid < 256) { const int t = tid & 63; if (t < p.nvalid) r.dt = WSP(float, WS_DT)[(size_t)(p.rowbase + t) * 8 + 4 * p.g + (tid >> 6)]; }
}
template <int PASS> __device__ __forceinline__ void mamba_item(Frame& F, const MbP p, MbRaw& raw, bool has_next, const MbP pn) {
    LAS unsigned char* L = F.lds;
    LAS float* CUM = (LAS float*)L;
    LAS float* DTV = (LAS float*)(L + 1024);
    LAS bf16* XT = (LAS bf16*)(L + 2048);
    LAS bf16* BT = (LAS bf16*)(L + 38912);
    LAS bf16* BN = (LAS bf16*)(L + 38912);
    LAS bf16* CN = (LAS bf16*)(L + 56320);
    LAS bf16* RAW = (LAS bf16*)(L + 73728);
    const int tid = F.tid, lane = F.lane, w = F.wave, g = p.g, rowbase = p.rowbase;
    if (w < 4) {
        const int head = 4 * g + w;
        const float dt = raw.dt;
        const float A = -__expf(inp(F, 17)[head]);
        float cum = dt * A;
#pragma unroll
        for (int o = 1; o < 64; o <<= 1) { const float n = __shfl_up(cum, o); if (lane >= o) cum += n; }
        const float last = __builtin_bit_cast(float, __builtin_amdgcn_readlane(__builtin_bit_cast(int, cum), 63));
        if (PASS == 1) { CUM[w * 64 + lane] = dt * __expf(last - cum); if (lane == 0) WSP(float, WS_DCY)[p.ent0 + w * p.estride] = __expf(last); }
        else { CUM[w * 64 + lane] = cum; DTV[w * 64 + lane] = dt; }
    }
#pragma unroll
    for (int i = 0; i < 4; ++i) { const int idx = tid + 512 * i; *(LAS v4u*)(RAW + ((idx >> 5) + 3) * 256 + (idx & 31) * 8) = raw.rx[i]; }
    if (tid < 192 && (tid & 63) < 32) *(LAS v4u*)(RAW + (tid >> 6) * 256 + (tid & 63) * 8) = raw.halo;
    __syncthreads();
    v4u rbc[4];
    {   const bf16* X = WSP(bf16, WS_XBC) + (size_t)rowbase * 1024;
#pragma unroll
        for (int i = 0; i < 4; ++i) { const int idx = tid + 512 * i, row = idx >> 5, pc = idx & 31;
            rbc[i] = (PASS == 3 || pc < 16) ? *(const GAS v4u*)(X + (size_t)row * 1024 + mb_bccol(g, pc)) : (v4u){0u, 0u, 0u, 0u}; } }
    const int ch = tid & 255, half = tid >> 8;
    const float* cw = inp(F, 14); const float* cbp = inp(F, 15);
    {
        const int col = 256 * g + ch;
        const float w0 = cw[col], w1 = cw[1024 + col], w2 = cw[2048 + col], w3 = cw[3072 + col], cb = cbp[col];
        float r0 = bf2f(RAW[(half * 32 + 0) * 256 + ch]), r1 = bf2f(RAW[(half * 32 + 1) * 256 + ch]), r2 = bf2f(RAW[(half * 32 + 2) * 256 + ch]);
        unsigned pk[16];
#pragma unroll
        for (int i = 0; i < 32; i += 2) {
            const int t = half * 32 + i;
            const float r3 = bf2f(RAW[(t + 3) * 256 + ch]), r4 = bf2f(RAW[(t + 4) * 256 + ch]);
            float a0 = silu(cb + w0 * r0 + w1 * r1 + w2 * r2 + w3 * r3), a1 = silu(cb + w0 * r1 + w1 * r2 + w2 * r3 + w3 * r4);
            if (PASS == 1) { a0 *= CUM[(ch >> 6) * 64 + t]; a1 *= CUM[(ch >> 6) * 64 + t + 1]; }
            pk[i >> 1] = pk2(a0, a1); r0 = r2; r1 = r3; r2 = r4;
        }
        LAS v4u* d = (LAS v4u*)(XT + ch * 72 + half * 32);
        d[0] = (v4u){pk[0], pk[1], pk[2], pk[3]}; d[1] = (v4u){pk[4], pk[5], pk[6], pk[7]}; d[2] = (v4u){pk[8], pk[9], pk[10], pk[11]}; d[3] = (v4u){pk[12], pk[13], pk[14], pk[15]};
    }
    __syncthreads();
#pragma unroll
    for (int i = 0; i < 4; ++i) { const int idx = tid + 512 * i; *(LAS v4u*)(RAW + ((idx >> 5) + 3) * 256 + (idx & 31) * 8) = rbc[i]; }
    if (tid < 192 && (tid & 63) >= 32) *(LAS v4u*)(RAW + (tid >> 6) * 256 + ((tid & 63) - 32) * 8) = raw.halo;
    if (has_next) mb_load<PASS>(F, pn, raw);
    __syncthreads();
    if (PASS == 3 || ch < 128) {
        const int col = ch < 128 ? 512 + 128 * g + ch : 768 + 128 * g + (ch - 128);
        const float w0 = cw[col], w1 = cw[1024 + col], w2 = cw[2048 + col], w3 = cw[3072 + col], cb = cbp[col];
        float r0 = bf2f(RAW[(half * 32 + 0) * 256 + ch]), r1 = bf2f(RAW[(half * 32 + 1) * 256 + ch]), r2 = bf2f(RAW[(half * 32 + 2) * 256 + ch]);
        unsigned pk[16];
#pragma unroll
        for (int i = 0; i < 32; i += 2) {
            const int t = half * 32 + i;
            const float r3 = bf2f(RAW[(t + 3) * 256 + ch]), r4 = bf2f(RAW[(t + 4) * 256 + ch]);
            const float a0 = silu(cb + w0 * r0 + w1 * r1 + w2 * r2 + w3 * r3), a1 = silu(cb + w0 * r1 + w1 * r2 + w2 * r3 + w3 * r4);
            if (PASS == 1) pk[i >> 1] = pk2(a0, a1);
            else { LAS bf16* dst = ch < 128 ? BN + ch : CN + (ch - 128); dst[t * 136] = (bf16)f2bf(a0); dst[(t + 1) * 136] = (bf16)f2bf(a1); }
            r0 = r2; r1 = r3; r2 = r4;
        }
        if (PASS == 1) { LAS v4u* d = (LAS v4u*)(BT + ch * 72 + half * 32);
            d[0] = (v4u){pk[0], pk[1], pk[2], pk[3]}; d[1] = (v4u){pk[4], pk[5], pk[6], pk[7]}; d[2] = (v4u){pk[8], pk[9], pk[10], pk[11]}; d[3] = (v4u){pk[12], pk[13], pk[14], pk[15]}; }
    }
    __syncthreads();
    bf16* UM = WSP(bf16, WS_UM);
    if (PASS == 1) {
        LAS bf16* OUT = (LAS bf16*)(L + 73728);
#pragma unroll
        for (int r = 0; r < 2; ++r) {
            const int hl = w >> 2, hd = 2 * r + hl, pt = (w >> 1) & 1;
#pragma unroll
            for (int q = 0; q < 2; ++q) {
                const int nt = (w & 1) * 2 + q;
                f32x16 acc = ZERO16;
                mma32_ll<64>(acc, XT + (hd * 64 + pt * 32) * 72, 72, BT + nt * 32 * 72, 72, lane);
#pragma unroll
                for (int reg = 0; reg < 16; ++reg) OUT[(hl * 64 + pt * 32 + rowreg(reg, lane)) * 136 + nt * 32 + (lane & 31)] = (bf16)f2bf(acc[reg]);
            }
            __syncthreads();
#pragma unroll
            for (int i = 0; i < 4; ++i) { const int idx = tid + 512 * i, hh = idx >> 10, row = (idx >> 4) & 63, pc = idx & 15;
                *(GAS v4u*)(UM + (size_t)(p.ent0 + (2 * r + hh) * p.estride) * UM_ENT + (size_t)row * 128 + pc * 8) = *(const LAS v4u*)(OUT + (hh * 64 + row) * 136 + pc * 8); }
            __syncthreads();
        }
    } else {
        LAS float* CB = (LAS float*)(L + 73728);
        LAS bf16* WW = (LAS bf16*)(L + 90624);
        LAS float* PART = (LAS float*)(L + 127488);
        LAS float* RS = (LAS float*)(L + 129536);
        bf16x8 hfr[8];
        load_frags8(UM + (size_t)(p.ent0 + (w >> 1) * p.estride) * UM_ENT + (size_t)(w & 1) * 32 * 128, 128, lane, hfr);
        v4u zr[4];
        { const bf16* Zg = WSP(bf16, WS_QZ) + (size_t)rowbase * 1024 + 512 + 256 * g;
#pragma unroll
          for (int i = 0; i < 4; ++i) { const int idx = tid + 512 * i; zr[i] = *(const GAS v4u*)(Zg + (size_t)(idx >> 5) * 1024 + (idx & 31) * 8); } }
        if (w < 4) {
            const int tm = w >> 1, sn = w & 1;
            if (!(tm == 0 && sn == 1)) {
                f32x16 acc = ZERO16;
                mma32_ll<128>(acc, CN + tm * 32 * 136, 136, BN + sn * 32 * 136, 136, lane);
#pragma unroll
                for (int reg = 0; reg < 16; ++reg) CB[(tm * 32 + rowreg(reg, lane)) * 66 + sn * 32 + (lane & 31)] = acc[reg];
            }
        }
        __syncthreads();
        {
            const int hd = tid >> 7, rem = tid & 127, t = rem >> 1, s0 = (rem & 1) * 32;
            const float ct = CUM[hd * 64 + t];
            unsigned pw[16];
#pragma unroll
            for (int j = 0; j < 32; j += 2) {
                const int s = s0 + j;
                const float a = (s <= t) ? CB[t * 66 + s] * __expf(ct - CUM[hd * 64 + s]) * DTV[hd * 64 + s] : 0.f;
                const float b = (s + 1 <= t) ? CB[t * 66 + s + 1] * __expf(ct - CUM[hd * 64 + s + 1]) * DTV[hd * 64 + s + 1] : 0.f;
                pw[j >> 1] = pk2(a, b);
            }
            __syncthreads();
#pragma unroll
            for (int i = 0; i < 4; ++i) { const int idx = tid + 512 * i, zt = idx >> 5, pc = idx & 31;
                *(LAS v4u*)((zt < 32 ? (LAS bf16*)(L + 38912) + zt * 264 : (LAS bf16*)(L + 73728) + (zt - 32) * 264) + pc * 8) = zr[i]; }
            LAS v4u* d = (LAS v4u*)(WW + (hd * 64 + t) * 72 + s0);
            d[0] = (v4u){pw[0], pw[1], pw[2], pw[3]}; d[1] = (v4u){pw[4], pw[5], pw[6], pw[7]}; d[2] = (v4u){pw[8], pw[9], pw[10], pw[11]}; d[3] = (v4u){pw[12], pw[13], pw[14], pw[15]};
        }
        __syncthreads();
        const int hd = w >> 1, pnn = w & 1, head = 4 * g + hd;
        const float Dk = inp(F, 18)[head];
        bf16* QZ = WSP(bf16, WS_QZ);
        const int chn = hd * 64 + pnn * 32 + (lane & 31);
        unsigned yzp[2][8];
#pragma unroll
        for (int tm = 0; tm < 2; ++tm) {
            const LAS bf16* ZL = tm == 0 ? (const LAS bf16*)(L + 38912) : (const LAS bf16*)(L + 73728);
            float sqv[16];
            f32x16 acc = ZERO16;
            mma32_lf8(acc, CN + tm * 32 * 136, 136, hfr, lane);
#pragma unroll
            for (int reg = 0; reg < 16; ++reg) acc[reg] *= __expf(CUM[hd * 64 + tm * 32 + rowreg(reg, lane)]);
            mma32_ll<64>(acc, WW + (hd * 64 + tm * 32) * 72, 72, XT + (hd * 64 + pnn * 32) * 72, 72, lane);
#pragma unroll
            for (int reg = 0; reg < 16; ++reg) {
                const int t = tm * 32 + rowreg(reg, lane);
                const float y = acc[reg] + Dk * bf2f(XT[chn * 72 + t]);
                const float v = y * bf2f(ZL[rowreg(reg, lane) * 264 + chn]);
                if (reg & 1) yzp[tm][reg >> 1] |= f2bf(v) << 16; else yzp[tm][reg >> 1] = f2bf(v);
                sqv[reg] = v * v;
            }
            { int rsel; const float sq = rowsum16(sqv, lane, rsel); if ((lane & 1) == 0) PART[(tm * 32 + rowreg(rsel, lane)) * 8 + w] = sq; }
            asm volatile("" ::: "memory");
        }
        __syncthreads();
        if (tid < 64) { float s = 0.f;
#pragma unroll
            for (int j = 0; j < 8; ++j) s += PART[tid * 8 + j];
            RS[tid] = 1.0f / sqrtf(s * (1.0f / 256.0f) + EPS); }
        __syncthreads();
        const float nw = inp(F, 19)[256 * g + chn];
        LAS bf16* OUT = (LAS bf16*)(L + 2048);
#pragma unroll
        for (int tm = 0; tm < 2; ++tm)
#pragma unroll
            for (int reg = 0; reg < 16; ++reg) { const int t = tm * 32 + rowreg(reg, lane);
                const float v = bf2f((unsigned short)((reg & 1) ? (yzp[tm][reg >> 1] >> 16) : (yzp[tm][reg >> 1] & 0xffffu)));
                OUT[t * 264 + chn] = (bf16)f2bf(v * RS[t] * nw); }
        __syncthreads();
#pragma unroll
        for (int i = 0; i < 4; ++i) { const int idx = tid + 512 * i, row = idx >> 5, pc = idx & 31; *(GAS v4u*)(QZ + (size_t)(rowbase + row) * 1024 + 512 + 256 * g + pc * 8) = *(const LAS v4u*)(OUT + row * 264 + pc * 8); }
        __syncthreads();
    }
}
__device__ __forceinline__ void unpack8(const v4u u, float (&f)[8]) {
    f[0] = bf2f((unsigned short)(u.x & 0xffffu)); f[1] = bf2f((unsigned short)(u.x >> 16)); f[2] = bf2f((unsigned short)(u.y & 0xffffu)); f[3] = bf2f((unsigned short)(u.y >> 16));
    f[4] = bf2f((unsigned short)(u.z & 0xffffu)); f[5] = bf2f((unsigned short)(u.z >> 16)); f[6] = bf2f((unsigned short)(u.w & 0xffffu)); f[7] = bf2f((unsigned short)(u.w >> 16));
}
__device__ __forceinline__ void p4b_scan(Frame& F) {
    const int gt = F.vcu * (NWAVES * 64) + F.tid, NT = F.G * NWAVES * 64;
    const float* ER = WSP(float, WS_ER); const float* EL = WSP(float, WS_EL); const float* DCY = WSP(float, WS_DCY);
    for (int idx = gt; idx < 131072; idx += NT) {
        float S[8];
#pragma unroll
        for (int j = 0; j < 8; ++j) S[j] = 0.f;
        if (idx < 65536) {
            const int bh = idx >> 11, rem = idx & 2047, v = rem >> 4, kd8 = (rem & 15) * 8, b = bh >> 2, h = bh & 3;
            bf16* UTH = UTHP + (size_t)v * 128 + kd8;
            {
                float uu[8]; unpack8(*(const GAS v4u*)(UTH + (size_t)(1024 + h) * UTH_ENT), uu);
                const float* el = EL + (size_t)256 * 512 + 128 * h + kd8;
#pragma unroll
                for (int j = 0; j < 8; ++j) S[j] = el[j] * uu[j];
            }
            for (int c0 = 0; c0 < NCH; c0 += 4) {
                v4u u[4]; f32x4 er[4][2], el[4][2];
#pragma unroll
                for (int q = 0; q < 4; ++q) { const size_t e = (size_t)(b * 32 + c0 + q);
                    u[q] = *(const GAS v4u*)(UTH + (size_t)(bh * 32 + c0 + q) * UTH_ENT);
                    er[q][0] = *(const GAS f32x4*)(ER + e * 512 + 128 * h + kd8); er[q][1] = *(const GAS f32x4*)(ER + e * 512 + 128 * h + kd8 + 4);
                    el[q][0] = *(const GAS f32x4*)(EL + e * 512 + 128 * h + kd8); el[q][1] = *(const GAS f32x4*)(EL + e * 512 + 128 * h + kd8 + 4); }
#pragma unroll
                for (int q = 0; q < 4; ++q) { float uu[8], sp[8]; unpack8(u[q], uu);
#pragma unroll
                    for (int j = 0; j < 8; ++j) { sp[j] = er[q][j >> 2][j & 3] * S[j]; S[j] = el[q][j >> 2][j & 3] * (sp[j] + uu[j]); }
                    *(GAS v4u*)(UTH + (size_t)(bh * 32 + c0 + q) * UTH_ENT) = (v4u){pk2(sp[0], sp[1]), pk2(sp[2], sp[3]), pk2(sp[4], sp[5]), pk2(sp[6], sp[7])}; }
            }
            float* o = OUTP(O_HGP) + ((size_t)bh * 128 + kd8) * 128 + v;
#pragma unroll
            for (int j = 0; j < 8; ++j) o[(size_t)j * 128] = S[j];
        } else {
            const int i2 = idx - 65536, bhd = i2 >> 10, rem = i2 & 1023, p_ = rem >> 4, n8 = (rem & 15) * 8, head = bhd & 7;
            bf16* UM = WSP(bf16, WS_UM) + (size_t)p_ * 128 + n8;
            {   float uu[8]; unpack8(*(const GAS v4u*)(UM + (size_t)(2048 + head) * UM_ENT), uu);
#pragma unroll
                for (int j = 0; j < 8; ++j) S[j] = uu[j]; }
            for (int c0 = 0; c0 < NCH; c0 += 4) {
                v4u u[4]; float d[4];
#pragma unroll
                for (int q = 0; q < 4; ++q) { u[q] = *(const GAS v4u*)(UM + (size_t)(bhd * 32 + c0 + q) * UM_ENT); d[q] = DCY[bhd * 32 + c0 + q]; }
#pragma unroll
                for (int q = 0; q < 4; ++q) { float uu[8], sp[8]; unpack8(u[q], uu);
#pragma unroll
                    for (int j = 0; j < 8; ++j) { sp[j] = S[j]; S[j] = d[q] * S[j] + uu[j]; }
                    *(GAS v4u*)(UM + (size_t)(bhd * 32 + c0 + q) * UM_ENT) = (v4u){pk2(sp[0], sp[1]), pk2(sp[2], sp[3]), pk2(sp[4], sp[5]), pk2(sp[6], sp[7])}; }
            }
            float* o = OUTP(O_SSP) + ((size_t)bhd * 64 + p_) * 128 + n8;
            *(GAS f32x4*)o = (f32x4){S[0], S[1], S[2], S[3]}; *(GAS f32x4*)(o + 4) = (f32x4){S[4], S[5], S[6], S[7]};
        }
    }
}
__device__ __forceinline__ void hgrn_decode(Frame& F, int smp, int h) {
    LAS float* OS = (LAS float*)F.lds;
    LAS float* RED = (LAS float*)(F.lds + 8192);
    const int tid = F.tid, row = ROW_SMP + smp, v4 = (tid & 31) * 4, kg = tid >> 5;
    const float* FZ = WSP(float, WS_FZ); const bf16* VB = WSP(bf16, WS_VB); bf16* QZ = WSP(bf16, WS_QZ); const float* LB = WSP(float, WS_LB);
    const float* Sin = inp(F, 2) + (size_t)(smp * 4 + h) * 16384; float* Sout = OUTP(O_HGS) + (size_t)(smp * 4 + h) * 16384;
    f32x4 vv; { const unsigned long long raw = *(const GAS unsigned long long*)(VB + (size_t)row * 512 + 128 * h + v4);
        vv = (f32x4){bf2f((unsigned short)raw), bf2f((unsigned short)(raw >> 16)), bf2f((unsigned short)(raw >> 32)), bf2f((unsigned short)(raw >> 48))}; }
    f32x4 o = (f32x4){0.f, 0.f, 0.f, 0.f};
    f32x4 st[8]; float fzv[8], lbv[8], qv[8];
#pragma unroll
    for (int j = 0; j < 8; ++j) { const int kd = kg * 8 + j;
        st[j] = *(const GAS f32x4*)(Sin + (size_t)kd * 128 + v4);
        fzv[j] = FZ[(size_t)row * 512 + 128 * h + kd]; lbv[j] = LB[128 * h + kd]; qv[j] = bf2f(QZ[(size_t)row * 1024 + 128 * h + kd]); }
#pragma unroll
    for (int j = 0; j < 8; ++j) {
        const int kd = kg * 8 + j;
        const float sg = sigm(fzv[j]), f = lbv[j] + (1.0f - lbv[j]) * sg, k = (1.0f - lbv[j]) * (1.0f - sg);
        const f32x4 sn = st[j] * f + vv * k;
        *(GAS f32x4*)(Sout + (size_t)kd * 128 + v4) = sn;
        o = o + sn * qv[j];
    }
    *(LAS f32x4*)(OS + kg * 128 + v4) = o;
    __syncthreads();
    float ov = 0.f;
    if (tid < 128) {
#pragma unroll
        for (int j = 0; j < 16; ++j) ov += OS[j * 128 + tid];
        const float sq = wave_sum(ov * ov); if (F.lane == 0) RED[F.wave] = sq;
    }
    __syncthreads();
    if (tid < 128) {
        const float rs = 1.0f / sqrtf((RED[0] + RED[1]) * (1.0f / 128.0f) + EPS);
        const float g = bf2f(WSP(bf16, WS_GB)[(size_t)row * 512 + 128 * h + tid]);
        QZ[(size_t)row * 1024 + 128 * h + tid] = (bf16)f2bf(ov * rs * g);
    }
    __syncthreads();
}
__device__ __forceinline__ void mamba_decode(Frame& F, int smp, int g) {
    LAS float* XS = (LAS float*)F.lds;
    LAS float* YS = (LAS float*)(F.lds + 2048);
    LAS float* RED = (LAS float*)(F.lds + 3072);
    const int tid = F.tid, row = ROW_SMP + smp;
    const bf16* XBC = WSP(bf16, WS_XBC); bf16* QZ = WSP(bf16, WS_QZ);
    {
        const int ch = tid, col = ch < 256 ? 256 * g + ch : ch < 384 ? 512 + 128 * g + (ch - 256) : 768 + 128 * g + (ch - 384);
        const float* cw = inp(F, 14); const float* sc = inp(F, 4) + (size_t)smp * 3 * 1024;
        const float s0 = sc[col], s1 = sc[1024 + col], s2 = sc[2048 + col], cur = bf2f(XBC[(size_t)row * 1024 + col]);
        XS[ch] = silu(inp(F, 15)[col] + cw[col] * s0 + cw[1024 + col] * s1 + cw[2048 + col] * s2 + cw[3072 + col] * cur);
        float* cs = OUTP(O_CVS) + (size_t)smp * 3 * 1024; cs[col] = s1; cs[1024 + col] = s2;
    }
    __syncthreads();
    {
        const int hd = tid >> 7, r = tid & 127, n4 = (r & 31) * 4, pg = r >> 5, head = 4 * g + hd;
        const float dt = WSP(float, WS_DT)[(size_t)row * 8 + head], dA = __expf(-dt * __expf(inp(F, 17)[head])), Dk = inp(F, 18)[head];
        const f32x4 Bv = *(const LAS f32x4*)(XS + 256 + n4), Cv = *(const LAS f32x4*)(XS + 384 + n4);
        const float* Sin = inp(F, 3) + (size_t)(smp * 8 + head) * 8192; float* Sout = OUTP(O_SSS) + (size_t)(smp * 8 + head) * 8192;
        float yv[16]; f32x4 st[16];
#pragma unroll
        for (int j = 0; j < 16; ++j) st[j] = *(const GAS f32x4*)(Sin + (size_t)(pg * 16 + j) * 128 + n4);
#pragma unroll
        for (int j = 0; j < 16; ++j) {
            const int p = pg * 16 + j; const float x = XS[hd * 64 + p];
            const f32x4 sn = st[j] * dA + Bv * (dt * x);
            *(GAS f32x4*)(Sout + (size_t)p * 128 + n4) = sn;
            yv[j] = (sn[0] * Cv[0] + sn[1] * Cv[1]) + (sn[2] * Cv[2] + sn[3] * Cv[3]);
        }
        { int rsel; const float y = rowsum16(yv, F.lane, rsel); if ((r & 1) == 0) { const int p = pg * 16 + rsel; YS[hd * 64 + p] = y + Dk * XS[hd * 64 + p]; } }
    }
    __syncthreads();
    float yz = 0.f;
    if (tid < 256) {
        yz = YS[tid] * bf2f(QZ[(size_t)row * 1024 + 512 + 256 * g + tid]);
        const float sq = wave_sum(yz * yz); if (F.lane == 0) RED[F.wave] = sq;
    }
    __syncthreads();
    if (tid < 256) {
        const float rs = 1.0f / sqrtf(((RED[0] + RED[1]) + (RED[2] + RED[3])) * (1.0f / 256.0f) + EPS);
        QZ[(size_t)row * 1024 + 512 + 256 * g + tid] = (bf16)f2bf(yz * rs * inp(F, 19)[256 * g + tid]);
    }
    __syncthreads();
}
__device__ __forceinline__ void p4a(Frame& F, bool decode) {
    if (decode) {
        for (int j = F.vcu; j < 512; j += F.G) hgrn_decode(F, j >> 2, j & 3);
        for (int j = F.vcu; j < 256; j += F.G) mamba_decode(F, j >> 1, j & 1);
    }
    {   HgRaw raw; int i = F.vcu; if (i < 1028) { const HgP p0 = hg_params(i); hg_load<1>(F, p0, raw); }
        for (; i < 1028; i += F.G) { const int in = i + F.G; hgrn_item<1>(F, hg_params(i), raw, in < 1028, hg_params(in < 1028 ? in : i)); } }
    {   MbRaw raw; int j = F.vcu; if (mb_valid(j, true)) { const MbP p0 = mb_params(F, j); mb_load<1>(F, p0, raw); }
        for (; mb_valid(j, true); j += F.G) { const int jn = j + F.G; const bool hn = mb_valid(jn, true); mamba_item<1>(F, mb_params(F, j), raw, hn, mb_params(F, hn ? jn : j)); } }
}
__device__ __forceinline__ void p4c(Frame& F) {
    {   HgRaw raw; int i = F.vcu; if (i < 1024) { const HgP p0 = hg_params(i); hg_load<3>(F, p0, raw); }
        for (; i < 1024; i += F.G) { const int in = i + F.G; hgrn_item<3>(F, hg_params(i), raw, in < 1024, hg_params(in < 1024 ? in : i)); } }
    {   MbRaw raw; int j = F.vcu; if (j < 512) { const MbP p0 = mb_params(F, j); mb_load<3>(F, p0, raw); }
        for (; j < 512; j += F.G) { const int jn = j + F.G; mamba_item<3>(F, mb_params(F, j), raw, jn < 512, mb_params(F, jn < 512 ? jn : j)); } }
}
#ifndef MK_PER_PHASE
#define MK_PER_PHASE 0
#endif
#ifndef GP_ALIGN
#define GP_ALIGN true
#endif
#ifndef GP_SP2
#define GP_SP2 true
#endif
#ifndef GP_SP2_FINAL
#define GP_SP2_FINAL false
#endif
#ifndef WGM_GU
#define WGM_GU 4
#endif
#ifndef WGM_IN
#define WGM_IN 4
#endif
#ifndef WGM_DN
#define WGM_DN 4
#endif
constexpr int N_PHASES = 13;
struct Args { const float* in[26]; float* out; unsigned char* ws; int ph_lo, ph_hi; };
static_assert(sizeof(Args) == 26 * 8 + 8 + 8 + 8, "Args has no padding");
template <bool SPLIT> __global__ void __launch_bounds__(NWAVES * 64, 2) hymba_fwd(Args args) {
    extern __shared__ __attribute__((aligned(16))) unsigned char lds[];
    Frame F;
    F.lds = (LAS unsigned char*)lds;
    F.MISC = (volatile LAS unsigned*)(F.lds + MISC_OFF);
    F.tid = threadIdx.x; F.lane = F.tid & 63; F.wave = __builtin_amdgcn_readfirstlane(F.tid >> 6);
    F.G = gridDim.x; { const int bx = blockIdx.x; F.vcu = (F.G % 8 == 0) ? (bx % 8) * (F.G / 8) + bx / 8 : bx; }
    F.ws = (GAS unsigned char*)args.ws; F.out = (GAS float*)args.out; F.ctl = (gu32*)(args.ws + WS_CTL);
    for (int u = F.tid; u < (LDS_BYTES - LDSCTL_OFF) / 4; u += NWAVES * 64) ((LAS unsigned*)(F.lds + LDSCTL_OFF))[u] = 0u;
    __syncthreads();
    if (F.tid < 26) ((LAS unsigned long long*)(F.lds + TAB_OFF))[F.tid] = (unsigned long long)args.in[F.tid];
    __syncthreads();
    XcdBarrier bar; bar.bar = (unsigned*)(F.ctl + CW_BAR); bar.x = 0; bar.st = nullptr;
    if (!MK_PER_PHASE) bar = xcd_barrier_post((unsigned*)(F.ctl + CW_BAR), F.MISC + 8);
    const int lo = args.ph_lo, hi = args.ph_hi;
#ifndef PH_MASK
#define PH_MASK 0x1fff
#endif
#define IN(k) (((PH_MASK >> (k)) & 1) && lo <= (k) && (k) < hi)
#ifndef PH_REPEAT
#define PH_REPEAT 0
#endif
#define SEAM(k) do { if (IN(k) && IN((k) + 1)) xcd_barrier(bar); } while (0)
#define PHASE_LOCAL() asm volatile("" : "+s"(F.ws), "+s"(F.out), "+v"(F.tid), "+v"(F.lane), "+s"(F.wave), "+s"(F.vcu), "+s"(F.G))
#define REP(k) for (int rep_ = 0; rep_ < 1 + ((PH_REPEAT >> (k)) & 1); ++rep_)
#define HB WSP(bf16, WS_HB)
#define HH WSP(bf16, WS_H)
#define QZ WSP(bf16, WS_QZ)
#define SS1 WSP(float, WS_SS1)
#define SS2 WSP(float, WS_SS2)
#define SS3 WSP(float, WS_SS3)
#define SS4 WSP(float, WS_SS4)
#define RS2 (WSP(float, WS_SS1) + 32768)
#define RS3 (WSP(float, WS_SS1) + 65536)
#define YP (OUTP(O_YP))
#define HX0 WSP(float, WS_HX0)
#define HX WSP(float, WS_HX)

    constexpr int split = SPLIT ? 1 : 0;
#define SLABS WSP(float, WS_XBC)
    if (IN(0)) REP(0) { if (rep_ == 1) xcd_barrier(bar); PHASE_LOCAL(); p0_prologue(F); } SEAM(0);
    if (IN(1)) REP(1) { if (rep_ == 1) xcd_barrier(bar); PHASE_LOCAL();
        pg8::Gemm g{HB, WSP(bf16, WS_WGU1), M, 2 * FF, D, D}; pg8::MixOrder S; S.init(65, 2 * FF, D, F.G, (int)blockIdx.x, 0, WGM_GU);
        pg8::EpiSwiglu E{HH, SS1, LDH, FF / 64};
        pg8::gemm_phase<pg8::EpiSwiglu, pg8::MixOrder, GP_ALIGN, GP_SP2>(F.lds, g, S, E, nullptr);
    } SEAM(1);
    if (IN(2)) REP(2) { if (rep_ == 1) xcd_barrier(bar); PHASE_LOCAL();
        pg8::Gemm g{HH, WSP(bf16, WS_WD1), M, D, FF, LDH}; pg8::MixOrder S; S.init(split ? 64 : 65, D, FF, F.G, (int)blockIdx.x, split, WGM_DN);
        pg8::EpiResid E{HB, nullptr, HX0, HX, HB, SS2, 0.5f, nullptr};
        pg8::gemm_phase<pg8::EpiResid, pg8::MixOrder, GP_ALIGN, GP_SP2>(F.lds, g, S, E, SLABS);
    } SEAM(2);
    if (IN(3)) REP(3) { if (rep_ == 1) xcd_barrier(bar); PHASE_LOCAL(); fix_extra<FF / 128>(F, split, SLABS, HX0, HX, HB, SS2, RS2, 0.5f); } SEAM(3);
    if (IN(4)) REP(4) { if (rep_ == 1) xcd_barrier(bar); PHASE_LOCAL();
        pg8::Gemm g{HB, WSP(bf16, WS_WIN), M, NINP, D, D}; pg8::MixOrder S; S.init(65, NINP, D, F.G, (int)blockIdx.x, 0, WGM_IN);
        pg8::EpiInproj E{RS2, QZ, WSP(float, WS_FZ), WSP(bf16, WS_VB), WSP(bf16, WS_GB), WSP(bf16, WS_XBC), WSP(float, WS_DT), inp(F, 13), inp(F, 16), OUTP(O_CVP), OUTP(O_CVS)};
        pg8::gemm_phase<pg8::EpiInproj, pg8::MixOrder, GP_ALIGN, GP_SP2>(F.lds, g, S, E, nullptr);
    } SEAM(4);
    if (IN(5)) REP(5) { if (rep_ == 1) xcd_barrier(bar); PHASE_LOCAL(); p4a(F, rep_ == 0); } SEAM(5);
    if (IN(6)) REP(6) { if (rep_ == 1) xcd_barrier(bar); PHASE_LOCAL(); p4b_scan(F); } SEAM(6);
    if (IN(7)) REP(7) { if (rep_ == 1) xcd_barrier(bar); PHASE_LOCAL(); p4c(F); } SEAM(7);
    if (IN(8)) REP(8) { if (rep_ == 1) xcd_barrier(bar); PHASE_LOCAL();
        pg8::Gemm g{QZ, WSP(bf16, WS_WOUT), M, D, D, D}; pg8::MixOrder S; S.init(split ? 64 : 65, D, D, F.G, (int)blockIdx.x, split, WGM_DN);
        pg8::EpiResid E{HB, nullptr, HX, HX, HB, SS3, 1.0f, nullptr};
        pg8::gemm_phase<pg8::EpiResid, pg8::MixOrder, GP_ALIGN, GP_SP2>(F.lds, g, S, E, SLABS);
    } SEAM(8);
    if (IN(9)) REP(9) { if (rep_ == 1) xcd_barrier(bar); PHASE_LOCAL(); fix_extra<D / 128>(F, split, SLABS, HX, HX, HB, SS3, RS3, 1.0f);
        if (split) { GAS v4u* z = (GAS v4u*)(F.ws + WS_UM); for (int i = F.vcu * (NWAVES * 64) + F.tid; i < 131072; i += F.G * NWAVES * 64) z[i] = (v4u){0u, 0u, 0u, 0u}; } }
    if (IN(10)) REP(10) { if (rep_ == 1) xcd_barrier(bar); PHASE_LOCAL();
        pg8::Gemm g{HB, WSP(bf16, WS_WGU2), M, 2 * FF, D, D}; pg8::MixOrder S; S.init(65, 2 * FF, D, F.G, (int)blockIdx.x, 0, WGM_GU);
        pg8::EpiSwiglu E{HH, RS3, LDH, FF / 64};
        pg8::gemm_phase<pg8::EpiSwiglu, pg8::MixOrder, GP_ALIGN, GP_SP2>(F.lds, g, S, E, nullptr);
    } SEAM(10);
    if (IN(11)) REP(11) { if (rep_ == 1) xcd_barrier(bar); PHASE_LOCAL();
        pg8::Gemm g{HH, WSP(bf16, WS_WD2), M, D, FF, LDH}; pg8::MixOrder S; S.init(split ? 64 : 65, D, FF, F.G, (int)blockIdx.x, split, WGM_DN);
        if constexpr (SPLIT) {
            pg8::EpiResid E{HB, nullptr, HX, HX, HB, SS4, 0.5f, (unsigned long long*)(F.ws + WS_UM)};
            pg8::gemm_phase<pg8::EpiResid, pg8::MixOrder, GP_ALIGN, GP_SP2>(F.lds, g, S, E, SLABS);
            pg8::Unit u; S.next(0, u);
            VM_WAIT(); __syncthreads();
            unsigned long long* gp = (unsigned long long*)(F.ws + WS_UM) + (size_t)u.pm * 256 * 16;
            const bf16* hb = HB + (size_t)u.pm * 256 * 1024 + u.pn * 256 + 4 * F.lane;
            float* yb = YP + (size_t)u.pm * 256 * 1024 + u.pn * 256 + 4 * F.lane;
            const f32x4 w = *(const GAS f32x4*)(inp(F, 25) + u.pn * 256 + 4 * F.lane);
            float tot[8];
            { unsigned long long x[8]; unsigned spins = 0;
              for (;;) { bool ok = true;
#pragma unroll
                  for (int j = 0; j < 8; ++j) { x[j] = __hip_atomic_load(gp + (size_t)F.wave * 512 + F.lane + 64 * j, __ATOMIC_RELAXED, __HIP_MEMORY_SCOPE_AGENT); ok = ok && ((unsigned)(x[j] >> 32) == 1u); }
                  if (__all(ok) || ++spins > (1u << 18)) break; __builtin_amdgcn_s_sleep(4); }
#pragma unroll
              for (int j = 0; j < 8; ++j) { float v = __builtin_bit_cast(float, (unsigned)x[j]); v += __shfl_xor(v, 1); v += __shfl_xor(v, 2); v += __shfl_xor(v, 4); v += __shfl_xor(v, 8); tot[j] = v; } }
            unsigned long long o[32];
#pragma unroll
            for (int i = 0; i < 32; ++i) o[i] = *(const GAS unsigned long long*)(hb + (size_t)(F.wave * 32 + i) * 1024);
#pragma unroll
            for (int r = 0; r < 32; ++r) { const float rs = __builtin_amdgcn_rsqf(__builtin_bit_cast(float, __builtin_amdgcn_readlane(__builtin_bit_cast(int, tot[r >> 2]), (r & 3) * 16)) * (1.0f / 1024.0f) + EPS);
                const unsigned lo = (unsigned)o[r], hi = (unsigned)(o[r] >> 32);
                const f32x4 v = (f32x4){__builtin_bit_cast(float, lo << 16), __builtin_bit_cast(float, lo & 0xffff0000u), __builtin_bit_cast(float, hi << 16), __builtin_bit_cast(float, hi & 0xffff0000u)};
                *(GAS f32x4*)(yb + (size_t)(F.wave * 32 + r) * 1024) = v * rs * w; }
        } else {
            pg8::EpiResid E{HB, YP, HX, HX, nullptr, SS4, 0.5f, nullptr};
            pg8::gemm_phase<pg8::EpiResid, pg8::MixOrder, GP_ALIGN, GP_SP2>(F.lds, g, S, E, SLABS);
        }
    } SEAM(11);
    if (IN(12)) REP(12) { if (rep_ == 1) xcd_barrier(bar); PHASE_LOCAL(); p8_final<FF / 128>(F, split, SLABS); }
#undef SLABS
#undef IN
#undef SEAM
#undef HB
#undef HH
#undef QZ
#undef SS1
#undef SS2
#undef SS3
#undef SS4
#undef RS2
#undef RS3
#undef YP
#undef HX0
#undef HX
}

extern "C" void kernel_launch(void* const* d_in, const int* in_sizes, int n_in, void* d_out, int out_size, void* d_ws, size_t ws_size, hipStream_t stream) {
    static int grid = 0;
    if (grid == 0) {
        if (n_in != 26 || in_sizes[0] != MP * D || (size_t)out_size != O_END || ws_size < WS_END) {
            fprintf(stderr, "kernel_launch: unexpected shapes: n_in %d in0 %d out %d ws %zu; nothing launched\n", n_in, n_in > 0 ? in_sizes[0] : -1, out_size, ws_size); grid = -1; return; }
        int dev = 0, cus = 0, per_cu = 0;
        if (hipGetDevice(&dev) != hipSuccess || hipDeviceGetAttribute(&cus, hipDeviceAttributeMultiprocessorCount, dev) != hipSuccess) { fprintf(stderr, "kernel_launch: device query failed\n"); grid = -1; return; }
        if (hipFuncSetAttribute((const void*)hymba_fwd<true>, hipFuncAttributeMaxDynamicSharedMemorySize, LDS_BYTES) != hipSuccess || hipFuncSetAttribute((const void*)hymba_fwd<false>, hipFuncAttributeMaxDynamicSharedMemorySize, LDS_BYTES) != hipSuccess) { fprintf(stderr, "kernel_launch: hipFuncSetAttribute failed\n"); grid = -1; return; }
        if (hipOccupancyMaxActiveBlocksPerMultiprocessor(&per_cu, cus == 256 ? (const void*)hymba_fwd<true> : (const void*)hymba_fwd<false>, NWAVES * 64, LDS_BYTES) != hipSuccess || per_cu < 1)
            fprintf(stderr, "kernel_launch: note: occupancy query reports %d workgroups per CU\n", per_cu);
        (void)hipGetLastError();
        grid = cus;
    }
    if (grid < 0) return;
    if (hipMemsetAsync((char*)d_ws + WS_CTL, 0, CTL_ZERO_BYTES, stream) != hipSuccess) { fprintf(stderr, "kernel_launch: memset failed\n"); return; }
    Args a{};
    for (int i = 0; i < 26; ++i) a.in[i] = (const float*)d_in[i];
    a.out = (float*)d_out; a.ws = (unsigned char*)d_ws;
#if MK_PER_PHASE
    for (int p = 0; p < N_PHASES; ++p) { a.ph_lo = p; a.ph_hi = p + 1; if (grid == 256) hipLaunchKernelGGL(hymba_fwd<true>, dim3(grid), dim3(NWAVES * 64), LDS_BYTES, stream, a); else hipLaunchKernelGGL(hymba_fwd<false>, dim3(grid), dim3(NWAVES * 64), LDS_BYTES, stream, a); }
#else
    a.ph_lo = 0; a.ph_hi = N_PHASES;
    if (grid == 256) hipLaunchKernelGGL(hymba_fwd<true>, dim3(grid), dim3(NWAVES * 64), LDS_BYTES, stream, a);
    else hipLaunchKernelGGL(hymba_fwd<false>, dim3(grid), dim3(NWAVES * 64), LDS_BYTES, stream, a);
#endif
    const hipError_t le = hipPeekAtLastError();
    if (le != hipSuccess) fprintf(stderr, "kernel_launch: launch failed: %s\n", hipGetErrorName(le));
}
```

```cpp
#include <hip/hip_runtime.h>
#include <cstdio>
#include <cstdint>
namespace pg8 {
#define PG8_LAS __attribute__((address_space(3)))
typedef unsigned short bf16_t;
typedef short bf16x8 __attribute__((ext_vector_type(8)));
typedef float f32x4 __attribute__((ext_vector_type(4)));
typedef unsigned u32x4 __attribute__((ext_vector_type(4)));
constexpr int BM = 256, BK = 64, HALF = 128, HTB = HALF * BK * 2  , STAGE_BYTES = 8 * HTB, NXCD = 8, WGM = 8;

__host__ __device__ __forceinline__ int lds_byte(int r, int c) { const int st = (r >> 4) * 2 + (c >> 5), rr = r & 15, cc = c & 31, ob = rr * 64 + cc * 2; return st * 1024 + (ob ^ (((ob >> 9) & 1) << 5)); }
__host__ __device__ __forceinline__ void stage_rc(int b, int& R, int& C) { const int st = b / 1024, sb = b % 1024, swz = sb ^ (((sb >> 9) & 1) << 5); R = (st >> 1) * 16 + swz / 64; C = (st & 1) * 32 + (swz % 64) / 2; }
__host__ __device__ __forceinline__ int perm32(int rho) { const int n = rho >> 4, i = rho & 15; return 8 * (i >> 2) + 4 * n + (i & 3); }

struct Unit { int pm, pn, k0, nt, kind, slot; };
struct Gemm { const bf16_t* A; const bf16_t* Bt; int M, N, K, lda; };

struct MixOrder {
    int nM, nN, nwg, G, c, ppu, npieces, rounds, wgm;
    __host__ __device__ __forceinline__ void init(int nM_, int N, int K, int G_, int c_, int split, int wgm_) { wgm = wgm_; nM = nM_; nN = N / BM; nwg = nM * nN; G = G_; c = c_; ppu = K / (2 * BK); npieces = split ? nN * ppu : 0; rounds = (nwg + G - 1) / G; }
    __host__ __device__ __forceinline__ bool next(int i, Unit& u) const {
        if (i >= rounds) { const int p = (i - rounds) * G + c; if (p >= npieces) return false; u.pm = nM; u.pn = p / ppu; u.k0 = 2 * (p % ppu); u.nt = 2; u.kind = 1; u.slot = p; return true; }
        const long L = (long)i * G + c; if (L >= nwg) return false;
        int wgid = (int)L; { const int q = nwg / NXCD, r = nwg % NXCD, xcd = wgid % NXCD, off = wgid / NXCD; wgid = (xcd < r ? xcd * (q + 1) : r * (q + 1) + (xcd - r) * q) + off; }
        const int nig = wgm * nN, gid = wgid / nig, fm = gid * wgm, gsz = (nM - fm) < wgm ? (nM - fm) : wgm;
        u.pm = fm + ((wgid % nig) % gsz); u.pn = (wgid % nig) / gsz; u.k0 = 0; u.nt = 2 * ppu; u.kind = 0; u.slot = 0; return true;
    }
};

__device__ __forceinline__ unsigned cvt_pk_bf16(float lo, float hi) { unsigned r; asm volatile("v_cvt_pk_bf16_f32 %0, %1, %2" : "=v"(r) : "v"(lo), "v"(hi)); return r; }
typedef float f32x2 __attribute__((ext_vector_type(2)));
constexpr float EPSN = 1e-6f;
__device__ __forceinline__ float row_rstd(const float* SS, int row) {
    const f32x4* p = (const f32x4*)(SS + (size_t)row * 16);
    const f32x4 a = p[0], b = p[1], c = p[2], d = p[3];
    const float s = (((a[0] + a[1]) + (a[2] + a[3])) + ((b[0] + b[1]) + (b[2] + b[3]))) + (((c[0] + c[1]) + (c[2] + c[3])) + ((d[0] + d[1]) + (d[2] + d[3])));
    return __builtin_amdgcn_rsqf(s * (1.0f / 1024.0f) + EPSN);
}
__device__ __forceinline__ float silu_f(float x) { return x * __builtin_amdgcn_rcpf(1.0f + __expf(-x)); }
typedef unsigned u32x2 __attribute__((ext_vector_type(2)));

struct EpiSwiglu {
    static constexpr bool PERM = true, AFTER_DRAIN = false;
    bf16_t* H; const float* RSTD; int ldh, nkt;
    __device__ __forceinline__ void operator()(const f32x4 (&acc)[2][2][4][2], const Unit& u, int wr, int wc, int fr, int fq) const {
        const int row0 = u.pm * BM + wr * 64 + fr, col0 = u.pn * 128 + wc * 32 + 8 * fq;
        float rs8[8];
#pragma unroll
        for (int i = 0; i < 8; ++i) rs8[i] = RSTD[row0 + (i >> 2) * HALF + (i & 3) * 16];
#pragma unroll
        for (int ai = 0; ai < 2; ++ai)
#pragma unroll
            for (int m = 0; m < 4; ++m) {
                const int row = row0 + ai * HALF + m * 16;
                const float rs = rs8[ai * 4 + m];
                float h[8];
#pragma unroll
                for (int n = 0; n < 2; ++n)
#pragma unroll
                    for (int j = 0; j < 4; ++j) { const float g = acc[ai][0][m][n][j] * rs, up = acc[ai][1][m][n][j] * rs; h[n * 4 + j] = silu_f(g) * up; }
                u32x4 w; w.x = cvt_pk_bf16(h[0], h[1]); w.y = cvt_pk_bf16(h[2], h[3]); w.z = cvt_pk_bf16(h[4], h[5]); w.w = cvt_pk_bf16(h[6], h[7]);
                if (ldh) *(u32x4*)(H + (size_t)row * ldh + col0) = w;
                else *(u32x4*)(H + ((size_t)((row >> 8) * nkt + (col0 >> 6)) * 256 + (row & 255)) * 64 + (col0 & 63)) = w;
            }
    }
};

struct EpiResid {
    static constexpr bool PERM = false, AFTER_DRAIN = false;
    const bf16_t* RB; float* D0;
    const float* RX; float* DX;
    bf16_t* HB; float* SS; float scale; unsigned long long* gran;
    __device__ __forceinline__ void operator()(const f32x4 (&acc)[2][2][4][2], const Unit& u, int wr, int wc, int fr, int fq) const {
        const int col0 = u.pn * BM + wc * 32 + 4 * fq;
        if (u.pm < 64) {
            const bf16_t* rb = RB + (size_t)u.pm * BM * 1024; float* db = D0 ? D0 + (size_t)u.pm * BM * 1024 : nullptr;
            u32x2 rn[2][2];
            { const size_t off0 = (size_t)(wr * 64 + fr) * 1024 + col0;
#pragma unroll
              for (int bj = 0; bj < 2; ++bj)
#pragma unroll
                  for (int n = 0; n < 2; ++n) rn[bj][n] = *(const u32x2*)(rb + off0 + bj * HALF + n * 16); }
#pragma unroll
            for (int ai = 0; ai < 2; ++ai)
#pragma unroll
                for (int m = 0; m < 4; ++m) {
                    int lrow = ai * HALF + wr * 64 + m * 16 + fr;
                    asm volatile("" : "+v"(lrow));
                    const size_t off = (size_t)lrow * 1024 + col0;
                    u32x2 rc[2][2];
#pragma unroll
                    for (int bj = 0; bj < 2; ++bj)
#pragma unroll
                        for (int n = 0; n < 2; ++n) rc[bj][n] = rn[bj][n];
                    if (ai * 4 + m < 7) { const int nx = ai * 4 + m + 1; int lnx = (nx >> 2) * HALF + wr * 64 + (nx & 3) * 16 + fr; asm volatile("" : "+v"(lnx));
                        const size_t offn = (size_t)lnx * 1024 + col0;
#pragma unroll
                        for (int bj = 0; bj < 2; ++bj)
#pragma unroll
                            for (int n = 0; n < 2; ++n) rn[bj][n] = *(const u32x2*)(rb + offn + bj * HALF + n * 16); }
                    float sq = 0.f;
#pragma unroll
                    for (int bj = 0; bj < 2; ++bj)
#pragma unroll
                        for (int n = 0; n < 2; ++n) {
                            const u32x2 rr = rc[bj][n];
                            const f32x4 r = (f32x4){__builtin_bit_cast(float, rr.x << 16), __builtin_bit_cast(float, rr.x & 0xffff0000u), __builtin_bit_cast(float, rr.y << 16), __builtin_bit_cast(float, rr.y & 0xffff0000u)};
                            const f32x4 o = r + acc[ai][bj][m][n] * scale;
                            if (db) *(f32x4*)(db + off + bj * HALF + n * 16) = o;
                            sq += (o[0] * o[0] + o[1] * o[1]) + (o[2] * o[2] + o[3] * o[3]);
                            if (HB) { u32x2 w; w.x = cvt_pk_bf16(o[0], o[1]); w.y = cvt_pk_bf16(o[2], o[3]); *(u32x2*)(HB + ((size_t)u.pm * BM + lrow) * 1024 + col0 + bj * HALF + n * 16) = w; }
                        }
                    sq += __shfl_xor(sq, 16); sq += __shfl_xor(sq, 32);
                    if (fq == 0) { if (gran) __hip_atomic_store(gran + ((size_t)u.pm * BM + lrow) * 16 + u.pn * 4 + wc, (1ull << 32) | (unsigned long long)__builtin_bit_cast(unsigned, sq), __ATOMIC_RELAXED, __HIP_MEMORY_SCOPE_AGENT);
                        else SS[((size_t)u.pm * BM + lrow) * 16 + u.pn * 4 + wc] = sq; }
                    asm volatile("" ::: "memory");
                }
        } else {
#pragma unroll
            for (int ai = 0; ai < 2; ++ai)
#pragma unroll
                for (int m = 0; m < 4; ++m) {
                    int lrow = ai * HALF + wr * 64 + m * 16 + fr;
                    asm volatile("" : "+v"(lrow));
                    const size_t off = (size_t)lrow * 1024 + col0;
                    float sq = 0.f;
#pragma unroll
                    for (int bj = 0; bj < 2; ++bj)
#pragma unroll
                        for (int n = 0; n < 2; ++n) {
                            const f32x4 o = *(const f32x4*)(RX + off + bj * HALF + n * 16) + acc[ai][bj][m][n] * scale;
                            *(f32x4*)(DX + off + bj * HALF + n * 16) = o;
                            sq += (o[0] * o[0] + o[1] * o[1]) + (o[2] * o[2] + o[3] * o[3]);
                            if (HB) { u32x2 w; w.x = cvt_pk_bf16(o[0], o[1]); w.y = cvt_pk_bf16(o[2], o[3]); *(u32x2*)(HB + ((size_t)u.pm * BM + lrow) * 1024 + col0 + bj * HALF + n * 16) = w; }
                        }
                    sq += __shfl_xor(sq, 16); sq += __shfl_xor(sq, 32);
                    if (fq == 0) SS[((size_t)u.pm * BM + lrow) * 16 + u.pn * 4 + wc] = sq;
                    asm volatile("" ::: "memory");
                }
        }
    }
};

struct EpiInproj {
    static constexpr bool PERM = true, AFTER_DRAIN = false;
    const float* RSTD; bf16_t* QZ; float* FZ; bf16_t* VB; bf16_t* GB; bf16_t* XBC; float* DT;
    const float* hgn; const float* dtb; float* convp; float* convs;
    __device__ __forceinline__ void operator()(const f32x4 (&acc)[2][2][4][2], const Unit& u, int wr, int wc, int fr, int fq) const {
        const int type = u.pn;
        const int row0 = u.pm * BM + wr * 64 + fr;
        float rs8[8];
#pragma unroll
        for (int i = 0; i < 8; ++i) rs8[i] = RSTD[row0 + (i >> 2) * HALF + (i & 3) * 16];
#pragma unroll
        for (int ai = 0; ai < 2; ++ai)
#pragma unroll
            for (int m = 0; m < 4; ++m) {
                const int row = row0 + ai * HALF + m * 16;
                const float rs = rs8[ai * 4 + m];
#pragma unroll
                for (int bj = 0; bj < 2; ++bj) {
                    const int c0 = 128 * bj + 32 * wc + 8 * fq;
                    float v[8];
#pragma unroll
                    for (int n = 0; n < 2; ++n)
#pragma unroll
                        for (int j = 0; j < 4; ++j) v[n * 4 + j] = acc[ai][bj][m][n][j] * rs;
                    if (type < 2 || (type >= 8 && type < 10)) {
                        const int col = (type < 2 ? 256 * type : 512 + 256 * (type - 8)) + c0;
#pragma unroll
                        for (int j = 0; j < 8; ++j) v[j] = silu_f(v[j]);
                        u32x4 w; w.x = cvt_pk_bf16(v[0], v[1]); w.y = cvt_pk_bf16(v[2], v[3]); w.z = cvt_pk_bf16(v[4], v[5]); w.w = cvt_pk_bf16(v[6], v[7]);
                        *(u32x4*)(QZ + (size_t)row * 1024 + col) = w;
                    } else if (type < 4) {
                        const int col = 256 * (type - 2) + c0;
                        *(f32x4*)(FZ + (size_t)row * 512 + col) = (f32x4){v[0], v[1], v[2], v[3]};
                        *(f32x4*)(FZ + (size_t)row * 512 + col + 4) = (f32x4){v[4], v[5], v[6], v[7]};
                    } else if (type < 6) {
                        const int col = 256 * (type - 4) + c0;
                        u32x4 w; w.x = cvt_pk_bf16(v[0], v[1]); w.y = cvt_pk_bf16(v[2], v[3]); w.z = cvt_pk_bf16(v[4], v[5]); w.w = cvt_pk_bf16(v[6], v[7]);
                        *(u32x4*)(VB + (size_t)row * 512 + col) = w;
                    } else if (type < 8) {
                        const int col = 256 * (type - 6) + c0;
                        const f32x4 n0 = *(const f32x4*)(hgn + col), n1 = *(const f32x4*)(hgn + col + 4);
#pragma unroll
                        for (int j = 0; j < 4; ++j) { v[j] = silu_f(v[j]) * n0[j]; v[4 + j] = silu_f(v[4 + j]) * n1[j]; }
                        u32x4 w; w.x = cvt_pk_bf16(v[0], v[1]); w.y = cvt_pk_bf16(v[2], v[3]); w.z = cvt_pk_bf16(v[4], v[5]); w.w = cvt_pk_bf16(v[6], v[7]);
                        *(u32x4*)(GB + (size_t)row * 512 + col) = w;
                    } else if (type < 14) {
                        const int col = 256 * (type - 10) + c0;
                        u32x4 w; w.x = cvt_pk_bf16(v[0], v[1]); w.y = cvt_pk_bf16(v[2], v[3]); w.z = cvt_pk_bf16(v[4], v[5]); w.w = cvt_pk_bf16(v[6], v[7]);
                        *(u32x4*)(XBC + (size_t)row * 1024 + col) = w;
                        float* cs = nullptr;
                        if (row < 16384) { const int t = row & 2047; if (t >= 2045) cs = convp + ((size_t)(row >> 11) * 3 + (t - 2045)) * 1024 + col; }
                        else if (row >= 16400 && row < 16528) cs = convs + ((size_t)(row - 16400) * 3 + 2) * 1024 + col;
                        if (cs) { *(f32x4*)cs = (f32x4){v[0], v[1], v[2], v[3]}; *(f32x4*)(cs + 4) = (f32x4){v[4], v[5], v[6], v[7]}; }
                    } else {
                        if (bj == 0 && wc == 0 && fq == 0) {
                            float d[8];
#pragma unroll
                            for (int j = 0; j < 8; ++j) { const float x = v[j] + dtb[j]; d[j] = x > 20.f ? x : log1pf(__expf(x)); }
                            *(f32x4*)(DT + (size_t)row * 8) = (f32x4){d[0], d[1], d[2], d[3]};
                            *(f32x4*)(DT + (size_t)row * 8 + 4) = (f32x4){d[4], d[5], d[6], d[7]};
                        }
                    }
                }
            }
    }
};
template <class Epi, class Sched, bool ALIGN_EPI = false, bool SP2 = false>
__device__ __forceinline__ void gemm_phase(PG8_LAS unsigned char* lds, const Gemm g, const Sched& S, const Epi& E, float* slab) {
    int tid_ = threadIdx.x; asm volatile("" : "+v"(tid_));
    const int tid = tid_, wid = __builtin_amdgcn_readfirstlane(tid >> 6), lane = tid & 63, wr = wid >> 2, wc = wid & 3, fr = lane & 15, fq = lane >> 4;
    const int K = g.K;
    unsigned voffA[2], voffB[2]; int aoff, boff;
#define PG8_LANE_OFFSETS(T_) do { _Pragma("unroll") for (int i = 0; i < 2; ++i) { int R, C; stage_rc((T_) * 16 + i * 8192, R, C); const int Rb = Epi::PERM ? ((R & ~31) + perm32(R & 31)) : R; \
        voffA[i] = (unsigned)(R * (g.lda ? g.lda : BK) + C) * 2u; voffB[i] = (unsigned)(Rb * K + C) * 2u; } \
        aoff = lds_byte((((T_) >> 8) & 1) * 64 + ((T_) & 15), (((T_) >> 4) & 3) * 8); boff = lds_byte((((T_) >> 6) & 3) * 32 + ((T_) & 15), (((T_) >> 4) & 3) * 8); } while (0)
    PG8_LANE_OFFSETS(tid);
    const size_t kstep = (size_t)(BK * 2), kstepA = g.lda ? (size_t)(BK * 2) : (size_t)(BM * BK * 2);
    const size_t hstep = (size_t)HALF * K * 2, hstepA = g.lda ? (size_t)HALF * g.lda * 2 : (size_t)(HALF * BK * 2);
    const size_t tstep = 2 * hstep, tstepA = g.lda ? 2 * hstepA : (size_t)(K / BK) * (BM * BK * 2);
    const unsigned ldsw = (unsigned)wid * 1024u;
#define PG8_SA(b, h) (((b) * 2 + (h)) * HTB)
#define PG8_SB(b, h) ((4 + (b) * 2 + (h)) * HTB)
#define PG8_STAGE(bufoff, gbase, voff) do { _Pragma("unroll") for (int _i = 0; _i < 2; ++_i) \
        __builtin_amdgcn_global_load_lds((const unsigned*)((const char*)(gbase) + (voff)[_i]), (PG8_LAS unsigned*)(lds + (bufoff) + ldsw + _i * 8192), 16, 0, 0); } while (0)
#define PG8_LDA(dst, b, h) do { _Pragma("unroll") for (int m = 0; m < 4; ++m) _Pragma("unroll") for (int k = 0; k < 2; ++k) dst[m][k] = *(const PG8_LAS bf16x8*)(lds + PG8_SA(b, h) + aoff + m * 2048 + k * 1024); } while (0)
#define PG8_LDB(dst, b, h) do { _Pragma("unroll") for (int n = 0; n < 2; ++n) _Pragma("unroll") for (int k = 0; k < 2; ++k) dst[n][k] = *(const PG8_LAS bf16x8*)(lds + PG8_SB(b, h) + boff + n * 2048 + k * 1024); } while (0)
#define PG8_MMA(ai, bj, At, Bt) do { __builtin_amdgcn_s_setprio(1); _Pragma("unroll") for (int m = 0; m < 4; ++m) _Pragma("unroll") for (int n = 0; n < 2; ++n) _Pragma("unroll") for (int k = 0; k < 2; ++k) \
        acc[ai][bj][m][n] = __builtin_amdgcn_mfma_f32_16x16x32_bf16(Bt[n][k], At[m][k], acc[ai][bj][m][n], 0, 0, 0); __builtin_amdgcn_s_setprio(0); } while (0)
#define PG8_WAIT_V(n) asm volatile("s_waitcnt vmcnt(" #n ")" ::: "memory")
#define PG8_WAIT_L(n) asm volatile("s_waitcnt lgkmcnt(" #n ")" ::: "memory")
#define PG8_BAR __builtin_amdgcn_s_barrier()
#define PG8_SCHED __builtin_amdgcn_sched_barrier(0)
    Unit cur, nxt; int ui = 0;
    if (!S.next(0, cur)) return;
    f32x4 acc[2][2][4][2];
#pragma unroll
    for (int a = 0; a < 2; ++a)
#pragma unroll
        for (int b = 0; b < 2; ++b)
#pragma unroll
            for (int m = 0; m < 4; ++m)
#pragma unroll
                for (int n = 0; n < 2; ++n) acc[a][b][m][n] = (f32x4){0.f, 0.f, 0.f, 0.f};
    bf16x8 At[4][2], B0[2][2], B1[2][2];
    const char* cA = (const char*)g.A + (size_t)cur.pm * tstepA + (size_t)cur.k0 * kstepA; const char* cB = (const char*)g.Bt + (size_t)cur.pn * tstep + (size_t)cur.k0 * kstep;
    if constexpr (SP2) {
        PG8_STAGE(PG8_SB(0, 0), cB, voffB); PG8_STAGE(PG8_SB(0, 1), cB + hstep, voffB); PG8_STAGE(PG8_SA(0, 0), cA, voffA); PG8_STAGE(PG8_SA(0, 1), cA + hstepA, voffA);
        if (wr == 1) PG8_BAR;
        PG8_WAIT_V(2); PG8_BAR;
        PG8_STAGE(PG8_SB(1, 0), cB + kstep, voffB); PG8_STAGE(PG8_SA(1, 0), cA + kstepA, voffA); PG8_STAGE(PG8_SB(1, 1), cB + hstep + kstep, voffB);
        PG8_WAIT_V(6); PG8_BAR;
    } else {
        PG8_STAGE(PG8_SB(0, 0), cB, voffB); PG8_STAGE(PG8_SA(0, 0), cA, voffA); PG8_STAGE(PG8_SB(0, 1), cB + hstep, voffB); PG8_STAGE(PG8_SA(0, 1), cA + hstepA, voffA);
        if (wr == 1) PG8_BAR;
        PG8_WAIT_V(4); PG8_BAR;
        PG8_STAGE(PG8_SB(1, 0), cB + kstep, voffB); PG8_STAGE(PG8_SA(1, 0), cA + kstepA, voffA); PG8_STAGE(PG8_SB(1, 1), cB + hstep + kstep, voffB);
        PG8_WAIT_V(6); PG8_BAR;
    }
    for (;;) {
        const bool has_next = S.next(ui + 1, nxt);
        const char* nA = has_next ? (const char*)g.A + (size_t)nxt.pm * tstepA + (size_t)nxt.k0 * kstepA : cA; const char* nB = has_next ? (const char*)g.Bt + (size_t)nxt.pn * tstep + (size_t)nxt.k0 * kstep : cB;
        const int nt = cur.nt;
        for (int t = 0; t < nt; t += 2) {
            const bool last = (t == nt - 2);
            const char* a1 = cA + (size_t)(t + 1) * kstepA;
            const char* a2 = last ? nA : cA + (size_t)(t + 2) * kstepA; const char* b2 = last ? nB : cB + (size_t)(t + 2) * kstep;
            const char* a3 = a2 + kstepA; const char* b3 = b2 + kstep;
            if constexpr (SP2) {
            PG8_LDB(B0, 0, 0); PG8_LDB(B1, 0, 1); PG8_SCHED; PG8_LDA(At, 0, 0); PG8_STAGE(PG8_SA(1, 1), a1 + hstepA, voffA);
            PG8_WAIT_V(8); PG8_WAIT_L(0); PG8_BAR; PG8_MMA(0, 0, At, B0); PG8_MMA(0, 1, At, B1); PG8_BAR; PG8_SCHED;
            PG8_LDA(At, 0, 1); PG8_STAGE(PG8_SB(0, 0), b2, voffB); PG8_STAGE(PG8_SB(0, 1), b2 + hstep, voffB); PG8_STAGE(PG8_SA(0, 0), a2, voffA);
            PG8_WAIT_V(8); PG8_WAIT_L(0); PG8_BAR; PG8_MMA(1, 0, At, B0); PG8_MMA(1, 1, At, B1); PG8_BAR; PG8_SCHED;
            PG8_LDB(B0, 1, 0); PG8_LDB(B1, 1, 1); PG8_SCHED; PG8_LDA(At, 1, 0); PG8_STAGE(PG8_SA(0, 1), a2 + hstepA, voffA);
            PG8_WAIT_V(8); PG8_WAIT_L(0); PG8_BAR; PG8_MMA(0, 0, At, B0); PG8_MMA(0, 1, At, B1); PG8_BAR; PG8_SCHED;
            PG8_LDA(At, 1, 1); PG8_STAGE(PG8_SB(1, 0), b3, voffB); PG8_STAGE(PG8_SB(1, 1), b3 + hstep, voffB); PG8_STAGE(PG8_SA(1, 0), a3, voffA);
            PG8_WAIT_V(8); PG8_WAIT_L(0); PG8_BAR; PG8_MMA(1, 0, At, B0); PG8_MMA(1, 1, At, B1); PG8_BAR; PG8_SCHED;
            } else {
            PG8_LDB(B0, 0, 0); PG8_SCHED; PG8_LDA(At, 0, 0); PG8_STAGE(PG8_SA(1, 1), a1 + hstepA, voffA);
            PG8_WAIT_L(8); PG8_BAR; PG8_WAIT_L(0); PG8_MMA(0, 0, At, B0); PG8_BAR; PG8_SCHED;
            PG8_LDB(B1, 0, 1); PG8_STAGE(PG8_SB(0, 0), b2, voffB);
            PG8_BAR; PG8_WAIT_L(0); PG8_MMA(0, 1, At, B1); PG8_BAR;
            PG8_LDA(At, 0, 1); PG8_STAGE(PG8_SA(0, 0), a2, voffA);
            PG8_BAR; PG8_WAIT_L(0); PG8_MMA(1, 0, At, B0); PG8_BAR; PG8_SCHED;
            PG8_STAGE(PG8_SB(0, 1), b2 + hstep, voffB);
            PG8_WAIT_V(6); PG8_BAR; PG8_MMA(1, 1, At, B1); PG8_BAR;
            PG8_LDB(B0, 1, 0); PG8_SCHED; PG8_LDA(At, 1, 0); PG8_STAGE(PG8_SA(0, 1), a2 + hstepA, voffA);
            PG8_WAIT_L(8); PG8_BAR; PG8_WAIT_L(0); PG8_MMA(0, 0, At, B0); PG8_BAR; PG8_SCHED;
            PG8_LDB(B1, 1, 1); PG8_STAGE(PG8_SB(1, 0), b3, voffB);
            PG8_BAR; PG8_WAIT_L(0); PG8_MMA(0, 1, At, B1); PG8_BAR;
            PG8_LDA(At, 1, 1); PG8_STAGE(PG8_SA(1, 0), a3, voffA);
            PG8_BAR; PG8_WAIT_L(0); PG8_MMA(1, 0, At, B0); PG8_BAR; PG8_SCHED;
            PG8_STAGE(PG8_SB(1, 1), b3 + hstep, voffB);
            PG8_WAIT_V(6); PG8_BAR; PG8_MMA(1, 1, At, B1); PG8_BAR;
            }
        }
        if constexpr (ALIGN_EPI) { if (wr == 0) PG8_BAR; }
        if (cur.kind == 1) {
            float* sb = slab + (size_t)cur.slot * 65536;
#pragma unroll
            for (int a = 0; a < 2; ++a)
#pragma unroll
                for (int m = 0; m < 4; ++m) {
                    int lrow = a * HALF + wr * 64 + m * 16 + fr; asm volatile("" : "+v"(lrow));
                    float* rp = sb + (size_t)lrow * 256 + wc * 32 + 4 * fq;
#pragma unroll
                    for (int b = 0; b < 2; ++b)
#pragma unroll
                        for (int n = 0; n < 2; ++n) *(f32x4*)(rp + b * HALF + n * 16) = acc[a][b][m][n];
                }
        } else {
            E(acc, cur, wr, wc, fr, fq);
        }
        if (!has_next) break;
#pragma unroll
        for (int a = 0; a < 2; ++a)
#pragma unroll
            for (int b = 0; b < 2; ++b)
#pragma unroll
                for (int m = 0; m < 4; ++m)
#pragma unroll
                    for (int n = 0; n < 2; ++n) acc[a][b][m][n] = (f32x4){0.f, 0.f, 0.f, 0.f};
        cur = nxt; cA = nA; cB = nB; ++ui;
        if constexpr (ALIGN_EPI) { if (wr == 1) PG8_BAR; }
    }
    PG8_WAIT_V(0);
    if constexpr (!ALIGN_EPI) { if (wr == 0) PG8_BAR; }
    PG8_BAR;
#undef PG8_LANE_OFFSETS
#undef PG8_SA
#undef PG8_SB
#undef PG8_STAGE
#undef PG8_LDA
#undef PG8_LDB
#undef PG8_MMA
#undef PG8_WAIT_V
#undef PG8_WAIT_L
#undef PG8_BAR
#undef PG8_SCHED
}
}
constexpr int NWAVES = 8;
constexpr int D = 1024, NBATCH = 8, SEQ = 2048, NMETA = 16, NSMP = 128, FF = 2816;
constexpr int MP = NBATCH * SEQ;
constexpr int ROW_META = MP, ROW_SMP = MP + NMETA;
constexpr int M = 16640;
constexpr int NIN = 3592, NINP = 3840;
constexpr int LDH = 0;
constexpr int CH = 64, NCH = SEQ / CH;
constexpr float EPS = 1e-6f;
constexpr size_t O_YP = 0, O_YS = O_YP + (size_t)MP * D, O_HGP = O_YS + (size_t)NSMP * D, O_SSP = O_HGP + (size_t)NBATCH * 4 * 128 * 128, O_CVP = O_SSP + (size_t)NBATCH * 8 * 64 * 128,
                 O_HGS = O_CVP + (size_t)NBATCH * 3 * 1024, O_SSS = O_HGS + (size_t)NSMP * 4 * 128 * 128, O_CVS = O_SSS + (size_t)NSMP * 8 * 64 * 128, O_END = O_CVS + (size_t)NSMP * 3 * 1024;
constexpr size_t KiB = 1024, MiB = 1u << 20;
constexpr size_t WS_CTL = 0, CTL_ZERO_BYTES = 1 * MiB;
constexpr size_t WS_WGU1 = 1 * MiB, WS_WD1 = 12 * MiB, WS_WIN = 17 * MiB + 512 * KiB, WS_WOUT = 25 * MiB, WS_WGU2 = 27 * MiB, WS_WD2 = 38 * MiB;
constexpr size_t WS_HB = 44 * MiB;
constexpr size_t WS_R = 77 * MiB;
constexpr size_t WS_H = WS_R;
constexpr size_t WS_QZ = 77 * MiB;
constexpr size_t WS_FZ = 110 * MiB;
constexpr size_t WS_VB = 143 * MiB;
constexpr size_t WS_GB = 160 * MiB;
constexpr size_t WS_XBC = 177 * MiB;
constexpr size_t WS_UM = 210 * MiB;
constexpr size_t WS_DT = 243 * MiB;
constexpr size_t WS_ER = 244 * MiB, WS_EL = 245 * MiB;
constexpr size_t WS_DCY = 246 * MiB;
constexpr size_t WS_LB = 246 * MiB + 512 * KiB;
constexpr size_t WS_HX0 = 247 * MiB, WS_HX = 248 * MiB;
constexpr size_t WS_SS1 = 249 * MiB, WS_SS2 = 250 * MiB + 256 * KiB, WS_SS3 = 251 * MiB + 512 * KiB, WS_SS4 = 252 * MiB + 768 * KiB;
constexpr size_t WS_END = 256 * MiB;
constexpr size_t UTH_ENT = 128 * 128;
constexpr size_t UM_ENT = 64 * 128;
static_assert(WS_HB + (size_t)M * 1024 * 2 <= WS_R && (1024 + 4) * UTH_ENT * 2 <= (size_t)MP * D * 4, "hb / UTH (in the y_prompt output region)");
static_assert(WS_H + (size_t)M * FF * 2 <= WS_XBC && WS_QZ + (size_t)M * 2048 <= WS_FZ && WS_FZ + (size_t)M * 2048 <= WS_VB && WS_VB + (size_t)M * 1024 <= WS_GB && WS_GB + (size_t)M * 1024 <= WS_XBC, "map 1");
static_assert(WS_XBC + (size_t)M * 2048 <= WS_UM && WS_UM + (2048 + 8) * UM_ENT * 2 <= WS_DT && WS_DT + (size_t)M * 32 <= WS_ER && WS_SS4 + (size_t)M * 64 <= WS_END, "map 2");
constexpr int CW_BAR = 4096;
constexpr int RING_BYTES = 131072, LDSCTL_OFF = RING_BYTES, MISC_OFF = LDSCTL_OFF + 320, LDS_BYTES = 147456;

#define GAS __attribute__((address_space(1)))
#define LAS __attribute__((address_space(3)))
typedef unsigned short bf16;
typedef unsigned v4u __attribute__((ext_vector_type(4)));
typedef float f32x4 __attribute__((ext_vector_type(4)));
typedef float f32x16 __attribute__((ext_vector_type(16)));
typedef short bf16x8 __attribute__((ext_vector_type(8)));
typedef GAS unsigned gu32;
#define RLX_AGENT __ATOMIC_RELAXED, __HIP_MEMORY_SCOPE_AGENT
#define LDS_WAIT() asm volatile("s_waitcnt lgkmcnt(0)" ::: "memory")
#define VM_WAIT() asm volatile("s_waitcnt vmcnt(0)" ::: "memory")
typedef __bf16 bf16x2_t __attribute__((ext_vector_type(2)));
__device__ __forceinline__ unsigned pk2(float lo, float hi) { bf16x2_t v; v.x = (__bf16)lo; v.y = (__bf16)hi; return __builtin_bit_cast(unsigned, v); }
__device__ __forceinline__ unsigned f2bf(float f) { return (unsigned)__builtin_bit_cast(unsigned short, (__bf16)f); }
__device__ __forceinline__ float bf2f(unsigned short b) { return __builtin_bit_cast(float, (unsigned)b << 16); }
__device__ __forceinline__ float sigm(float x) { return __builtin_amdgcn_rcpf(1.0f + __expf(-x)); }
__device__ __forceinline__ float silu(float x) { return x * __builtin_amdgcn_rcpf(1.0f + __expf(-x)); }
#define XB_TMO      128
#define XB_XCNT(j)  (256  + 64 * (j))
#define XB_XSUB(j)  (1280 + 64 * (j))
#define XB_XGEN(j)  (2304 + 64 * (j))
#define XB_TOP      3328
#define XB_TOPGEN   3392
#define XCD_BAR_WORDS 3456
#define XB_SPIN_CAP (1u << 18)

__device__ __forceinline__ unsigned xb_ld(unsigned* p)              { return __hip_atomic_load(p, __ATOMIC_RELAXED, __HIP_MEMORY_SCOPE_AGENT); }
__device__ __forceinline__ unsigned xb_add(unsigned* p, unsigned v) { return __hip_atomic_fetch_add(p, v, __ATOMIC_RELAXED, __HIP_MEMORY_SCOPE_AGENT); }
__device__ __forceinline__ unsigned xb_xcc_id() { return (unsigned)__builtin_amdgcn_s_getreg((3 << 11) | 20) & 0xFu; }
#define XB_SPIN(cond, bar) do { unsigned _sp = 0; while (cond) { __builtin_amdgcn_s_sleep(1); \
    if ((++_sp & 255u) == 0u) { if (xb_ld(&(bar)[XB_TMO])) break; if (_sp > XB_SPIN_CAP) { atomicAdd(&(bar)[XB_TMO], 1u); break; } } } } while (0)

struct XcdBarrier {
    unsigned* bar; unsigned x;
    volatile LAS unsigned* st;
};

__device__ __forceinline__ XcdBarrier xcd_barrier_post(unsigned* bar, volatile LAS unsigned* st) {
    XcdBarrier b; b.bar = bar; b.x = xb_xcc_id(); b.st = st;
    if (threadIdx.x == 0) (void)xb_add(&bar[XB_XCNT(b.x)], 1u);
    return b;
}
__device__ __forceinline__ void xcd_barrier_complete(unsigned* bar, unsigned x, unsigned& nloc, unsigned& nx) {
    const unsigned G = gridDim.x * gridDim.y * gridDim.z;
    unsigned sum, cnt, mine, sp = 0u;
    for (;;) {
        sum = 0u; cnt = 0u; mine = 0u;
#pragma unroll
        for (unsigned j = 0; j < 16; ++j) { const unsigned c = xb_ld(&bar[XB_XCNT(j)]); sum += c; cnt += (c > 0u) ? 1u : 0u; mine = (j == x) ? c : mine; }
        if (sum == G) break;
        __builtin_amdgcn_s_sleep(1);
        if ((++sp & 255u) == 0u) { if (xb_ld(&bar[XB_TMO])) break; if (sp > XB_SPIN_CAP) { atomicAdd(&bar[XB_TMO], 1u); break; } }
    }
    nloc = mine > 0u ? mine : 1u; nx = cnt > 0u ? cnt : 1u;
}

__device__ __forceinline__ void xcd_barrier(const XcdBarrier& b) {
    asm volatile("s_waitcnt vmcnt(0)" ::: "memory");
    __syncthreads();
    if (threadIdx.x == 0) {
        unsigned* bar = b.bar;
        __builtin_amdgcn_s_waitcnt(0);
        unsigned nloc = b.st[0], nx = b.st[1];
        if (nloc == 0u) { xcd_barrier_complete(bar, b.x, nloc, nx); b.st[0] = nloc; b.st[1] = nx; }
        const unsigned old = xb_add(&bar[XB_XSUB(b.x)], 1u);
        const unsigned gen = old / nloc;
        if (old + 1u == (gen + 1u) * nloc) {
            __builtin_amdgcn_fence(__ATOMIC_RELEASE, "agent");
            asm volatile("s_waitcnt vmcnt(0)" ::: "memory");
            const unsigned og = xb_add(&bar[XB_TOP], 1u);
            const unsigned tg = og / nx;
            if (og + 1u == (tg + 1u) * nx) xb_add(&bar[XB_TOPGEN], 1u);
            else XB_SPIN(xb_ld(&bar[XB_TOPGEN]) == tg, bar);
            __builtin_amdgcn_fence(__ATOMIC_ACQUIRE, "agent");
            xb_add(&bar[XB_XGEN(b.x)], 1u);
            asm volatile("s_waitcnt vmcnt(0)" ::: "memory");
        } else {
            XB_SPIN(xb_ld(&bar[XB_XGEN(b.x)]) == gen, bar);
            __builtin_amdgcn_fence(__ATOMIC_ACQUIRE, "agent");
            asm volatile("s_waitcnt vmcnt(0)" ::: "memory");
        }
    }
    __syncthreads();
}
struct Frame {
    LAS unsigned char* lds;
    volatile LAS unsigned* MISC;
    gu32* ctl;
    int tid, lane, wave, vcu, G;
    GAS float* out; GAS unsigned char* ws;
};
#define WSP(T, off) ((T*)(F.ws + (off)))
#define OUTP(off) ((float*)(F.out + (off)))
#define UTHP ((bf16*)OUTP(O_YP))
constexpr int TAB_OFF = MISC_OFF + 256;
__device__ __forceinline__ const float* inp(const Frame& F, int k) {
    const unsigned long long v = ((const LAS unsigned long long*)(F.lds + TAB_OFF))[k];
    const unsigned lo = __builtin_amdgcn_readfirstlane((unsigned)v), hi = __builtin_amdgcn_readfirstlane((unsigned)(v >> 32));
    return (const float*)(const GAS float*)(((unsigned long long)hi << 32) | lo);
}
__device__ __forceinline__ float wave_sum(float v) {
#pragma unroll
    for (int o = 1; o < 64; o <<= 1) v += __shfl_xor(v, o);
    return v;
}
__device__ __forceinline__ float half_sum32(float v) {
#pragma unroll
    for (int o = 1; o < 32; o <<= 1) v += __shfl_xor(v, o);
    return v;
}
__device__ __forceinline__ float rowsum16(const float (&v)[16], int lane, int& rsel) {
    const bool b4 = (lane & 16) != 0, b3 = (lane & 8) != 0, b2 = (lane & 4) != 0, b1 = (lane & 2) != 0;
    float a[8], b[4], c2[2];
#pragma unroll
    for (int j = 0; j < 8; ++j) { const float t = __shfl_xor(b4 ? v[j] : v[j + 8], 16); a[j] = (b4 ? v[j + 8] : v[j]) + t; }
#pragma unroll
    for (int j = 0; j < 4; ++j) { const float t = __shfl_xor(b3 ? a[j] : a[j + 4], 8); b[j] = (b3 ? a[j + 4] : a[j]) + t; }
#pragma unroll
    for (int j = 0; j < 2; ++j) { const float t = __shfl_xor(b2 ? b[j] : b[j + 2], 4); c2[j] = (b2 ? b[j + 2] : b[j]) + t; }
    float d = (b1 ? c2[1] : c2[0]) + __shfl_xor(b1 ? c2[0] : c2[1], 2);
    d += __shfl_xor(d, 1);
    rsel = (b4 ? 8 : 0) + (b3 ? 4 : 0) + (b2 ? 2 : 0) + (b1 ? 1 : 0);
    return d;
}
__device__ __forceinline__ void tr_item(const float* W, int N, int K, int k0, int n0, const float* nw, bf16* dst, LAS float* scr, int lane) {
    float v[32];
    const int n = n0 + (lane & 31);
#pragma unroll
    for (int i = 0; i < 32; ++i) { const int kk = 2 * i + (lane >> 5); v[i] = (n < N) ? W[(size_t)(k0 + kk) * N + n] : 0.f; }
    if (nw) {
#pragma unroll
        for (int i = 0; i < 32; ++i) v[i] *= nw[k0 + 2 * i + (lane >> 5)];
    }
#pragma unroll
    for (int i = 0; i < 32; ++i) scr[(2 * i + (lane >> 5)) * 33 + (lane & 31)] = v[i];
    LDS_WAIT(); asm volatile("" ::: "memory");
    const int c = lane & 7;
#pragma unroll
    for (int j = 0; j < 4; ++j) { const int nn = (lane >> 3) + 8 * j; const LAS float* s = scr + (8 * c) * 33 + nn;
        v4u o; o.x = pk2(s[0 * 33], s[1 * 33]); o.y = pk2(s[2 * 33], s[3 * 33]); o.z = pk2(s[4 * 33], s[5 * 33]); o.w = pk2(s[6 * 33], s[7 * 33]);
        *(GAS v4u*)(dst + (size_t)nn * K + k0 + 8 * c) = o; }
    LDS_WAIT(); asm volatile("" ::: "memory");
}
constexpr int P0_I_GU = 16 * 88, P0_I_IN = 16 * 120, P0_I_OUT = 16 * 32, P0_NITEMS = 6 * P0_I_GU + P0_I_IN + P0_I_OUT, P0_ITEMS_FIRST = 2 * P0_I_GU;
__device__ __forceinline__ void p0_weight_items(Frame& F, int lo, int hi, int iw, int nw_) {
    LAS float* scr = (LAS float*)(F.lds + F.wave * 16384);
    const int lane = F.lane;
    constexpr int I_GU = P0_I_GU, I_DN = 44 * 32, I_IN = P0_I_IN;
    static_assert(I_DN == I_GU, "items");
    for (int it = lo + iw; it < hi; it += nw_) {
        int r = it;
        if (r < 6 * I_GU) {
            const int which = r / I_GU; r -= which * I_GU;
            const int ffn = which / 3, kind = which % 3;
            if (kind < 2) {
                const int kb = r / 88, nb = r % 88, n0 = 32 * nb, k0 = 64 * kb;
                const float* W = ffn ? (kind ? inp(F, 23) : inp(F, 22)) : (kind ? inp(F, 9) : inp(F, 8)); const float* nw = ffn ? inp(F, 21) : inp(F, 7);
                bf16* base = WSP(bf16, ffn ? WS_WGU2 : WS_WGU1);
                const int drow = 256 * (n0 >> 7) + (n0 & 127) + 128 * kind;
                tr_item(W, FF, 1024, k0, n0, nw, base + (size_t)drow * 1024, scr, lane);
            } else {
                const int kb = r / 32, nb = r % 32, n0 = 32 * nb, k0 = 64 * kb;
                const float* W = ffn ? inp(F, 24) : inp(F, 10);
                bf16* base = WSP(bf16, ffn ? WS_WD2 : WS_WD1);
                tr_item(W, 1024, FF, k0, n0, nullptr, base + (size_t)n0 * FF, scr, lane);
            }
            continue;
        }
        r -= 6 * I_GU;
        if (r < I_IN) { const int kb = r / 120, nb = r % 120, n0 = 32 * nb, k0 = 64 * kb;
            tr_item(inp(F, 12), NIN, 1024, k0, n0, inp(F, 11), WSP(bf16, WS_WIN) + (size_t)n0 * 1024, scr, lane); continue; }
        r -= I_IN;
        { const int kb = r / 32, nb = r % 32, n0 = 32 * nb, k0 = 64 * kb;
          tr_item(inp(F, 20), 1024, 1024, k0, n0, nullptr, WSP(bf16, WS_WOUT) + (size_t)n0 * 1024, scr, lane); }
    }
}
__device__ __forceinline__ void p0_prologue(Frame& F, int defer) {
    const int gw = F.vcu * NWAVES + F.wave, NGW = F.G * NWAVES, lane = F.lane;
    p0_weight_items(F, 0, defer ? P0_ITEMS_FIRST : P0_NITEMS, gw, NGW);
    bf16* HB = WSP(bf16, WS_HB); float* RS1 = WSP(float, WS_SS1); float* HX0 = WSP(float, WS_HX0);
    {
        const float* x0 = inp(F, 0); const float* xm = inp(F, 5); const float* xs = inp(F, 1);
#define ROWSRC(m) ((m) < MP ? x0 + (size_t)(m) * D : (m) < ROW_SMP ? xm + (size_t)((m) - ROW_META) * D : (m) < ROW_SMP + NSMP ? xs + (size_t)((m) - ROW_SMP) * D : nullptr)
        f32x4 nx[4];
        { const float* src = gw < M ? ROWSRC(gw) : nullptr;
#pragma unroll
          for (int j = 0; j < 4; ++j) nx[j] = src ? ((const GAS f32x4*)src)[lane + 64 * j] : (f32x4){0.f, 0.f, 0.f, 0.f}; }
        for (int m = gw; m < M; m += NGW) {
            f32x4 v[4]; float s = 0.f;
#pragma unroll
            for (int j = 0; j < 4; ++j) v[j] = nx[j];
            { const int mn = m + NGW; const float* src = mn < M ? ROWSRC(mn) : nullptr;
#pragma unroll
              for (int j = 0; j < 4; ++j) nx[j] = src ? ((const GAS f32x4*)src)[lane + 64 * j] : (f32x4){0.f, 0.f, 0.f, 0.f}; }
#pragma unroll
            for (int j = 0; j < 4; ++j) s += (v[j][0] * v[j][0] + v[j][1] * v[j][1]) + (v[j][2] * v[j][2] + v[j][3] * v[j][3]);
            s = wave_sum(s);
            GAS unsigned long long* o8 = (GAS unsigned long long*)(HB + (size_t)m * D) + lane;
#pragma unroll
            for (int j = 0; j < 4; ++j) o8[64 * j] = (unsigned long long)pk2(v[j][0], v[j][1]) | ((unsigned long long)pk2(v[j][2], v[j][3]) << 32);
            if (lane == 0) RS1[m] = 1.0f / sqrtf(s * (1.0f / 1024.0f) + EPS);
            if (m >= MP) {
#pragma unroll
                for (int j = 0; j < 4; ++j) ((GAS f32x4*)(HX0 + (size_t)(m - MP) * D))[lane + 64 * j] = v[j];
            }
        }
#undef ROWSRC
    }
    if (gw == 0) { float* LB = WSP(float, WS_LB); const float* l = inp(F, 6);
        for (int c = lane; c < 512; c += 64) LB[c] = 1.0f / (1.0f + __expf(l[512 + c] - l[c])); }
}
template <int ppu> __device__ __forceinline__ void fix_extra(Frame& F, int split, const float* slab, const float* RX, float* DX, bf16* HB, const float* SS, float* RSTD, float scale) {
    const int lane = F.lane;
    if (split) {
        LAS float* red = (LAS float*)F.lds;
        for (int lr = F.vcu; lr < 256; lr += F.G) {
            if (F.wave < 4) {
                const int j = F.wave;
                const float* sp = slab + (size_t)j * ppu * 65536 + (size_t)lr * 256 + 4 * lane; f32x4 sum = (f32x4){0.f, 0.f, 0.f, 0.f};
#pragma unroll
                for (int p = 0; p < ppu; ++p) sum = sum + *(const GAS f32x4*)(sp + (size_t)p * 65536);
                const f32x4 v = ((const GAS f32x4*)(RX + (size_t)lr * 1024))[lane + 64 * j] + sum * scale;
                const float ss = wave_sum((v[0] * v[0] + v[1] * v[1]) + (v[2] * v[2] + v[3] * v[3]));
                ((GAS f32x4*)(DX + (size_t)lr * 1024))[lane + 64 * j] = v;
                ((GAS unsigned long long*)(HB + (size_t)(MP + lr) * 1024))[lane + 64 * j] = (unsigned long long)pk2(v[0], v[1]) | ((unsigned long long)pk2(v[2], v[3]) << 32);
                if (lane == 0) red[j] = ss;
            }
            __syncthreads();
            if (F.tid == 0) RSTD[MP + lr] = 1.0f / sqrtf(((red[0] + red[1]) + (red[2] + red[3])) * (1.0f / 1024.0f) + EPS);
            __syncthreads();
        }
    }
    const int gt = F.vcu * (NWAVES * 64) + F.tid, NT = F.G * NWAVES * 64, nrows = split ? MP : M;
    for (int r = gt; r < nrows; r += NT) RSTD[r] = pg8::row_rstd(SS, r);
}
template <int ppu> __device__ __forceinline__ void p8_final(Frame& F, int split, const float* slab) {
    const int gw = F.vcu * NWAVES + F.wave, NGW = F.G * NWAVES, lane = F.lane;
    const float* SS4 = WSP(float, WS_SS4); const float* nf = inp(F, 25);
    f32x4 w[4];
#pragma unroll
    for (int j = 0; j < 4; ++j) w[j] = ((const GAS f32x4*)nf)[lane + 64 * j];
    for (int m = split ? MP + gw : gw; m < MP + NSMP; m += NGW) {
        if (m < MP) {
            float* p = OUTP(O_YP) + (size_t)m * D;
            const float rs = pg8::row_rstd(SS4, m);
#pragma unroll
            for (int j = 0; j < 4; ++j) { f32x4 v = ((const GAS f32x4*)p)[lane + 64 * j]; v = v * rs * w[j]; ((GAS f32x4*)p)[lane + 64 * j] = v; }
        } else {
            const int s = m - MP, lr = NMETA + s; const float* src = WSP(float, WS_HX) + (size_t)lr * D; float* dst = OUTP(O_YS) + (size_t)s * D;
            f32x4 v[4]; float ss = 0.f;
#pragma unroll
            for (int j = 0; j < 4; ++j) { v[j] = ((const GAS f32x4*)src)[lane + 64 * j];
                if (split) { const float* sp = slab + (size_t)j * ppu * 65536 + (size_t)lr * 256 + 4 * lane; f32x4 sum = (f32x4){0.f, 0.f, 0.f, 0.f};
#pragma unroll
                    for (int p = 0; p < ppu; ++p) sum = sum + *(const GAS f32x4*)(sp + (size_t)p * 65536);
                    v[j] = v[j] + sum * 0.5f; }
                ss += (v[j][0] * v[j][0] + v[j][1] * v[j][1]) + (v[j][2] * v[j][2] + v[j][3] * v[j][3]); }
            const float rs = split ? 1.0f / sqrtf(wave_sum(ss) * (1.0f / 1024.0f) + EPS) : pg8::row_rstd(SS4, ROW_SMP + s);
#pragma unroll
            for (int j = 0; j < 4; ++j) ((GAS f32x4*)dst)[lane + 64 * j] = v[j] * rs * w[j];
        }
    }
}
__device__ __forceinline__ int rowreg(int reg, int lane) { return (reg & 3) + 8 * (reg >> 2) + 4 * (lane >> 5); }
template <int K> __device__ __forceinline__ void mma32_ll(f32x16& acc, const LAS bf16* A, int lda, const LAS bf16* B, int ldb, int lane) {
    const LAS bf16* pa = A + (lane & 31) * lda + 8 * (lane >> 5); const LAS bf16* pb = B + (lane & 31) * ldb + 8 * (lane >> 5);
#pragma unroll
    for (int k0 = 0; k0 < K; k0 += 16) { const bf16x8 a = *(const LAS bf16x8*)(pa + k0); const bf16x8 b = *(const LAS bf16x8*)(pb + k0); acc = __builtin_amdgcn_mfma_f32_32x32x16_bf16(a, b, acc, 0, 0, 0); }
}
template <int K> __device__ __forceinline__ void mma32_lg(f32x16& acc, const LAS bf16* A, int lda, const bf16* Bg, int ldb, int lane) {
    const LAS bf16* pa = A + (lane & 31) * lda + 8 * (lane >> 5); const bf16* pb = Bg + (size_t)(lane & 31) * ldb + 8 * (lane >> 5);
#pragma unroll
    for (int kc = 0; kc < K; kc += 64) {
        bf16x8 b[4];
#pragma unroll
        for (int k = 0; k < 4; ++k) b[k] = *(const GAS bf16x8*)(pb + kc + 16 * k);
#pragma unroll
        for (int k = 0; k < 4; ++k) { const bf16x8 a = *(const LAS bf16x8*)(pa + kc + 16 * k); acc = __builtin_amdgcn_mfma_f32_32x32x16_bf16(a, b[k], acc, 0, 0, 0); }
        asm volatile("" ::: "memory");
    }
}
__device__ __forceinline__ void load_frags8(const bf16* Bg, int ldb, int lane, bf16x8 (&b)[8]) {
    const bf16* pb = Bg + (size_t)(lane & 31) * ldb + 8 * (lane >> 5);
#pragma unroll
    for (int k = 0; k < 8; ++k) b[k] = *(const GAS bf16x8*)(pb + 16 * k);
}
__device__ __forceinline__ void mma32_lf8(f32x16& acc, const LAS bf16* A, int lda, const bf16x8 (&b)[8], int lane) {
    const LAS bf16* pa = A + (lane & 31) * lda + 8 * (lane >> 5);
#pragma unroll
    for (int k = 0; k < 8; ++k) { const bf16x8 a = *(const LAS bf16x8*)(pa + 16 * k); acc = __builtin_amdgcn_mfma_f32_32x32x16_bf16(a, b[k], acc, 0, 0, 0); }
}
#define ZERO16 ((f32x16){0.f,0.f,0.f,0.f,0.f,0.f,0.f,0.f,0.f,0.f,0.f,0.f,0.f,0.f,0.f,0.f})

struct HgP { int rowbase, h, nvalid, ent, eidx; };
__device__ __forceinline__ HgP hg_params(int i) {
    HgP p;
    if (i < 1024) { const int b = i >> 7, h = (i >> 5) & 3, c = i & 31; p.rowbase = b * SEQ + c * CH; p.h = h; p.nvalid = CH; p.ent = (b * 4 + h) * 32 + c; p.eidx = b * 32 + c; }
    else { const int h = i - 1024; p.rowbase = ROW_META; p.h = h; p.nvalid = NMETA; p.ent = 1024 + h; p.eidx = 256; }
    return p;
}
struct HgRaw { f32x4 fz[4]; v4u vb[2]; v4u qz[2]; v4u gb[2]; };
template <int PASS> __device__ __forceinline__ void hg_load(Frame& F, const HgP& p, HgRaw& r) {
    const int tid = F.tid;
    const float* FZ = WSP(float, WS_FZ) + (size_t)p.rowbase * 512 + 128 * p.h;
#pragma unroll
    for (int i = 0; i < 4; ++i) { const int idx = tid + 512 * i; r.fz[i] = *(const GAS f32x4*)(FZ + (size_t)(idx >> 5) * 512 + (idx & 31) * 4); }
    const bf16* VB = WSP(bf16, WS_VB) + (size_t)p.rowbase * 512 + 128 * p.h;
#pragma unroll
    for (int i = 0; i < 2; ++i) { const int idx = tid + 512 * i; r.vb[i] = *(const GAS v4u*)(VB + (size_t)(idx >> 4) * 512 + (idx & 15) * 8); }
    if (PASS == 3) { const bf16* QZ = WSP(bf16, WS_QZ) + (size_t)p.rowbase * 1024 + 128 * p.h;
#pragma unroll
        for (int i = 0; i < 2; ++i) { const int idx = tid + 512 * i; r.qz[i] = *(const GAS v4u*)(QZ + (size_t)(idx >> 4) * 1024 + (idx & 15) * 8); }
        const bf16* GB = WSP(bf16, WS_GB) + (size_t)p.rowbase * 512 + 128 * p.h;
#pragma unroll
        for (int i = 0; i < 2; ++i) { const int idx = tid + 512 * i; r.gb[i] = *(const GAS v4u*)(GB + (size_t)(idx >> 4) * 512 + (idx & 15) * 8); } }
}
template <int PASS> __device__ __forceinline__ void hgrn_item(Frame& F, const HgP p, HgRaw& raw, bool has_next, const HgP pn) {
    LAS unsigned char* L = F.lds;
    LAS float* TOT = (LAS float*)L;
    LAS float* FZL = (LAS float*)(L + 2048);
    LAS bf16* VL = (LAS bf16*)(L + 35840);
    LAS bf16* QN = (LAS bf16*)(L + 53248);
    LAS bf16* KN = (LAS bf16*)(L + 70656);
    LAS bf16* VT = (LAS bf16*)(L + 88064);
    LAS bf16* KT = (LAS bf16*)(L + 106496);
    LAS bf16* PP = (LAS bf16*)(L + 106496);
    LAS float* PART = (LAS float*)(L + 124928);
    LAS float* RS = (LAS float*)(L + 125952);
    const int tid = F.tid, lane = F.lane, w = F.wave, c = tid & 127, rg = tid >> 7;
    const int rowbase = p.rowbase, h = p.h;
#pragma unroll
    for (int i = 0; i < 4; ++i) { const int idx = tid + 512 * i; *(LAS f32x4*)(FZL + (idx >> 5) * 132 + (idx & 31) * 4) = raw.fz[i]; }
#pragma unroll
    for (int i = 0; i < 2; ++i) { const int idx = tid + 512 * i; *(LAS v4u*)(VL + (idx >> 4) * 136 + (idx & 15) * 8) = raw.vb[i]; if (PASS == 3) *(LAS v4u*)(QN + (idx >> 4) * 136 + (idx & 15) * 8) = raw.qz[i]; }
    v4u gbr[2]; if (PASS == 3) { gbr[0] = raw.gb[0]; gbr[1] = raw.gb[1]; }
    if (has_next) hg_load<PASS>(F, pn, raw);
    const float lbc = WSP(float, WS_LB)[128 * h + c];
    __syncthreads();
    float bl[16], kk[16], run = 0.f;
#pragma unroll
    for (int i = 0; i < 16; ++i) {
        const int t = rg * 16 + i; const float fz = FZL[t * 132 + c];
        const float sg = sigm(fz), f = lbc + (1.0f - lbc) * sg; float lf = __logf(f), k = (1.0f - lbc) * (1.0f - sg);
        if (t >= p.nvalid) { lf = 0.f; k = 0.f; }
        run += lf; bl[i] = run; kk[i] = k;
    }
    TOT[rg * 128 + c] = run;
    __syncthreads();
    const float t0 = TOT[c], t1 = TOT[128 + c], t2 = TOT[256 + c], t3 = TOT[384 + c];
    const float pre = rg == 0 ? 0.f : rg == 1 ? t0 : rg == 2 ? t0 + t1 : (t0 + t1) + t2;
    const float r = t0 + t1, blast = (t0 + t1) + (t2 + t3);
    unsigned pvv[8];
#pragma unroll
    for (int i = 0; i < 16; i += 2) pvv[i >> 1] = (unsigned)VL[(rg * 16 + i) * 136 + c] | ((unsigned)VL[(rg * 16 + i + 1) * 136 + c] << 16);
    *(LAS v4u*)(VT + c * 72 + rg * 16) = (v4u){pvv[0], pvv[1], pvv[2], pvv[3]}; *(LAS v4u*)(VT + c * 72 + rg * 16 + 8) = (v4u){pvv[4], pvv[5], pvv[6], pvv[7]};
    if (PASS == 1) {
        unsigned pkk[8];
#pragma unroll
        for (int i = 0; i < 16; i += 2) pkk[i >> 1] = pk2(kk[i] * __expf(r - (pre + bl[i])), kk[i + 1] * __expf(r - (pre + bl[i + 1])));
        *(LAS v4u*)(KT + c * 72 + rg * 16) = (v4u){pkk[0], pkk[1], pkk[2], pkk[3]}; *(LAS v4u*)(KT + c * 72 + rg * 16 + 8) = (v4u){pkk[4], pkk[5], pkk[6], pkk[7]};
        if (rg == 0) { WSP(float, WS_ER)[(size_t)p.eidx * 512 + 128 * h + c] = __expf(r); WSP(float, WS_EL)[(size_t)p.eidx * 512 + 128 * h + c] = __expf(blast - r); }
        __syncthreads();
        bf16* UT = UTHP + (size_t)p.ent * UTH_ENT;
        LAS bf16* OUT = (LAS bf16*)(L + 2048);
        const int vt = w >> 1;
#pragma unroll
        for (int q = 0; q < 2; ++q) {
            const int kt = (w & 1) * 2 + q;
            f32x16 acc = ZERO16;
            mma32_ll<64>(acc, VT + vt * 32 * 72, 72, KT + kt * 32 * 72, 72, lane);
#pragma unroll
            for (int reg = 0; reg < 16; ++reg) OUT[(vt * 32 + rowreg(reg, lane)) * 136 + kt * 32 + (lane & 31)] = (bf16)f2bf(acc[reg]);
        }
        __syncthreads();
#pragma unroll
        for (int i = 0; i < 4; ++i) { const int idx = tid + 512 * i, row = idx >> 4, pc = idx & 15; *(GAS v4u*)(UT + (size_t)row * 128 + pc * 8) = *(const LAS v4u*)(OUT + row * 136 + pc * 8); }
        __syncthreads();
    } else {
#pragma unroll
        for (int i = 0; i < 2; ++i) { const int idx = tid + 512 * i; *(LAS v4u*)((LAS bf16*)(L + 2048) + (idx >> 4) * 136 + (idx & 15) * 8) = gbr[i]; }
#pragma unroll
        for (int i = 0; i < 16; ++i) {
            const int t = rg * 16 + i; const float b = pre + bl[i];
            QN[t * 136 + c] = (bf16)f2bf(bf2f(QN[t * 136 + c]) * __expf(b - r));
            KN[t * 136 + c] = (bf16)f2bf(kk[i] * __expf(r - b));
        }
        __syncthreads();
        bf16x8 sfr[8];
        load_frags8(UTHP + (size_t)p.ent * UTH_ENT + (size_t)(w & 3) * 32 * 128, 128, lane, sfr);
        if (w < 4) {
            const int tm = w >> 1, sn = w & 1;
            f32x16 acc = ZERO16;
            if (!(tm == 0 && sn == 1)) mma32_ll<128>(acc, QN + tm * 32 * 136, 136, KN + sn * 32 * 136, 136, lane);
#pragma unroll
            for (int reg = 0; reg < 16; ++reg) { const int t = tm * 32 + rowreg(reg, lane), s = sn * 32 + (lane & 31);
                PP[t * 72 + s] = (s <= t) ? (bf16)f2bf(acc[reg]) : (bf16)0; }
        }
        __syncthreads();
        const int tm = w >> 2, vn = w & 3;
        f32x16 acc = ZERO16;
        mma32_ll<64>(acc, PP + tm * 32 * 72, 72, VT + vn * 32 * 72, 72, lane);
        mma32_lf8(acc, QN + tm * 32 * 136, 136, sfr, lane);
        { float sqv[16]; int rsel;
#pragma unroll
          for (int reg = 0; reg < 16; ++reg) sqv[reg] = acc[reg] * acc[reg];
          const float sq = rowsum16(sqv, lane, rsel); if ((lane & 1) == 0) PART[(tm * 32 + rowreg(rsel, lane)) * 4 + vn] = sq; }
        __syncthreads();
        if (tid < 64) RS[tid] = 1.0f / sqrtf(((PART[tid * 4] + PART[tid * 4 + 1]) + (PART[tid * 4 + 2] + PART[tid * 4 + 3])) * (1.0f / 128.0f) + EPS);
        __syncthreads();
        bf16* QZ = WSP(bf16, WS_QZ);
        LAS bf16* OUT = (LAS bf16*)(L + 2048);
#pragma unroll
        for (int reg = 0; reg < 16; ++reg) { const int t = tm * 32 + rowreg(reg, lane), v = vn * 32 + (lane & 31);
            OUT[t * 136 + v] = (bf16)f2bf(acc[reg] * RS[t] * bf2f(OUT[t * 136 + v])); }
        __syncthreads();
#pragma unroll
        for (int i = 0; i < 2; ++i) { const int idx = tid + 512 * i, row = idx >> 4, pc = idx & 15; *(GAS v4u*)(QZ + (size_t)(rowbase + row) * 1024 + 128 * h + pc * 8) = *(const LAS v4u*)(OUT + row * 136 + pc * 8); }
        __syncthreads();
    }
}

struct MbP { int rowbase, g, nvalid, ent0, estride; const bf16* prev; };
__device__ __forceinline__ bool mb_valid(int o, bool with_meta) { return o < 512 || (with_meta && o >= 516 && o < 518); }
__device__ __forceinline__ MbP mb_params(Frame& F, int j) {
    MbP p; const bf16* XBC = WSP(bf16, WS_XBC);
    if (j < 512) { const int b = j >> 6, g = (j >> 5) & 1, c = j & 31, rb = b * SEQ + c * CH; p.rowbase = rb; p.g = g; p.nvalid = CH; p.ent0 = (b * 8 + 4 * g) * 32 + c; p.estride = 32;
        p.prev = c > 0 ? XBC + (size_t)(rb - 3) * 1024 : XBC + (size_t)(ROW_META + 13) * 1024; }
    else { const int g = j - 516; p.rowbase = ROW_META; p.g = g; p.nvalid = NMETA; p.ent0 = 2048 + 4 * g; p.estride = 1; p.prev = nullptr; }
    return p;
}
struct MbRaw { v4u rx[4]; v4u halo; float dt; };
__device__ __forceinline__ int mb_bccol(int g, int pc) { return pc < 16 ? 512 + 128 * g + pc * 8 : 768 + 128 * g + (pc - 16) * 8; }
template <int PASS> __device__ __forceinline__ void mb_load(Frame& F, const MbP& p, MbRaw& r) {
    const int tid = F.tid; const bf16* X = WSP(bf16, WS_XBC) + (size_t)p.rowbase * 1024;
#pragma unroll
    for (int i = 0; i < 4; ++i) { const int idx = tid + 512 * i, row = idx >> 5, pc = idx & 31;
        r.rx[i] = *(const GAS v4u*)(X + (size_t)row * 1024 + 256 * p.g + pc * 8); }
    r.halo = (v4u){0u, 0u, 0u, 0u};
    if (p.prev && tid < 192) { const int hr = tid >> 6, pc = tid & 63; r.halo = *(const GAS v4u*)(p.prev + (size_t)hr * 1024 + (pc < 32 ? 256 * p.g + pc * 8 : mb_bccol(p.g, pc - 32))); }
    r.dt = 0.f;
    if (tid < 256) { const int t = tid & 63; if (t < p.nvalid) r.dt = WSP(float, WS_DT)[(size_t)(p.rowbase + t) * 8 + 4 * p.g + (tid >> 6)]; }
}
template <int PASS> __device__ __forceinline__ void mamba_item(Frame& F, const MbP p, MbRaw& raw, bool has_next, const MbP pn) {
    LAS unsigned char* L = F.lds;
    LAS float* CUM = (LAS float*)L;
    LAS float* DTV = (LAS float*)(L + 1024);
    LAS bf16* XT = (LAS bf16*)(L + 2048);
    LAS bf16* BT = (LAS bf16*)(L + 38912);
    LAS bf16* BN = (LAS bf16*)(L + 38912);
    LAS bf16* CN = (LAS bf16*)(L + 56320);
    LAS bf16* RAW = (LAS bf16*)(L + 73728);
    const int tid = F.tid, lane = F.lane, w = F.wave, g = p.g, rowbase = p.rowbase;
    if (w < 4) {
        const int head = 4 * g + w;
        const float dt = raw.dt;
        const float A = -__expf(inp(F, 17)[head]);
        float cum = dt * A;
#pragma unroll
        for (int o = 1; o < 64; o <<= 1) { const float n = __shfl_up(cum, o); if (lane >= o) cum += n; }
        const float last = __builtin_bit_cast(float, __builtin_amdgcn_readlane(__builtin_bit_cast(int, cum), 63));
        if (PASS == 1) { CUM[w * 64 + lane] = dt * __expf(last - cum); if (lane == 0) WSP(float, WS_DCY)[p.ent0 + w * p.estride] = __expf(last); }
        else { CUM[w * 64 + lane] = cum; DTV[w * 64 + lane] = dt; }
    }
#pragma unroll
    for (int i = 0; i < 4; ++i) { const int idx = tid + 512 * i; *(LAS v4u*)(RAW + ((idx >> 5) + 3) * 256 + (idx & 31) * 8) = raw.rx[i]; }
    if (tid < 192 && (tid & 63) < 32) *(LAS v4u*)(RAW + (tid >> 6) * 256 + (tid & 63) * 8) = raw.halo;
    __syncthreads();
    v4u rbc[4];
    {   const bf16* X = WSP(bf16, WS_XBC) + (size_t)rowbase * 1024;
#pragma unroll
        for (int i = 0; i < 4; ++i) { const int idx = tid + 512 * i, row = idx >> 5, pc = idx & 31;
            rbc[i] = (PASS == 3 || pc < 16) ? *(const GAS v4u*)(X + (size_t)row * 1024 + mb_bccol(g, pc)) : (v4u){0u, 0u, 0u, 0u}; } }
    const int ch = tid & 255, half = tid >> 8;
    const float* cw = inp(F, 14); const float* cbp = inp(F, 15);
    {
        const int col = 256 * g + ch;
        const float w0 = cw[col], w1 = cw[1024 + col], w2 = cw[2048 + col], w3 = cw[3072 + col], cb = cbp[col];
        float r0 = bf2f(RAW[(half * 32 + 0) * 256 + ch]), r1 = bf2f(RAW[(half * 32 + 1) * 256 + ch]), r2 = bf2f(RAW[(half * 32 + 2) * 256 + ch]);
        unsigned pk[16];
#pragma unroll
        for (int i = 0; i < 32; i += 2) {
            const int t = half * 32 + i;
            const float r3 = bf2f(RAW[(t + 3) * 256 + ch]), r4 = bf2f(RAW[(t + 4) * 256 + ch]);
            float a0 = silu(cb + w0 * r0 + w1 * r1 + w2 * r2 + w3 * r3), a1 = silu(cb + w0 * r1 + w1 * r2 + w2 * r3 + w3 * r4);
            if (PASS == 1) { a0 *= CUM[(ch >> 6) * 64 + t]; a1 *= CUM[(ch >> 6) * 64 + t + 1]; }
            pk[i >> 1] = pk2(a0, a1); r0 = r2; r1 = r3; r2 = r4;
        }
        LAS v4u* d = (LAS v4u*)(XT + ch * 72 + half * 32);
        d[0] = (v4u){pk[0], pk[1], pk[2], pk[3]}; d[1] = (v4u){pk[4], pk[5], pk[6], pk[7]}; d[2] = (v4u){pk[8], pk[9], pk[10], pk[11]}; d[3] = (v4u){pk[12], pk[13], pk[14], pk[15]};
    }
    __syncthreads();
#pragma unroll
    for (int i = 0; i < 4; ++i) { const int idx = tid + 512 * i; *(LAS v4u*)(RAW + ((idx >> 5) + 3) * 256 + (idx & 31) * 8) = rbc[i]; }
    if (tid < 192 && (tid & 63) >= 32) *(LAS v4u*)(RAW + (tid >> 6) * 256 + ((tid & 63) - 32) * 8) = raw.halo;
    if (has_next) mb_load<PASS>(F, pn, raw);
    __syncthreads();
    if (PASS == 3 || ch < 128) {
        const int col = ch < 128 ? 512 + 128 * g + ch : 768 + 128 * g + (ch - 128);
        const float w0 = cw[col], w1 = cw[1024 + col], w2 = cw[2048 + col], w3 = cw[3072 + col], cb = cbp[col];
        float r0 = bf2f(RAW[(half * 32 + 0) * 256 + ch]), r1 = bf2f(RAW[(half * 32 + 1) * 256 + ch]), r2 = bf2f(RAW[(half * 32 + 2) * 256 + ch]);
        unsigned pk[16];
#pragma unroll
        for (int i = 0; i < 32; i += 2) {
            const int t = half * 32 + i;
            const float r3 = bf2f(RAW[(t + 3) * 256 + ch]), r4 = bf2f(RAW[(t + 4) * 256 + ch]);
            const float a0 = silu(cb + w0 * r0 + w1 * r1 + w2 * r2 + w3 * r3), a1 = silu(cb + w0 * r1 + w1 * r2 + w2 * r3 + w3 * r4);
            if (PASS == 1) pk[i >> 1] = pk2(a0, a1);
            else { LAS bf16* dst = ch < 128 ? BN + ch : CN + (ch - 128); dst[t * 136] = (bf16)f2bf(a0); dst[(t + 1) * 136] = (bf16)f2bf(a1); }
            r0 = r2; r1 = r3; r2 = r4;
        }
        if (PASS == 1) { LAS v4u* d = (LAS v4u*)(BT + ch * 72 + half * 32);
            d[0] = (v4u){pk[0], pk[1], pk[2], pk[3]}; d[1] = (v4u){pk[4], pk[5], pk[6], pk[7]}; d[2] = (v4u){pk[8], pk[9], pk[10], pk[11]}; d[3] = (v4u){pk[12], pk[13], pk[14], pk[15]}; }
    }
    __syncthreads();
    bf16* UM = WSP(bf16, WS_UM);
    if (PASS == 1) {
        LAS bf16* OUT = (LAS bf16*)(L + 73728);
#pragma unroll
        for (int r = 0; r < 2; ++r) {
            const int hl = w >> 2, hd = 2 * r + hl, pt = (w >> 1) & 1;
#pragma unroll
            for (int q = 0; q < 2; ++q) {
                const int nt = (w & 1) * 2 + q;
                f32x16 acc = ZERO16;
                mma32_ll<64>(acc, XT + (hd * 64 + pt * 32) * 72, 72, BT + nt * 32 * 72, 72, lane);
#pragma unroll
                for (int reg = 0; reg < 16; ++reg) OUT[(hl * 64 + pt * 32 + rowreg(reg, lane)) * 136 + nt * 32 + (lane & 31)] = (bf16)f2bf(acc[reg]);
            }
            __syncthreads();
#pragma unroll
            for (int i = 0; i < 4; ++i) { const int idx = tid + 512 * i, hh = idx >> 10, row = (idx >> 4) & 63, pc = idx & 15;
                *(GAS v4u*)(UM + (size_t)(p.ent0 + (2 * r + hh) * p.estride) * UM_ENT + (size_t)row * 128 + pc * 8) = *(const LAS v4u*)(OUT + (hh * 64 + row) * 136 + pc * 8); }
            __syncthreads();
        }
    } else {
        LAS float* CB = (LAS float*)(L + 73728);
        LAS bf16* WW = (LAS bf16*)(L + 90624);
        LAS float* PART = (LAS float*)(L + 127488);
        LAS float* RS = (LAS float*)(L + 129536);
        bf16x8 hfr[8];
        load_frags8(UM + (size_t)(p.ent0 + (w >> 1) * p.estride) * UM_ENT + (size_t)(w & 1) * 32 * 128, 128, lane, hfr);
        v4u zr[4];
        { const bf16* Zg = WSP(bf16, WS_QZ) + (size_t)rowbase * 1024 + 512 + 256 * g;
#pragma unroll
          for (int i = 0; i < 4; ++i) { const int idx = tid + 512 * i; zr[i] = *(const GAS v4u*)(Zg + (size_t)(idx >> 5) * 1024 + (idx & 31) * 8); } }
        if (w < 4) {
            const int tm = w >> 1, sn = w & 1;
            if (!(tm == 0 && sn == 1)) {
                f32x16 acc = ZERO16;
                mma32_ll<128>(acc, CN + tm * 32 * 136, 136, BN + sn * 32 * 136, 136, lane);
#pragma unroll
                for (int reg = 0; reg < 16; ++reg) CB[(tm * 32 + rowreg(reg, lane)) * 66 + sn * 32 + (lane & 31)] = acc[reg];
            }
        }
        __syncthreads();
        {
            const int hd = tid >> 7, rem = tid & 127, t = rem >> 1, s0 = (rem & 1) * 32;
            const float ct = CUM[hd * 64 + t];
            unsigned pw[16];
#pragma unroll
            for (int j = 0; j < 32; j += 2) {
                const int s = s0 + j;
                const float a = (s <= t) ? CB[t * 66 + s] * __expf(ct - CUM[hd * 64 + s]) * DTV[hd * 64 + s] : 0.f;
                const float b = (s + 1 <= t) ? CB[t * 66 + s + 1] * __expf(ct - CUM[hd * 64 + s + 1]) * DTV[hd * 64 + s + 1] : 0.f;
                pw[j >> 1] = pk2(a, b);
            }
            __syncthreads();
#pragma unroll
            for (int i = 0; i < 4; ++i) { const int idx = tid + 512 * i, zt = idx >> 5, pc = idx & 31;
                *(LAS v4u*)((zt < 32 ? (LAS bf16*)(L + 38912) + zt * 264 : (LAS bf16*)(L + 73728) + (zt - 32) * 264) + pc * 8) = zr[i]; }
            LAS v4u* d = (LAS v4u*)(WW + (hd * 64 + t) * 72 + s0);
            d[0] = (v4u){pw[0], pw[1], pw[2], pw[3]}; d[1] = (v4u){pw[4], pw[5], pw[6], pw[7]}; d[2] = (v4u){pw[8], pw[9], pw[10], pw[11]}; d[3] = (v4u){pw[12], pw[13], pw[14], pw[15]};
        }
        __syncthreads();
        const int hd = w >> 1, pnn = w & 1, head = 4 * g + hd;
        const float Dk = inp(F, 18)[head];
        bf16* QZ = WSP(bf16, WS_QZ);
        const int chn = hd * 64 + pnn * 32 + (lane & 31);
        unsigned yzp[2][8];
#pragma unroll
        for (int tm = 0; tm < 2; ++tm) {
            const LAS bf16* ZL = tm == 0 ? (const LAS bf16*)(L + 38912) : (const LAS bf16*)(L + 73728);
            float sqv[16];
            f32x16 acc = ZERO16;
            mma32_lf8(acc, CN + tm * 32 * 136, 136, hfr, lane);
#pragma unroll
            for (int reg = 0; reg < 16; ++reg) acc[reg] *= __expf(CUM[hd * 64 + tm * 32 + rowreg(reg, lane)]);
            mma32_ll<64>(acc, WW + (hd * 64 + tm * 32) * 72, 72, XT + (hd * 64 + pnn * 32) * 72, 72, lane);
#pragma unroll
            for (int reg = 0; reg < 16; ++reg) {
                const int t = tm * 32 + rowreg(reg, lane);
                const float y = acc[reg] + Dk * bf2f(XT[chn * 72 + t]);
                const float v = y * bf2f(ZL[rowreg(reg, lane) * 264 + chn]);
                if (reg & 1) yzp[tm][reg >> 1] |= f2bf(v) << 16; else yzp[tm][reg >> 1] = f2bf(v);
                sqv[reg] = v * v;
            }
            { int rsel; const float sq = rowsum16(sqv, lane, rsel); if ((lane & 1) == 0) PART[(tm * 32 + rowreg(rsel, lane)) * 8 + w] = sq; }
            asm volatile("" ::: "memory");
        }
        __syncthreads();
        if (tid < 64) { float s = 0.f;
#pragma unroll
            for (int j = 0; j < 8; ++j) s += PART[tid * 8 + j];
            RS[tid] = 1.0f / sqrtf(s * (1.0f / 256.0f) + EPS); }
        __syncthreads();
        const float nw = inp(F, 19)[256 * g + chn];
        LAS bf16* OUT = (LAS bf16*)(L + 2048);
#pragma unroll
        for (int tm = 0; tm < 2; ++tm)
#pragma unroll
            for (int reg = 0; reg < 16; ++reg) { const int t = tm * 32 + rowreg(reg, lane);
                const float v = bf2f((unsigned short)((reg & 1) ? (yzp[tm][reg >> 1] >> 16) : (yzp[tm][reg >> 1] & 0xffffu)));
                OUT[t * 264 + chn] = (bf16)f2bf(v * RS[t] * nw); }
        __syncthreads();
#pragma unroll
        for (int i = 0; i < 4; ++i) { const int idx = tid + 512 * i, row = idx >> 5, pc = idx & 31; *(GAS v4u*)(QZ + (size_t)(rowbase + row) * 1024 + 512 + 256 * g + pc * 8) = *(const LAS v4u*)(OUT + row * 264 + pc * 8); }
        __syncthreads();
    }
}
__device__ __forceinline__ void unpack8(const v4u u, float (&f)[8]) {
    f[0] = bf2f((unsigned short)(u.x & 0xffffu)); f[1] = bf2f((unsigned short)(u.x >> 16)); f[2] = bf2f((unsigned short)(u.y & 0xffffu)); f[3] = bf2f((unsigned short)(u.y >> 16));
    f[4] = bf2f((unsigned short)(u.z & 0xffffu)); f[5] = bf2f((unsigned short)(u.z >> 16)); f[6] = bf2f((unsigned short)(u.w & 0xffffu)); f[7] = bf2f((unsigned short)(u.w >> 16));
}
__device__ __forceinline__ void p4b_scan(Frame& F) {
    const int gt = F.vcu * (NWAVES * 64) + F.tid, NT = F.G * NWAVES * 64;
    const float* ER = WSP(float, WS_ER); const float* EL = WSP(float, WS_EL); const float* DCY = WSP(float, WS_DCY);
    for (int idx = gt; idx < 131072; idx += NT) {
        float S[8];
#pragma unroll
        for (int j = 0; j < 8; ++j) S[j] = 0.f;
        if (idx < 65536) {
            const int bh = idx >> 11, rem = idx & 2047, v = rem >> 4, kd8 = (rem & 15) * 8, b = bh >> 2, h = bh & 3;
            bf16* UTH = UTHP + (size_t)v * 128 + kd8;
            {
                float uu[8]; unpack8(*(const GAS v4u*)(UTH + (size_t)(1024 + h) * UTH_ENT), uu);
                const float* el = EL + (size_t)256 * 512 + 128 * h + kd8;
#pragma unroll
                for (int j = 0; j < 8; ++j) S[j] = el[j] * uu[j];
            }
            for (int c0 = 0; c0 < NCH; c0 += 4) {
                v4u u[4]; f32x4 er[4][2], el[4][2];
#pragma unroll
                for (int q = 0; q < 4; ++q) { const size_t e = (size_t)(b * 32 + c0 + q);
                    u[q] = *(const GAS v4u*)(UTH + (size_t)(bh * 32 + c0 + q) * UTH_ENT);
                    er[q][0] = *(const GAS f32x4*)(ER + e * 512 + 128 * h + kd8); er[q][1] = *(const GAS f32x4*)(ER + e * 512 + 128 * h + kd8 + 4);
                    el[q][0] = *(const GAS f32x4*)(EL + e * 512 + 128 * h + kd8); el[q][1] = *(const GAS f32x4*)(EL + e * 512 + 128 * h + kd8 + 4); }
#pragma unroll
                for (int q = 0; q < 4; ++q) { float uu[8], sp[8]; unpack8(u[q], uu);
#pragma unroll
                    for (int j = 0; j < 8; ++j) { sp[j] = er[q][j >> 2][j & 3] * S[j]; S[j] = el[q][j >> 2][j & 3] * (sp[j] + uu[j]); }
                    *(GAS v4u*)(UTH + (size_t)(bh * 32 + c0 + q) * UTH_ENT) = (v4u){pk2(sp[0], sp[1]), pk2(sp[2], sp[3]), pk2(sp[4], sp[5]), pk2(sp[6], sp[7])}; }
            }
            float* o = OUTP(O_HGP) + ((size_t)bh * 128 + kd8) * 128 + v;
#pragma unroll
            for (int j = 0; j < 8; ++j) o[(size_t)j * 128] = S[j];
        } else {
            const int i2 = idx - 65536, bhd = i2 >> 10, rem = i2 & 1023, p_ = rem >> 4, n8 = (rem & 15) * 8, head = bhd & 7;
            bf16* UM = WSP(bf16, WS_UM) + (size_t)p_ * 128 + n8;
            {   float uu[8]; unpack8(*(const GAS v4u*)(UM + (size_t)(2048 + head) * UM_ENT), uu);
#pragma unroll
                for (int j = 0; j < 8; ++j) S[j] = uu[j]; }
            for (int c0 = 0; c0 < NCH; c0 += 4) {
                v4u u[4]; float d[4];
#pragma unroll
                for (int q = 0; q < 4; ++q) { u[q] = *(const GAS v4u*)(UM + (size_t)(bhd * 32 + c0 + q) * UM_ENT); d[q] = DCY[bhd * 32 + c0 + q]; }
#pragma unroll
                for (int q = 0; q < 4; ++q) { float uu[8], sp[8]; unpack8(u[q], uu);
#pragma unroll
                    for (int j = 0; j < 8; ++j) { sp[j] = S[j]; S[j] = d[q] * S[j] + uu[j]; }
                    *(GAS v4u*)(UM + (size_t)(bhd * 32 + c0 + q) * UM_ENT) = (v4u){pk2(sp[0], sp[1]), pk2(sp[2], sp[3]), pk2(sp[4], sp[5]), pk2(sp[6], sp[7])}; }
            }
            float* o = OUTP(O_SSP) + ((size_t)bhd * 64 + p_) * 128 + n8;
            *(GAS f32x4*)o = (f32x4){S[0], S[1], S[2], S[3]}; *(GAS f32x4*)(o + 4) = (f32x4){S[4], S[5], S[6], S[7]};
        }
    }
}
__device__ __forceinline__ void hgrn_decode(Frame& F, int smp, int h) {
    LAS float* OS = (LAS float*)F.lds;
    LAS float* RED = (LAS float*)(F.lds + 8192);
    const int tid = F.tid, row = ROW_SMP + smp, v4 = (tid & 31) * 4, kg = tid >> 5;
    const float* FZ = WSP(float, WS_FZ); const bf16* VB = WSP(bf16, WS_VB); bf16* QZ = WSP(bf16, WS_QZ); const float* LB = WSP(float, WS_LB);
    const float* Sin = inp(F, 2) + (size_t)(smp * 4 + h) * 16384; float* Sout = OUTP(O_HGS) + (size_t)(smp * 4 + h) * 16384;
    f32x4 vv; { const unsigned long long raw = *(const GAS unsigned long long*)(VB + (size_t)row * 512 + 128 * h + v4);
        vv = (f32x4){bf2f((unsigned short)raw), bf2f((unsigned short)(raw >> 16)), bf2f((unsigned short)(raw >> 32)), bf2f((unsigned short)(raw >> 48))}; }
    f32x4 o = (f32x4){0.f, 0.f, 0.f, 0.f};
    f32x4 st[8]; float fzv[8], lbv[8], qv[8];
#pragma unroll
    for (int j = 0; j < 8; ++j) { const int kd = kg * 8 + j;
        st[j] = *(const GAS f32x4*)(Sin + (size_t)kd * 128 + v4);
        fzv[j] = FZ[(size_t)row * 512 + 128 * h + kd]; lbv[j] = LB[128 * h + kd]; qv[j] = bf2f(QZ[(size_t)row * 1024 + 128 * h + kd]); }
#pragma unroll
    for (int j = 0; j < 8; ++j) {
        const int kd = kg * 8 + j;
        const float sg = sigm(fzv[j]), f = lbv[j] + (1.0f - lbv[j]) * sg, k = (1.0f - lbv[j]) * (1.0f - sg);
        const f32x4 sn = st[j] * f + vv * k;
        *(GAS f32x4*)(Sout + (size_t)kd * 128 + v4) = sn;
        o = o + sn * qv[j];
    }
    *(LAS f32x4*)(OS + kg * 128 + v4) = o;
    __syncthreads();
    float ov = 0.f;
    if (tid < 128) {
#pragma unroll
        for (int j = 0; j < 16; ++j) ov += OS[j * 128 + tid];
        const float sq = wave_sum(ov * ov); if (F.lane == 0) RED[F.wave] = sq;
    }
    __syncthreads();
    if (tid < 128) {
        const float rs = 1.0f / sqrtf((RED[0] + RED[1]) * (1.0f / 128.0f) + EPS);
        const float g = bf2f(WSP(bf16, WS_GB)[(size_t)row * 512 + 128 * h + tid]);
        QZ[(size_t)row * 1024 + 128 * h + tid] = (bf16)f2bf(ov * rs * g);
    }
    __syncthreads();
}
__device__ __forceinline__ void mamba_decode(Frame& F, int smp, int g) {
    LAS float* XS = (LAS float*)F.lds;
    LAS float* YS = (LAS float*)(F.lds + 2048);
    LAS float* RED = (LAS float*)(F.lds + 3072);
    const int tid = F.tid, row = ROW_SMP + smp;
    const bf16* XBC = WSP(bf16, WS_XBC); bf16* QZ = WSP(bf16, WS_QZ);
    {
        const int ch = tid, col = ch < 256 ? 256 * g + ch : ch < 384 ? 512 + 128 * g + (ch - 256) : 768 + 128 * g + (ch - 384);
        const float* cw = inp(F, 14); const float* sc = inp(F, 4) + (size_t)smp * 3 * 1024;
        const float s0 = sc[col], s1 = sc[1024 + col], s2 = sc[2048 + col], cur = bf2f(XBC[(size_t)row * 1024 + col]);
        XS[ch] = silu(inp(F, 15)[col] + cw[col] * s0 + cw[1024 + col] * s1 + cw[2048 + col] * s2 + cw[3072 + col] * cur);
        float* cs = OUTP(O_CVS) + (size_t)smp * 3 * 1024; cs[col] = s1; cs[1024 + col] = s2;
    }
    __syncthreads();
    {
        const int hd = tid >> 7, r = tid & 127, n4 = (r & 31) * 4, pg = r >> 5, head = 4 * g + hd;
        const float dt = WSP(float, WS_DT)[(size_t)row * 8 + head], dA = __expf(-dt * __expf(inp(F, 17)[head])), Dk = inp(F, 18)[head];
        const f32x4 Bv = *(const LAS f32x4*)(XS + 256 + n4), Cv = *(const LAS f32x4*)(XS + 384 + n4);
        const float* Sin = inp(F, 3) + (size_t)(smp * 8 + head) * 8192; float* Sout = OUTP(O_SSS) + (size_t)(smp * 8 + head) * 8192;
        float yv[16]; f32x4 st[16];
#pragma unroll
        for (int j = 0; j < 16; ++j) st[j] = *(const GAS f32x4*)(Sin + (size_t)(pg * 16 + j) * 128 + n4);
#pragma unroll
        for (int j = 0; j < 16; ++j) {
            const int p = pg * 16 + j; const float x = XS[hd * 64 + p];
            const f32x4 sn = st[j] * dA + Bv * (dt * x);
            *(GAS f32x4*)(Sout + (size_t)p * 128 + n4) = sn;
            yv[j] = (sn[0] * Cv[0] + sn[1] * Cv[1]) + (sn[2] * Cv[2] + sn[3] * Cv[3]);
        }
        { int rsel; const float y = rowsum16(yv, F.lane, rsel); if ((r & 1) == 0) { const int p = pg * 16 + rsel; YS[hd * 64 + p] = y + Dk * XS[hd * 64 + p]; } }
    }
    __syncthreads();
    float yz = 0.f;
    if (tid < 256) {
        yz = YS[tid] * bf2f(QZ[(size_t)row * 1024 + 512 + 256 * g + tid]);
        const float sq = wave_sum(yz * yz); if (F.lane == 0) RED[F.wave] = sq;
    }
    __syncthreads();
    if (tid < 256) {
        const float rs = 1.0f / sqrtf(((RED[0] + RED[1]) + (RED[2] + RED[3])) * (1.0f / 256.0f) + EPS);
        QZ[(size_t)row * 1024 + 512 + 256 * g + tid] = (bf16)f2bf(yz * rs * inp(F, 19)[256 * g + tid]);
    }
    __syncthreads();
}
__device__ __forceinline__ void p4a(Frame& F, bool decode) {
    if (decode) {
        for (int j = F.vcu; j < 512; j += F.G) hgrn_decode(F, j >> 2, j & 3);
        for (int j = F.vcu; j < 256; j += F.G) mamba_decode(F, j >> 1, j & 1);
    }
    {   HgRaw raw; int i = F.vcu; if (i < 1028) { const HgP p0 = hg_params(i); hg_load<1>(F, p0, raw); }
        for (; i < 1028; i += F.G) { const int in = i + F.G; hgrn_item<1>(F, hg_params(i), raw, in < 1028, hg_params(in < 1028 ? in : i)); } }
    {   MbRaw raw; int j = F.vcu; if (mb_valid(j, true)) { const MbP p0 = mb_params(F, j); mb_load<1>(F, p0, raw); }
        for (; mb_valid(j, true); j += F.G) { const int jn = j + F.G; const bool hn = mb_valid(jn, true); mamba_item<1>(F, mb_params(F, j), raw, hn, mb_params(F, hn ? jn : j)); } }
}
__device__ __forceinline__ void p4c(Frame& F) {
    {   HgRaw raw; int i = F.vcu; if (i < 1024) { const HgP p0 = hg_params(i); hg_load<3>(F, p0, raw); }
        for (; i < 1024; i += F.G) { const int in = i + F.G; hgrn_item<3>(F, hg_params(i), raw, in < 1024, hg_params(in < 1024 ? in : i)); } }
    {   MbRaw raw; int j = F.vcu; if (j < 512) { const MbP p0 = mb_params(F, j); mb_load<3>(F, p0, raw); }
        for (; j < 512; j += F.G) { const int jn = j + F.G; mamba_item<3>(F, mb_params(F, j), raw, jn < 512, mb_params(F, jn < 512 ? jn : j)); } }
}
#ifndef MK_PER_PHASE
#define MK_PER_PHASE 0
#endif
#ifndef GP_ALIGN
#define GP_ALIGN true
#endif
#ifndef GP_SP2
#define GP_SP2 true
#endif
#ifndef GP_SP2_FINAL
#define GP_SP2_FINAL false
#endif
#ifndef WGM_GU
#define WGM_GU 4
#endif
#ifndef WGM_IN
#define WGM_IN 4
#endif
#ifndef WGM_DN
#define WGM_DN 4
#endif
constexpr int N_PHASES = 13;
struct Args { const float* in[26]; float* out; unsigned char* ws; int ph_lo, ph_hi; };
static_assert(sizeof(Args) == 26 * 8 + 8 + 8 + 8, "Args has no padding");
template <bool SPLIT> __global__ void __launch_bounds__(NWAVES * 64, 2) hymba_fwd(Args args) {
    extern __shared__ __attribute__((aligned(16))) unsigned char lds[];
    Frame F;
    F.lds = (LAS unsigned char*)lds;
    F.MISC = (volatile LAS unsigned*)(F.lds + MISC_OFF);
    F.tid = threadIdx.x; F.lane = F.tid & 63; F.wave = __builtin_amdgcn_readfirstlane(F.tid >> 6);
    F.G = gridDim.x; { const int bx = blockIdx.x; F.vcu = (F.G % 8 == 0) ? (bx % 8) * (F.G / 8) + bx / 8 : bx; }
    F.ws = (GAS unsigned char*)args.ws; F.out = (GAS float*)args.out; F.ctl = (gu32*)(args.ws + WS_CTL);
    for (int u = F.tid; u < (LDS_BYTES - LDSCTL_OFF) / 4; u += NWAVES * 64) ((LAS unsigned*)(F.lds + LDSCTL_OFF))[u] = 0u;
    __syncthreads();
    if (F.tid < 26) ((LAS unsigned long long*)(F.lds + TAB_OFF))[F.tid] = (unsigned long long)args.in[F.tid];
    __syncthreads();
    XcdBarrier bar; bar.bar = (unsigned*)(F.ctl + CW_BAR); bar.x = 0; bar.st = nullptr;
    if (!MK_PER_PHASE) bar = xcd_barrier_post((unsigned*)(F.ctl + CW_BAR), F.MISC + 8);
    const int lo = args.ph_lo, hi = args.ph_hi;
#ifndef PH_MASK
#define PH_MASK 0x1fff
#endif
#define IN(k) (((PH_MASK >> (k)) & 1) && lo <= (k) && (k) < hi)
#ifndef PH_REPEAT
#define PH_REPEAT 0
#endif
#define SEAM(k) do { if (IN(k) && IN((k) + 1)) xcd_barrier(bar); } while (0)
#define PHASE_LOCAL() asm volatile("" : "+s"(F.ws), "+s"(F.out), "+v"(F.tid), "+v"(F.lane), "+s"(F.wave), "+s"(F.vcu), "+s"(F.G))
#define REP(k) for (int rep_ = 0; rep_ < 1 + ((PH_REPEAT >> (k)) & 1); ++rep_)
#define HB WSP(bf16, WS_HB)
#define HH WSP(bf16, WS_H)
#define QZ WSP(bf16, WS_QZ)
#define SS1 WSP(float, WS_SS1)
#define SS2 WSP(float, WS_SS2)
#define SS3 WSP(float, WS_SS3)
#define SS4 WSP(float, WS_SS4)
#define RS2 (WSP(float, WS_SS1) + 32768)
#define RS3 (WSP(float, WS_SS1) + 65536)
#define YP (OUTP(O_YP))
#define HX0 WSP(float, WS_HX0)
#define HX WSP(float, WS_HX)

    constexpr int split = SPLIT ? 1 : 0;
#define SLABS WSP(float, WS_XBC)
    if (IN(0)) REP(0) { if (rep_ == 1) xcd_barrier(bar); PHASE_LOCAL(); p0_prologue(F, split); } SEAM(0);
    if (IN(1)) REP(1) { if (rep_ == 1) xcd_barrier(bar); PHASE_LOCAL();
        pg8::Gemm g{HB, WSP(bf16, WS_WGU1), M, 2 * FF, D, D}; pg8::MixOrder S; S.init(65, 2 * FF, D, F.G, (int)blockIdx.x, 0, WGM_GU);
        pg8::EpiSwiglu E{HH, SS1, LDH, FF / 64};
        pg8::gemm_phase<pg8::EpiSwiglu, pg8::MixOrder, GP_ALIGN, GP_SP2>(F.lds, g, S, E, nullptr);
        if (split && rep_ == 0) {
            const int idle0 = 1430 - 5 * 256;
            if ((int)blockIdx.x >= idle0) { __syncthreads(); p0_weight_items(F, P0_ITEMS_FIRST, P0_NITEMS, ((int)blockIdx.x - idle0) * NWAVES + F.wave, (256 - idle0) * NWAVES); }
        }
    } SEAM(1);
    if (IN(2)) REP(2) { if (rep_ == 1) xcd_barrier(bar); PHASE_LOCAL();
        pg8::Gemm g{HH, WSP(bf16, WS_WD1), M, D, FF, LDH}; pg8::MixOrder S; S.init(split ? 64 : 65, D, FF, F.G, (int)blockIdx.x, split, WGM_DN);
        pg8::EpiResid E{HB, nullptr, HX0, HX, HB, SS2, 0.5f, nullptr};
        pg8::gemm_phase<pg8::EpiResid, pg8::MixOrder, GP_ALIGN, GP_SP2>(F.lds, g, S, E, SLABS);
    } SEAM(2);
    if (IN(3)) REP(3) { if (rep_ == 1) xcd_barrier(bar); PHASE_LOCAL(); fix_extra<FF / 128>(F, split, SLABS, HX0, HX, HB, SS2, RS2, 0.5f); } SEAM(3);
    if (IN(4)) REP(4) { if (rep_ == 1) xcd_barrier(bar); PHASE_LOCAL();
        pg8::Gemm g{HB, WSP(bf16, WS_WIN), M, NINP, D, D}; pg8::MixOrder S; S.init(65, NINP, D, F.G, (int)blockIdx.x, 0, WGM_IN);
        pg8::EpiInproj E{RS2, QZ, WSP(float, WS_FZ), WSP(bf16, WS_VB), WSP(bf16, WS_GB), WSP(bf16, WS_XBC), WSP(float, WS_DT), inp(F, 13), inp(F, 16), OUTP(O_CVP), OUTP(O_CVS)};
        pg8::gemm_phase<pg8::EpiInproj, pg8::MixOrder, GP_ALIGN, GP_SP2>(F.lds, g, S, E, nullptr);
    } SEAM(4);
    if (IN(5)) REP(5) { if (rep_ == 1) xcd_barrier(bar); PHASE_LOCAL(); p4a(F, rep_ == 0); } SEAM(5);
    if (IN(6)) REP(6) { if (rep_ == 1) xcd_barrier(bar); PHASE_LOCAL(); p4b_scan(F); } SEAM(6);
    if (IN(7)) REP(7) { if (rep_ == 1) xcd_barrier(bar); PHASE_LOCAL(); p4c(F); } SEAM(7);
    if (IN(8)) REP(8) { if (rep_ == 1) xcd_barrier(bar); PHASE_LOCAL();
        pg8::Gemm g{QZ, WSP(bf16, WS_WOUT), M, D, D, D}; pg8::MixOrder S; S.init(split ? 64 : 65, D, D, F.G, (int)blockIdx.x, split, WGM_DN);
        pg8::EpiResid E{HB, nullptr, HX, HX, HB, SS3, 1.0f, nullptr};
        pg8::gemm_phase<pg8::EpiResid, pg8::MixOrder, GP_ALIGN, GP_SP2>(F.lds, g, S, E, SLABS);
    } SEAM(8);
    if (IN(9)) REP(9) { if (rep_ == 1) xcd_barrier(bar); PHASE_LOCAL(); fix_extra<D / 128>(F, split, SLABS, HX, HX, HB, SS3, RS3, 1.0f);
        if (split) { GAS v4u* z = (GAS v4u*)(F.ws + WS_UM); for (int i = F.vcu * (NWAVES * 64) + F.tid; i < 131072; i += F.G * NWAVES * 64) z[i] = (v4u){0u, 0u, 0u, 0u}; } }
    if (IN(10)) REP(10) { if (rep_ == 1) xcd_barrier(bar); PHASE_LOCAL();
        pg8::Gemm g{HB, WSP(bf16, WS_WGU2), M, 2 * FF, D, D}; pg8::MixOrder S; S.init(65, 2 * FF, D, F.G, (int)blockIdx.x, 0, WGM_GU);
        pg8::EpiSwiglu E{HH, RS3, LDH, FF / 64};
        pg8::gemm_phase<pg8::EpiSwiglu, pg8::MixOrder, GP_ALIGN, GP_SP2>(F.lds, g, S, E, nullptr);
    } SEAM(10);
    if (IN(11)) REP(11) { if (rep_ == 1) xcd_barrier(bar); PHASE_LOCAL();
        pg8::Gemm g{HH, WSP(bf16, WS_WD2), M, D, FF, LDH}; pg8::MixOrder S; S.init(split ? 64 : 65, D, FF, F.G, (int)blockIdx.x, split, WGM_DN);
        if constexpr (SPLIT) {
            pg8::EpiResid E{HB, nullptr, HX, HX, HB, SS4, 0.5f, (unsigned long long*)(F.ws + WS_UM)};
            pg8::gemm_phase<pg8::EpiResid, pg8::MixOrder, GP_ALIGN, GP_SP2>(F.lds, g, S, E, SLABS);
            pg8::Unit u; S.next(0, u);
            VM_WAIT(); __syncthreads();
            unsigned long long* gp = (unsigned long long*)(F.ws + WS_UM) + (size_t)u.pm * 256 * 16;
            const bf16* hb = HB + (size_t)u.pm * 256 * 1024 + u.pn * 256 + 4 * F.lane;
            float* yb = YP + (size_t)u.pm * 256 * 1024 + u.pn * 256 + 4 * F.lane;
            const f32x4 w = *(const GAS f32x4*)(inp(F, 25) + u.pn * 256 + 4 * F.lane);
            float tot[8];
            { unsigned long long x[8]; unsigned spins = 0;
              for (;;) { bool ok = true;
#pragma unroll
                  for (int j = 0; j < 8; ++j) { x[j] = __hip_atomic_load(gp + (size_t)F.wave * 512 + F.lane + 64 * j, __ATOMIC_RELAXED, __HIP_MEMORY_SCOPE_AGENT); ok = ok && ((unsigned)(x[j] >> 32) == 1u); }
                  if (__all(ok) || ++spins > (1u << 18)) break; __builtin_amdgcn_s_sleep(4); }
#pragma unroll
              for (int j = 0; j < 8; ++j) { float v = __builtin_bit_cast(float, (unsigned)x[j]); v += __shfl_xor(v, 1); v += __shfl_xor(v, 2); v += __shfl_xor(v, 4); v += __shfl_xor(v, 8); tot[j] = v; } }
            unsigned long long o[32];
#pragma unroll
            for (int i = 0; i < 32; ++i) o[i] = *(const GAS unsigned long long*)(hb + (size_t)(F.wave * 32 + i) * 1024);
#pragma unroll
            for (int r = 0; r < 32; ++r) { const float rs = __builtin_amdgcn_rsqf(__builtin_bit_cast(float, __builtin_amdgcn_readlane(__builtin_bit_cast(int, tot[r >> 2]), (r & 3) * 16)) * (1.0f / 1024.0f) + EPS);
                const unsigned lo = (unsigned)o[r], hi = (unsigned)(o[r] >> 32);
                const f32x4 v = (f32x4){__builtin_bit_cast(float, lo << 16), __builtin_bit_cast(float, lo & 0xffff0000u), __builtin_bit_cast(float, hi << 16), __builtin_bit_cast(float, hi & 0xffff0000u)};
                *(GAS f32x4*)(yb + (size_t)(F.wave * 32 + r) * 1024) = v * rs * w; }
        } else {
            pg8::EpiResid E{HB, YP, HX, HX, nullptr, SS4, 0.5f, nullptr};
            pg8::gemm_phase<pg8::EpiResid, pg8::MixOrder, GP_ALIGN, GP_SP2>(F.lds, g, S, E, SLABS);
        }
    } SEAM(11);
    if (IN(12)) REP(12) { if (rep_ == 1) xcd_barrier(bar); PHASE_LOCAL(); p8_final<FF / 128>(F, split, SLABS); }
#undef SLABS
#undef IN
#undef SEAM
#undef HB
#undef HH
#undef QZ
#undef SS1
#undef SS2
#undef SS3
#undef SS4
#undef RS2
#undef RS3
#undef YP
#undef HX0
#undef HX
}

extern "C" void kernel_launch(void* const* d_in, const int* in_sizes, int n_in, void* d_out, int out_size, void* d_ws, size_t ws_size, hipStream_t stream) {
    static int grid = 0;
    if (grid == 0) {
        if (n_in != 26 || in_sizes[0] != MP * D || (size_t)out_size != O_END || ws_size < WS_END) {
            fprintf(stderr, "kernel_launch: unexpected shapes: n_in %d in0 %d out %d ws %zu; nothing launched\n", n_in, n_in > 0 ? in_sizes[0] : -1, out_size, ws_size); grid = -1; return; }
        int dev = 0, cus = 0, per_cu = 0;
        if (hipGetDevice(&dev) != hipSuccess || hipDeviceGetAttribute(&cus, hipDeviceAttributeMultiprocessorCount, dev) != hipSuccess) { fprintf(stderr, "kernel_launch: device query failed\n"); grid = -1; return; }
        if (hipFuncSetAttribute((const void*)hymba_fwd<true>, hipFuncAttributeMaxDynamicSharedMemorySize, LDS_BYTES) != hipSuccess || hipFuncSetAttribute((const void*)hymba_fwd<false>, hipFuncAttributeMaxDynamicSharedMemorySize, LDS_BYTES) != hipSuccess) { fprintf(stderr, "kernel_launch: hipFuncSetAttribute failed\n"); grid = -1; return; }
        if (hipOccupancyMaxActiveBlocksPerMultiprocessor(&per_cu, cus == 256 ? (const void*)hymba_fwd<true> : (const void*)hymba_fwd<false>, NWAVES * 64, LDS_BYTES) != hipSuccess || per_cu < 1)
            fprintf(stderr, "kernel_launch: note: occupancy query reports %d workgroups per CU\n", per_cu);
        (void)hipGetLastError();
        grid = cus;
    }
    if (grid < 0) return;
    if (hipMemsetAsync((char*)d_ws + WS_CTL, 0, CTL_ZERO_BYTES, stream) != hipSuccess) { fprintf(stderr, "kernel_launch: memset failed\n"); return; }
    Args a{};
    for (int i = 0; i < 26; ++i) a.in[i] = (const float*)d_in[i];
    a.out = (float*)d_out; a.ws = (unsigned char*)d_ws;
#if MK_PER_PHASE
    for (int p = 0; p < N_PHASES; ++p) { a.ph_lo = p; a.ph_hi = p + 1; if (grid == 256) hipLaunchKernelGGL(hymba_fwd<true>, dim3(grid), dim3(NWAVES * 64), LDS_BYTES, stream, a); else hipLaunchKernelGGL(hymba_fwd<false>, dim3(grid), dim3(NWAVES * 64), LDS_BYTES, stream, a); }
#else
    a.ph_lo = 0; a.ph_hi = N_PHASES;
    if (grid == 256) hipLaunchKernelGGL(hymba_fwd<true>, dim3(grid), dim3(NWAVES * 64), LDS_BYTES, stream, a);
    else hipLaunchKernelGGL(hymba_fwd<false>, dim3(grid), dim3(NWAVES * 64), LDS_BYTES, stream, a);
#endif
    const hipError_t le = hipPeekAtLastError();
    if (le != hipSuccess) fprintf(stderr, "kernel_launch: launch failed: %s\n", hipGetErrorName(le));
}
```

```cpp
#include <hip/hip_runtime.h>
#include <cstdio>
#include <cstdint>
namespace pg8 {
#define PG8_LAS __attribute__((address_space(3)))
typedef unsigned short bf16_t;
typedef short bf16x8 __attribute__((ext_vector_type(8)));
typedef float f32x4 __attribute__((ext_vector_type(4)));
typedef unsigned u32x4 __attribute__((ext_vector_type(4)));
constexpr int BM = 256, BK = 64, HALF = 128, HTB = HALF * BK * 2  , STAGE_BYTES = 8 * HTB, NXCD = 8, WGM = 8;

__host__ __device__ __forceinline__ int lds_byte(int r, int c) { const int st = (r >> 4) * 2 + (c >> 5), rr = r & 15, cc = c & 31, ob = rr * 64 + cc * 2; return st * 1024 + (ob ^ (((ob >> 9) & 1) << 5)); }
__host__ __device__ __forceinline__ void stage_rc(int b, int& R, int& C) { const int st = b / 1024, sb = b % 1024, swz = sb ^ (((sb >> 9) & 1) << 5); R = (st >> 1) * 16 + swz / 64; C = (st & 1) * 32 + (swz % 64) / 2; }
__host__ __device__ __forceinline__ int perm32(int rho) { const int n = rho >> 4, i = rho & 15; return 8 * (i >> 2) + 4 * n + (i & 3); }

struct Unit { int pm, pn, k0, nt, kind, slot; };
struct Gemm { const bf16_t* A; const bf16_t* Bt; int M, N, K, lda; };

struct MixOrder {
    int nM, nN, nwg, G, c, ppu, npieces, rounds, wgm;
    __host__ __device__ __forceinline__ void init(int nM_, int N, int K, int G_, int c_, int split, int wgm_) { wgm = wgm_; nM = nM_; nN = N / BM; nwg = nM * nN; G = G_; c = c_; ppu = K / (2 * BK); npieces = split ? nN * ppu : 0; rounds = (nwg + G - 1) / G; }
    __host__ __device__ __forceinline__ bool next(int i, Unit& u) const {
        if (i >= rounds) { const int p = (i - rounds) * G + c; if (p >= npieces) return false; u.pm = nM; u.pn = p / ppu; u.k0 = 2 * (p % ppu); u.nt = 2; u.kind = 1; u.slot = p; return true; }
        const long L = (long)i * G + c; if (L >= nwg) return false;
        int wgid = (int)L; { const int q = nwg / NXCD, r = nwg % NXCD, xcd = wgid % NXCD, off = wgid / NXCD; wgid = (xcd < r ? xcd * (q + 1) : r * (q + 1) + (xcd - r) * q) + off; }
        const int nig = wgm * nN, gid = wgid / nig, fm = gid * wgm, gsz = (nM - fm) < wgm ? (nM - fm) : wgm;
        u.pm = fm + ((wgid % nig) % gsz); u.pn = (wgid % nig) / gsz; u.k0 = 0; u.nt = 2 * ppu; u.kind = 0; u.slot = 0; return true;
    }
};

__device__ __forceinline__ unsigned cvt_pk_bf16(float lo, float hi) { unsigned r; asm volatile("v_cvt_pk_bf16_f32 %0, %1, %2" : "=v"(r) : "v"(lo), "v"(hi)); return r; }
typedef float f32x2 __attribute__((ext_vector_type(2)));
constexpr float EPSN = 1e-6f;
__device__ __forceinline__ float row_rstd(const float* SS, int row) {
    const f32x4* p = (const f32x4*)(SS + (size_t)row * 16);
    const f32x4 a = p[0], b = p[1], c = p[2], d = p[3];
    const float s = (((a[0] + a[1]) + (a[2] + a[3])) + ((b[0] + b[1]) + (b[2] + b[3]))) + (((c[0] + c[1]) + (c[2] + c[3])) + ((d[0] + d[1]) + (d[2] + d[3])));
    return __builtin_amdgcn_rsqf(s * (1.0f / 1024.0f) + EPSN);
}
__device__ __forceinline__ float silu_f(float x) { return x * __builtin_amdgcn_rcpf(1.0f + __expf(-x)); }
typedef unsigned u32x2 __attribute__((ext_vector_type(2)));

struct EpiSwiglu {
    static constexpr bool PERM = true, AFTER_DRAIN = false;
    bf16_t* H; const float* RSTD; int ldh, nkt;
    __device__ __forceinline__ void operator()(const f32x4 (&acc)[2][2][4][2], const Unit& u, int wr, int wc, int fr, int fq) const {
        const int row0 = u.pm * BM + wr * 64 + fr, col0 = u.pn * 128 + wc * 32 + 8 * fq;
        float rs8[8];
#pragma unroll
        for (int i = 0; i < 8; ++i) rs8[i] = RSTD[row0 + (i >> 2) * HALF + (i & 3) * 16];
#pragma unroll
        for (int ai = 0; ai < 2; ++ai)
#pragma unroll
            for (int m = 0; m < 4; ++m) {
                const int row = row0 + ai * HALF + m * 16;
                const float rs = rs8[ai * 4 + m];
                float h[8];
#pragma unroll
                for (int n = 0; n < 2; ++n)
#pragma unroll
                    for (int j = 0; j < 4; ++j) { const float g = acc[ai][0][m][n][j] * rs, up = acc[ai][1][m][n][j] * rs; h[n * 4 + j] = silu_f(g) * up; }
                u32x4 w; w.x = cvt_pk_bf16(h[0], h[1]); w.y = cvt_pk_bf16(h[2], h[3]); w.z = cvt_pk_bf16(h[4], h[5]); w.w = cvt_pk_bf16(h[6], h[7]);
                if (ldh) *(u32x4*)(H + (size_t)row * ldh + col0) = w;
                else *(u32x4*)(H + ((size_t)((row >> 8) * nkt + (col0 >> 6)) * 256 + (row & 255)) * 64 + (col0 & 63)) = w;
            }
    }
};

struct EpiResid {
    static constexpr bool PERM = false, AFTER_DRAIN = false;
    const bf16_t* RB; float* D0;
    const float* RX; float* DX;
    bf16_t* HB; float* SS; float scale; unsigned long long* gran;
    __device__ __forceinline__ void operator()(const f32x4 (&acc)[2][2][4][2], const Unit& u, int wr, int wc, int fr, int fq) const {
        const int col0 = u.pn * BM + wc * 32 + 4 * fq;
        if (u.pm < 64) {
            const bf16_t* rb = RB + (size_t)u.pm * BM * 1024; float* db = D0 ? D0 + (size_t)u.pm * BM * 1024 : nullptr;
            u32x2 rn[2][2];
            { const size_t off0 = (size_t)(wr * 64 + fr) * 1024 + col0;
#pragma unroll
              for (int bj = 0; bj < 2; ++bj)
#pragma unroll
                  for (int n = 0; n < 2; ++n) rn[bj][n] = *(const u32x2*)(rb + off0 + bj * HALF + n * 16); }
#pragma unroll
            for (int ai = 0; ai < 2; ++ai)
#pragma unroll
                for (int m = 0; m < 4; ++m) {
                    int lrow = ai * HALF + wr * 64 + m * 16 + fr;
                    asm volatile("" : "+v"(lrow));
                    const size_t off = (size_t)lrow * 1024 + col0;
                    u32x2 rc[2][2];
#pragma unroll
                    for (int bj = 0; bj < 2; ++bj)
#pragma unroll
                        for (int n = 0; n < 2; ++n) rc[bj][n] = rn[bj][n];
                    if (ai * 4 + m < 7) { const int nx = ai * 4 + m + 1; int lnx = (nx >> 2) * HALF + wr * 64 + (nx & 3) * 16 + fr; asm volatile("" : "+v"(lnx));
                        const size_t offn = (size_t)lnx * 1024 + col0;
#pragma unroll
                        for (int bj = 0; bj < 2; ++bj)
#pragma unroll
                            for (int n = 0; n < 2; ++n) rn[bj][n] = *(const u32x2*)(rb + offn + bj * HALF + n * 16); }
                    float sq = 0.f;
#pragma unroll
                    for (int bj = 0; bj < 2; ++bj)
#pragma unroll
                        for (int n = 0; n < 2; ++n) {
                            const u32x2 rr = rc[bj][n];
                            const f32x4 r = (f32x4){__builtin_bit_cast(float, rr.x << 16), __builtin_bit_cast(float, rr.x & 0xffff0000u), __builtin_bit_cast(float, rr.y << 16), __builtin_bit_cast(float, rr.y & 0xffff0000u)};
                            const f32x4 o = r + acc[ai][bj][m][n] * scale;
                            if (db) *(f32x4*)(db + off + bj * HALF + n * 16) = o;
                            sq += (o[0] * o[0] + o[1] * o[1]) + (o[2] * o[2] + o[3] * o[3]);
                            if (HB) { u32x2 w; w.x = cvt_pk_bf16(o[0], o[1]); w.y = cvt_pk_bf16(o[2], o[3]); *(u32x2*)(HB + ((size_t)u.pm * BM + lrow) * 1024 + col0 + bj * HALF + n * 16) = w; }
                        }
                    sq += __shfl_xor(sq, 16); sq += __shfl_xor(sq, 32);
                    if (fq == 0) { if (gran) __hip_atomic_store(gran + ((size_t)u.pm * BM + lrow) * 16 + u.pn * 4 + wc, (1ull << 32) | (unsigned long long)__builtin_bit_cast(unsigned, sq), __ATOMIC_RELAXED, __HIP_MEMORY_SCOPE_AGENT);
                        else SS[((size_t)u.pm * BM + lrow) * 16 + u.pn * 4 + wc] = sq; }
                    asm volatile("" ::: "memory");
                }
        } else {
#pragma unroll
            for (int ai = 0; ai < 2; ++ai)
#pragma unroll
                for (int m = 0; m < 4; ++m) {
                    int lrow = ai * HALF + wr * 64 + m * 16 + fr;
                    asm volatile("" : "+v"(lrow));
                    const size_t off = (size_t)lrow * 1024 + col0;
                    float sq = 0.f;
#pragma unroll
                    for (int bj = 0; bj < 2; ++bj)
#pragma unroll
                        for (int n = 0; n < 2; ++n) {
                            const f32x4 o = *(const f32x4*)(RX + off + bj * HALF + n * 16) + acc[ai][bj][m][n] * scale;
                            *(f32x4*)(DX + off + bj * HALF + n * 16) = o;
                            sq += (o[0] * o[0] + o[1] * o[1]) + (o[2] * o[2] + o[3] * o[3]);
                            if (HB) { u32x2 w; w.x = cvt_pk_bf16(o[0], o[1]); w.y = cvt_pk_bf16(o[2], o[3]); *(u32x2*)(HB + ((size_t)u.pm * BM + lrow) * 1024 + col0 + bj * HALF + n * 16) = w; }
                        }
                    sq += __shfl_xor(sq, 16); sq += __shfl_xor(sq, 32);
                    if (fq == 0) SS[((size_t)u.pm * BM + lrow) * 16 + u.pn * 4 + wc] = sq;
                    asm volatile("" ::: "memory");
                }
        }
    }
};

struct EpiInproj {
    static constexpr bool PERM = true, AFTER_DRAIN = false;
    const float* RSTD; bf16_t* QZ; float* FZ; bf16_t* VB; bf16_t* GB; bf16_t* XBC; float* DT;
    const float* hgn; const float* dtb; float* convp; float* convs;
    __device__ __forceinline__ void operator()(const f32x4 (&acc)[2][2][4][2], const Unit& u, int wr, int wc, int fr, int fq) const {
        const int type = u.pn;
        const int row0 = u.pm * BM + wr * 64 + fr;
        float rs8[8];
#pragma unroll
        for (int i = 0; i < 8; ++i) rs8[i] = RSTD[row0 + (i >> 2) * HALF + (i & 3) * 16];
#pragma unroll
        for (int ai = 0; ai < 2; ++ai)
#pragma unroll
            for (int m = 0; m < 4; ++m) {
                const int row = row0 + ai * HALF + m * 16;
                const float rs = rs8[ai * 4 + m];
#pragma unroll
                for (int bj = 0; bj < 2; ++bj) {
                    const int c0 = 128 * bj + 32 * wc + 8 * fq;
                    float v[8];
#pragma unroll
                    for (int n = 0; n < 2; ++n)
#pragma unroll
                        for (int j = 0; j < 4; ++j) v[n * 4 + j] = acc[ai][bj][m][n][j] * rs;
                    if (type < 2 || (type >= 8 && type < 10)) {
                        const int col = (type < 2 ? 256 * type : 512 + 256 * (type - 8)) + c0;
#pragma unroll
                        for (int j = 0; j < 8; ++j) v[j] = silu_f(v[j]);
                        u32x4 w; w.x = cvt_pk_bf16(v[0], v[1]); w.y = cvt_pk_bf16(v[2], v[3]); w.z = cvt_pk_bf16(v[4], v[5]); w.w = cvt_pk_bf16(v[6], v[7]);
                        *(u32x4*)(QZ + (size_t)row * 1024 + col) = w;
                    } else if (type < 4) {
                        const int col = 256 * (type - 2) + c0;
                        *(f32x4*)(FZ + (size_t)row * 512 + col) = (f32x4){v[0], v[1], v[2], v[3]};
                        *(f32x4*)(FZ + (size_t)row * 512 + col + 4) = (f32x4){v[4], v[5], v[6], v[7]};
                    } else if (type < 6) {
                        const int col = 256 * (type - 4) + c0;
                        u32x4 w; w.x = cvt_pk_bf16(v[0], v[1]); w.y = cvt_pk_bf16(v[2], v[3]); w.z = cvt_pk_bf16(v[4], v[5]); w.w = cvt_pk_bf16(v[6], v[7]);
                        *(u32x4*)(VB + (size_t)row * 512 + col) = w;
                    } else if (type < 8) {
                        const int col = 256 * (type - 6) + c0;
                        const f32x4 n0 = *(const f32x4*)(hgn + col), n1 = *(const f32x4*)(hgn + col + 4);
#pragma unroll
                        for (int j = 0; j < 4; ++j) { v[j] = silu_f(v[j]) * n0[j]; v[4 + j] = silu_f(v[4 + j]) * n1[j]; }
                        u32x4 w; w.x = cvt_pk_bf16(v[0], v[1]); w.y = cvt_pk_bf16(v[2], v[3]); w.z = cvt_pk_bf16(v[4], v[5]); w.w = cvt_pk_bf16(v[6], v[7]);
                        *(u32x4*)(GB + (size_t)row * 512 + col) = w;
                    } else if (type < 14) {
                        const int col = 256 * (type - 10) + c0;
                        u32x4 w; w.x = cvt_pk_bf16(v[0], v[1]); w.y = cvt_pk_bf16(v[2], v[3]); w.z = cvt_pk_bf16(v[4], v[5]); w.w = cvt_pk_bf16(v[6], v[7]);
                        *(u32x4*)(XBC + (size_t)row * 1024 + col) = w;
                        float* cs = nullptr;
                        if (row < 16384) { const int t = row & 2047; if (t >= 2045) cs = convp + ((size_t)(row >> 11) * 3 + (t - 2045)) * 1024 + col; }
                        else if (row >= 16400 && row < 16528) cs = convs + ((size_t)(row - 16400) * 3 + 2) * 1024 + col;
                        if (cs) { *(f32x4*)cs = (f32x4){v[0], v[1], v[2], v[3]}; *(f32x4*)(cs + 4) = (f32x4){v[4], v[5], v[6], v[7]}; }
                    } else {
                        if (bj == 0 && wc == 0 && fq == 0) {
                            float d[8];
#pragma unroll
                            for (int j = 0; j < 8; ++j) { const float x = v[j] + dtb[j]; d[j] = x > 20.f ? x : log1pf(__expf(x)); }
                            *(f32x4*)(DT + (size_t)row * 8) = (f32x4){d[0], d[1], d[2], d[3]};
                            *(f32x4*)(DT + (size_t)row * 8 + 4) = (f32x4){d[4], d[5], d[6], d[7]};
                        }
                    }
                }
            }
    }
};
template <class Epi, class Sched, bool ALIGN_EPI = false, bool SP2 = false>
__device__ __forceinline__ void gemm_phase(PG8_LAS unsigned char* lds, const Gemm g, const Sched& S, const Epi& E, float* slab) {
    int tid_ = threadIdx.x; asm volatile("" : "+v"(tid_));
    const int tid = tid_, wid = __builtin_amdgcn_readfirstlane(tid >> 6), lane = tid & 63, wr = wid >> 2, wc = wid & 3, fr = lane & 15, fq = lane >> 4;
    const int K = g.K;
    unsigned voffA[2], voffB[2]; int aoff, boff;
#define PG8_LANE_OFFSETS(T_) do { _Pragma("unroll") for (int i = 0; i < 2; ++i) { int R, C; stage_rc((T_) * 16 + i * 8192, R, C); const int Rb = Epi::PERM ? ((R & ~31) + perm32(R & 31)) : R; \
        voffA[i] = (unsigned)(R * (g.lda ? g.lda : BK) + C) * 2u; voffB[i] = (unsigned)(Rb * K + C) * 2u; } \
        aoff = lds_byte((((T_) >> 8) & 1) * 64 + ((T_) & 15), (((T_) >> 4) & 3) * 8); boff = lds_byte((((T_) >> 6) & 3) * 32 + ((T_) & 15), (((T_) >> 4) & 3) * 8); } while (0)
    PG8_LANE_OFFSETS(tid);
    const size_t kstep = (size_t)(BK * 2), kstepA = g.lda ? (size_t)(BK * 2) : (size_t)(BM * BK * 2);
    const size_t hstep = (size_t)HALF * K * 2, hstepA = g.lda ? (size_t)HALF * g.lda * 2 : (size_t)(HALF * BK * 2);
    const size_t tstep = 2 * hstep, tstepA = g.lda ? 2 * hstepA : (size_t)(K / BK) * (BM * BK * 2);
    const unsigned ldsw = (unsigned)wid * 1024u;
#define PG8_SA(b, h) (((b) * 2 + (h)) * HTB)
#define PG8_SB(b, h) ((4 + (b) * 2 + (h)) * HTB)
#define PG8_STAGE(bufoff, gbase, voff) do { _Pragma("unroll") for (int _i = 0; _i < 2; ++_i) \
        __builtin_amdgcn_global_load_lds((const unsigned*)((const char*)(gbase) + (voff)[_i]), (PG8_LAS unsigned*)(lds + (bufoff) + ldsw + _i * 8192), 16, 0, 0); } while (0)
#define PG8_LDA(dst, b, h) do { _Pragma("unroll") for (int m = 0; m < 4; ++m) _Pragma("unroll") for (int k = 0; k < 2; ++k) dst[m][k] = *(const PG8_LAS bf16x8*)(lds + PG8_SA(b, h) + aoff + m * 2048 + k * 1024); } while (0)
#define PG8_LDB(dst, b, h) do { _Pragma("unroll") for (int n = 0; n < 2; ++n) _Pragma("unroll") for (int k = 0; k < 2; ++k) dst[n][k] = *(const PG8_LAS bf16x8*)(lds + PG8_SB(b, h) + boff + n * 2048 + k * 1024); } while (0)
#define PG8_MMA(ai, bj, At, Bt) do { __builtin_amdgcn_s_setprio(1); _Pragma("unroll") for (int m = 0; m < 4; ++m) _Pragma("unroll") for (int n = 0; n < 2; ++n) _Pragma("unroll") for (int k = 0; k < 2; ++k) \
        acc[ai][bj][m][n] = __builtin_amdgcn_mfma_f32_16x16x32_bf16(Bt[n][k], At[m][k], acc[ai][bj][m][n], 0, 0, 0); __builtin_amdgcn_s_setprio(0); } while (0)
#define PG8_WAIT_V(n) asm volatile("s_waitcnt vmcnt(" #n ")" ::: "memory")
#define PG8_WAIT_L(n) asm volatile("s_waitcnt lgkmcnt(" #n ")" ::: "memory")
#define PG8_BAR __builtin_amdgcn_s_barrier()
#define PG8_SCHED __builtin_amdgcn_sched_barrier(0)
    Unit cur, nxt; int ui = 0;
    if (!S.next(0, cur)) return;
    f32x4 acc[2][2][4][2];
#pragma unroll
    for (int a = 0; a < 2; ++a)
#pragma unroll
        for (int b = 0; b < 2; ++b)
#pragma unroll
            for (int m = 0; m < 4; ++m)
#pragma unroll
                for (int n = 0; n < 2; ++n) acc[a][b][m][n] = (f32x4){0.f, 0.f, 0.f, 0.f};
    bf16x8 At[4][2], B0[2][2], B1[2][2];
    const char* cA = (const char*)g.A + (size_t)cur.pm * tstepA + (size_t)cur.k0 * kstepA; const char* cB = (const char*)g.Bt + (size_t)cur.pn * tstep + (size_t)cur.k0 * kstep;
    if constexpr (SP2) {
        PG8_STAGE(PG8_SB(0, 0), cB, voffB); PG8_STAGE(PG8_SB(0, 1), cB + hstep, voffB); PG8_STAGE(PG8_SA(0, 0), cA, voffA); PG8_STAGE(PG8_SA(0, 1), cA + hstepA, voffA);
        if (wr == 1) PG8_BAR;
        PG8_WAIT_V(2); PG8_BAR;
        PG8_STAGE(PG8_SB(1, 0), cB + kstep, voffB); PG8_STAGE(PG8_SA(1, 0), cA + kstepA, voffA); PG8_STAGE(PG8_SB(1, 1), cB + hstep + kstep, voffB);
        PG8_WAIT_V(6); PG8_BAR;
    } else {
        PG8_STAGE(PG8_SB(0, 0), cB, voffB); PG8_STAGE(PG8_SA(0, 0), cA, voffA); PG8_STAGE(PG8_SB(0, 1), cB + hstep, voffB); PG8_STAGE(PG8_SA(0, 1), cA + hstepA, voffA);
        if (wr == 1) PG8_BAR;
        PG8_WAIT_V(4); PG8_BAR;
        PG8_STAGE(PG8_SB(1, 0), cB + kstep, voffB); PG8_STAGE(PG8_SA(1, 0), cA + kstepA, voffA); PG8_STAGE(PG8_SB(1, 1), cB + hstep + kstep, voffB);
        PG8_WAIT_V(6); PG8_BAR;
    }
    for (;;) {
        const bool has_next = S.next(ui + 1, nxt);
        const char* nA = has_next ? (const char*)g.A + (size_t)nxt.pm * tstepA + (size_t)nxt.k0 * kstepA : cA; const char* nB = has_next ? (const char*)g.Bt + (size_t)nxt.pn * tstep + (size_t)nxt.k0 * kstep : cB;
        const int nt = cur.nt;
        for (int t = 0; t < nt; t += 2) {
            const bool last = (t == nt - 2);
            const char* a1 = cA + (size_t)(t + 1) * kstepA;
            const char* a2 = last ? nA : cA + (size_t)(t + 2) * kstepA; const char* b2 = last ? nB : cB + (size_t)(t + 2) * kstep;
            const char* a3 = a2 + kstepA; const char* b3 = b2 + kstep;
            if constexpr (SP2) {
            PG8_LDB(B0, 0, 0); PG8_LDB(B1, 0, 1); PG8_SCHED; PG8_LDA(At, 0, 0); PG8_STAGE(PG8_SA(1, 1), a1 + hstepA, voffA);
            PG8_WAIT_V(8); PG8_WAIT_L(0); PG8_BAR; PG8_MMA(0, 0, At, B0); PG8_MMA(0, 1, At, B1); PG8_BAR; PG8_SCHED;
            PG8_LDA(At, 0, 1); PG8_STAGE(PG8_SB(0, 0), b2, voffB); PG8_STAGE(PG8_SB(0, 1), b2 + hstep, voffB); PG8_STAGE(PG8_SA(0, 0), a2, voffA);
            PG8_WAIT_V(8); PG8_WAIT_L(0); PG8_BAR; PG8_MMA(1, 0, At, B0); PG8_MMA(1, 1, At, B1); PG8_BAR; PG8_SCHED;
            PG8_LDB(B0, 1, 0); PG8_LDB(B1, 1, 1); PG8_SCHED; PG8_LDA(At, 1, 0); PG8_STAGE(PG8_SA(0, 1), a2 + hstepA, voffA);
            PG8_WAIT_V(8); PG8_WAIT_L(0); PG8_BAR; PG8_MMA(0, 0, At, B0); PG8_MMA(0, 1, At, B1); PG8_BAR; PG8_SCHED;
            PG8_LDA(At, 1, 1); PG8_STAGE(PG8_SB(1, 0), b3, voffB); PG8_STAGE(PG8_SB(1, 1), b3 + hstep, voffB); PG8_STAGE(PG8_SA(1, 0), a3, voffA);
            PG8_WAIT_V(8); PG8_WAIT_L(0); PG8_BAR; PG8_MMA(1, 0, At, B0); PG8_MMA(1, 1, At, B1); PG8_BAR; PG8_SCHED;
            } else {
            PG8_LDB(B0, 0, 0); PG8_SCHED; PG8_LDA(At, 0, 0); PG8_STAGE(PG8_SA(1, 1), a1 + hstepA, voffA);
            PG8_WAIT_L(8); PG8_BAR; PG8_WAIT_L(0); PG8_MMA(0, 0, At, B0); PG8_BAR; PG8_SCHED;
            PG8_LDB(B1, 0, 1); PG8_STAGE(PG8_SB(0, 0), b2, voffB);
            PG8_BAR; PG8_WAIT_L(0); PG8_MMA(0, 1, At, B1); PG8_BAR;
            PG8_LDA(At, 0, 1); PG8_STAGE(PG8_SA(0, 0), a2, voffA);
            PG8_BAR; PG8_WAIT_L(0); PG8_MMA(1, 0, At, B0); PG8_BAR; PG8_SCHED;
            PG8_STAGE(PG8_SB(0, 1), b2 + hstep, voffB);
            PG8_WAIT_V(6); PG8_BAR; PG8_MMA(1, 1, At, B1); PG8_BAR;
            PG8_LDB(B0, 1, 0); PG8_SCHED; PG8_LDA(At, 1, 0); PG8_STAGE(PG8_SA(0, 1), a2 + hstepA, voffA);
            PG8_WAIT_L(8); PG8_BAR; PG8_WAIT_L(0); PG8_MMA(0, 0, At, B0); PG8_BAR; PG8_SCHED;
            PG8_LDB(B1, 1, 1); PG8_STAGE(PG8_SB(1, 0), b3, voffB);
            PG8_BAR; PG8_WAIT_L(0); PG8_MMA(0, 1, At, B1); PG8_BAR;
            PG8_LDA(At, 1, 1); PG8_STAGE(PG8_SA(1, 0), a3, voffA);
            PG8_BAR; PG8_WAIT_L(0); PG8_MMA(1, 0, At, B0); PG8_BAR; PG8_SCHED;
            PG8_STAGE(PG8_SB(1, 1), b3 + hstep, voffB);
            PG8_WAIT_V(6); PG8_BAR; PG8_MMA(1, 1, At, B1); PG8_BAR;
            }
        }
        if constexpr (ALIGN_EPI) { if (wr == 0) PG8_BAR; }
        if (cur.kind == 1) {
            float* sb = slab + (size_t)cur.slot * 65536;
#pragma unroll
            for (int a = 0; a < 2; ++a)
#pragma unroll
                for (int m = 0; m < 4; ++m) {
                    int lrow = a * HALF + wr * 64 + m * 16 + fr; asm volatile("" : "+v"(lrow));
                    float* rp = sb + (size_t)lrow * 256 + wc * 32 + 4 * fq;
#pragma unroll
                    for (int b = 0; b < 2; ++b)
#pragma unroll
                        for (int n = 0; n < 2; ++n) *(f32x4*)(rp + b * HALF + n * 16) = acc[a][b][m][n];
                }
        } else {
            E(acc, cur, wr, wc, fr, fq);
        }
        if (!has_next) break;
#pragma unroll
        for (int a = 0; a < 2; ++a)
#pragma unroll
            for (int b = 0; b < 2; ++b)
#pragma unroll
                for (int m = 0; m < 4; ++m)
#pragma unroll
                    for (int n = 0; n < 2; ++n) acc[a][b][m][n] = (f32x4){0.f, 0.f, 0.f, 0.f};
        cur = nxt; cA = nA; cB = nB; ++ui;
        if constexpr (ALIGN_EPI) { if (wr == 1) PG8_BAR; }
    }
    PG8_WAIT_V(0);
    if constexpr (!ALIGN_EPI) { if (wr == 0) PG8_BAR; }
    PG8_BAR;
#undef PG8_LANE_OFFSETS
#undef PG8_SA
#undef PG8_SB
#undef PG8_STAGE
#undef PG8_LDA
#undef PG8_LDB
#undef PG8_MMA
#undef PG8_WAIT_V
#undef PG8_WAIT_L
#undef PG8_BAR
#undef PG8_SCHED
}
}
constexpr int NWAVES = 8;
constexpr int D = 1024, NBATCH = 8, SEQ = 2048, NMETA = 16, NSMP = 128, FF = 2816;
constexpr int MP = NBATCH * SEQ;
constexpr int ROW_META = MP, ROW_SMP = MP + NMETA;
constexpr int M = 16640;
constexpr int NIN = 3592, NINP = 3840;
constexpr int LDH = 0;
constexpr int CH = 64, NCH = SEQ / CH;
constexpr float EPS = 1e-6f;
constexpr size_t O_YP = 0, O_YS = O_YP + (size_t)MP * D, O_HGP = O_YS + (size_t)NSMP * D, O_SSP = O_HGP + (size_t)NBATCH * 4 * 128 * 128, O_CVP = O_SSP + (size_t)NBATCH * 8 * 64 * 128,
                 O_HGS = O_CVP + (size_t)NBATCH * 3 * 1024, O_SSS = O_HGS + (size_t)NSMP * 4 * 128 * 128, O_CVS = O_SSS + (size_t)NSMP * 8 * 64 * 128, O_END = O_CVS + (size_t)NSMP * 3 * 1024;
constexpr size_t KiB = 1024, MiB = 1u << 20;
constexpr size_t WS_CTL = 0, CTL_ZERO_BYTES = 1 * MiB;
constexpr size_t WS_WGU1 = 1 * MiB, WS_WD1 = 12 * MiB, WS_WIN = 17 * MiB + 512 * KiB, WS_WOUT = 25 * MiB, WS_WGU2 = 27 * MiB, WS_WD2 = 38 * MiB;
constexpr size_t WS_HB = 44 * MiB;
constexpr size_t WS_R = 77 * MiB;
constexpr size_t WS_H = WS_R;
constexpr size_t WS_QZ = 77 * MiB;
constexpr size_t WS_FZ = 110 * MiB;
constexpr size_t WS_VB = 143 * MiB;
constexpr size_t WS_GB = 160 * MiB;
constexpr size_t WS_XBC = 177 * MiB;
constexpr size_t WS_UM = 210 * MiB;
constexpr size_t WS_DT = 243 * MiB;
constexpr size_t WS_ER = 244 * MiB, WS_EL = 245 * MiB;
constexpr size_t WS_DCY = 246 * MiB;
constexpr size_t WS_LB = 246 * MiB + 512 * KiB;
constexpr size_t WS_HX0 = 247 * MiB, WS_HX = 248 * MiB;
constexpr size_t WS_SS1 = 249 * MiB, WS_SS2 = 250 * MiB + 256 * KiB, WS_SS3 = 251 * MiB + 512 * KiB, WS_SS4 = 252 * MiB + 768 * KiB;
constexpr size_t WS_END = 256 * MiB;
constexpr size_t UTH_ENT = 128 * 128;
constexpr size_t UM_ENT = 64 * 128;
static_assert(WS_HB + (size_t)M * 1024 * 2 <= WS_R && (1024 + 4) * UTH_ENT * 2 <= (size_t)MP * D * 4, "hb / UTH (in the y_prompt output region)");
static_assert(WS_H + (size_t)M * FF * 2 <= WS_XBC && WS_QZ + (size_t)M * 2048 <= WS_FZ && WS_FZ + (size_t)M * 2048 <= WS_VB && WS_VB + (size_t)M * 1024 <= WS_GB && WS_GB + (size_t)M * 1024 <= WS_XBC, "map 1");
static_assert(WS_XBC + (size_t)M * 2048 <= WS_UM && WS_UM + (2048 + 8) * UM_ENT * 2 <= WS_DT && WS_DT + (size_t)M * 32 <= WS_ER && WS_SS4 + (size_t)M * 64 <= WS_END, "map 2");
constexpr int CW_BAR = 4096;
constexpr int RING_BYTES = 131072, LDSCTL_OFF = RING_BYTES, MISC_OFF = LDSCTL_OFF + 320, LDS_BYTES = 147456;

#define GAS __attribute__((address_space(1)))
#define LAS __attribute__((address_space(3)))
typedef unsigned short bf16;
typedef unsigned v4u __attribute__((ext_vector_type(4)));
typedef float f32x4 __attribute__((ext_vector_type(4)));
typedef float f32x16 __attribute__((ext_vector_type(16)));
typedef short bf16x8 __attribute__((ext_vector_type(8)));
typedef GAS unsigned gu32;
#define RLX_AGENT __ATOMIC_RELAXED, __HIP_MEMORY_SCOPE_AGENT
#define LDS_WAIT() asm volatile("s_waitcnt lgkmcnt(0)" ::: "memory")
#define VM_WAIT() asm volatile("s_waitcnt vmcnt(0)" ::: "memory")
typedef __bf16 bf16x2_t __attribute__((ext_vector_type(2)));
__device__ __forceinline__ unsigned pk2(float lo, float hi) { bf16x2_t v; v.x = (__bf16)lo; v.y = (__bf16)hi; return __builtin_bit_cast(unsigned, v); }
__device__ __forceinline__ unsigned f2bf(float f) { return (unsigned)__builtin_bit_cast(unsigned short, (__bf16)f); }
__device__ __forceinline__ float bf2f(unsigned short b) { return __builtin_bit_cast(float, (unsigned)b << 16); }
__device__ __forceinline__ float sigm(float x) { return __builtin_amdgcn_rcpf(1.0f + __expf(-x)); }
__device__ __forceinline__ float silu(float x) { return x * __builtin_amdgcn_rcpf(1.0f + __expf(-x)); }
#define XB_TMO      128
#define XB_XCNT(j)  (256  + 64 * (j))
#define XB_XSUB(j)  (1280 + 64 * (j))
#define XB_XGEN(j)  (2304 + 64 * (j))
#define XB_TOP      3328
#define XB_TOPGEN   3392
#define XCD_BAR_WORDS 3456
#define XB_SPIN_CAP (1u << 18)

__device__ __forceinline__ unsigned xb_ld(unsigned* p)              { return __hip_atomic_load(p, __ATOMIC_RELAXED, __HIP_MEMORY_SCOPE_AGENT); }
__device__ __forceinline__ unsigned xb_add(unsigned* p, unsigned v) { return __hip_atomic_fetch_add(p, v, __ATOMIC_RELAXED, __HIP_MEMORY_SCOPE_AGENT); }
__device__ __forceinline__ unsigned xb_xcc_id() { return (unsigned)__builtin_amdgcn_s_getreg((3 << 11) | 20) & 0xFu; }
#define XB_SPIN(cond, bar) do { unsigned _sp = 0; while (cond) { __builtin_amdgcn_s_sleep(1); \
    if ((++_sp & 255u) == 0u) { if (xb_ld(&(bar)[XB_TMO])) break; if (_sp > XB_SPIN_CAP) { atomicAdd(&(bar)[XB_TMO], 1u); break; } } } } while (0)

struct XcdBarrier {
    unsigned* bar; unsigned x;
    volatile LAS unsigned* st;
};

__device__ __forceinline__ XcdBarrier xcd_barrier_post(unsigned* bar, volatile LAS unsigned* st) {
    XcdBarrier b; b.bar = bar; b.x = xb_xcc_id(); b.st = st;
    if (threadIdx.x == 0) (void)xb_add(&bar[XB_XCNT(b.x)], 1u);
    return b;
}
__device__ __forceinline__ void xcd_barrier_complete(unsigned* bar, unsigned x, unsigned& nloc, unsigned& nx) {
    const unsigned G = gridDim.x * gridDim.y * gridDim.z;
    unsigned sum, cnt, mine, sp = 0u;
    for (;;) {
        sum = 0u; cnt = 0u; mine = 0u;
#pragma unroll
        for (unsigned j = 0; j < 16; ++j) { const unsigned c = xb_ld(&bar[XB_XCNT(j)]); sum += c; cnt += (c > 0u) ? 1u : 0u; mine = (j == x) ? c : mine; }
        if (sum == G) break;
        __builtin_amdgcn_s_sleep(1);
        if ((++sp & 255u) == 0u) { if (xb_ld(&bar[XB_TMO])) break; if (sp > XB_SPIN_CAP) { atomicAdd(&bar[XB_TMO], 1u); break; } }
    }
    nloc = mine > 0u ? mine : 1u; nx = cnt > 0u ? cnt : 1u;
}

__device__ __forceinline__ void xcd_barrier(const XcdBarrier& b) {
    asm volatile("s_waitcnt vmcnt(0)" ::: "memory");
    __syncthreads();
    if (threadIdx.x == 0) {
        unsigned* bar = b.bar;
        __builtin_amdgcn_s_waitcnt(0);
        unsigned nloc = b.st[0], nx = b.st[1];
        if (nloc == 0u) { xcd_barrier_complete(bar, b.x, nloc, nx); b.st[0] = nloc; b.st[1] = nx; }
        const unsigned old = xb_add(&bar[XB_XSUB(b.x)], 1u);
        const unsigned gen = old / nloc;
        if (old + 1u == (gen + 1u) * nloc) {
            __builtin_amdgcn_fence(__ATOMIC_RELEASE, "agent");
            asm volatile("s_waitcnt vmcnt(0)" ::: "memory");
            const unsigned og = xb_add(&bar[XB_TOP], 1u);
            const unsigned tg = og / nx;
            if (og + 1u == (tg + 1u) * nx) xb_add(&bar[XB_TOPGEN], 1u);
            else XB_SPIN(xb_ld(&bar[XB_TOPGEN]) == tg, bar);
            xb_add(&bar[XB_XGEN(b.x)], 1u);
            __builtin_amdgcn_fence(__ATOMIC_ACQUIRE, "agent");
            asm volatile("s_waitcnt vmcnt(0)" ::: "memory");
        } else {
            XB_SPIN(xb_ld(&bar[XB_XGEN(b.x)]) == gen, bar);
            __builtin_amdgcn_fence(__ATOMIC_ACQUIRE, "agent");
            asm volatile("s_waitcnt vmcnt(0)" ::: "memory");
        }
    }
    __syncthreads();
}
struct Frame {
    LAS unsigned char* lds;
    volatile LAS unsigned* MISC;
    gu32* ctl;
    int tid, lane, wave, vcu, G;
    GAS float* out; GAS unsigned char* ws;
};
#define WSP(T, off) ((T*)(F.ws + (off)))
#define OUTP(off) ((float*)(F.out + (off)))
#define UTHP ((bf16*)OUTP(O_YP))
constexpr int TAB_OFF = MISC_OFF + 256;
__device__ __forceinline__ const float* inp(const Frame& F, int k) {
    const unsigned long long v = ((const LAS unsigned long long*)(F.lds + TAB_OFF))[k];
    const unsigned lo = __builtin_amdgcn_readfirstlane((unsigned)v), hi = __builtin_amdgcn_readfirstlane((unsigned)(v >> 32));
    return (const float*)(const GAS float*)(((unsigned long long)hi << 32) | lo);
}
__device__ __forceinline__ float wave_sum(float v) {
#pragma unroll
    for (int o = 1; o < 64; o <<= 1) v += __shfl_xor(v, o);
    return v;
}
__device__ __forceinline__ float half_sum32(float v) {
#pragma unroll
    for (int o = 1; o < 32; o <<= 1) v += __shfl_xor(v, o);
    return v;
}
__device__ __forceinline__ float rowsum16(const float (&v)[16], int lane, int& rsel) {
    const bool b4 = (lane & 16) != 0, b3 = (lane & 8) != 0, b2 = (lane & 4) != 0, b1 = (lane & 2) != 0;
    float a[8], b[4], c2[2];
#pragma unroll
    for (int j = 0; j < 8; ++j) { const float t = __shfl_xor(b4 ? v[j] : v[j + 8], 16); a[j] = (b4 ? v[j + 8] : v[j]) + t; }
#pragma unroll
    for (int j = 0; j < 4; ++j) { const float t = __shfl_xor(b3 ? a[j] : a[j + 4], 8); b[j] = (b3 ? a[j + 4] : a[j]) + t; }
#pragma unroll
    for (int j = 0; j < 2; ++j) { const float t = __shfl_xor(b2 ? b[j] : b[j + 2], 4); c2[j] = (b2 ? b[j + 2] : b[j]) + t; }
    float d = (b1 ? c2[1] : c2[0]) + __shfl_xor(b1 ? c2[0] : c2[1], 2);
    d += __shfl_xor(d, 1);
    rsel = (b4 ? 8 : 0) + (b3 ? 4 : 0) + (b2 ? 2 : 0) + (b1 ? 1 : 0);
    return d;
}
__device__ __forceinline__ void tr_item(const float* W, int N, int K, int k0, int n0, const float* nw, bf16* dst, LAS float* scr, int lane) {
    float v[32];
    const int n = n0 + (lane & 31);
#pragma unroll
    for (int i = 0; i < 32; ++i) { const int kk = 2 * i + (lane >> 5); v[i] = (n < N) ? W[(size_t)(k0 + kk) * N + n] : 0.f; }
    if (nw) {
#pragma unroll
        for (int i = 0; i < 32; ++i) v[i] *= nw[k0 + 2 * i + (lane >> 5)];
    }
#pragma unroll
    for (int i = 0; i < 32; ++i) scr[(2 * i + (lane >> 5)) * 33 + (lane & 31)] = v[i];
    LDS_WAIT(); asm volatile("" ::: "memory");
    const int c = lane & 7;
#pragma unroll
    for (int j = 0; j < 4; ++j) { const int nn = (lane >> 3) + 8 * j; const LAS float* s = scr + (8 * c) * 33 + nn;
        v4u o; o.x = pk2(s[0 * 33], s[1 * 33]); o.y = pk2(s[2 * 33], s[3 * 33]); o.z = pk2(s[4 * 33], s[5 * 33]); o.w = pk2(s[6 * 33], s[7 * 33]);
        *(GAS v4u*)(dst + (size_t)nn * K + k0 + 8 * c) = o; }
    LDS_WAIT(); asm volatile("" ::: "memory");
}
constexpr int P0_I_GU = 16 * 88, P0_I_IN = 16 * 120, P0_I_OUT = 16 * 32, P0_NITEMS = 6 * P0_I_GU + P0_I_IN + P0_I_OUT, P0_ITEMS_FIRST = 2 * P0_I_GU;
__device__ __forceinline__ void p0_weight_items(Frame& F, int lo, int hi, int iw, int nw_) {
    LAS float* scr = (LAS float*)(F.lds + F.wave * 16384);
    const int lane = F.lane;
    constexpr int I_GU = P0_I_GU, I_DN = 44 * 32, I_IN = P0_I_IN;
    static_assert(I_DN == I_GU, "items");
    for (int it = lo + iw; it < hi; it += nw_) {
        int r = it;
        if (r < 6 * I_GU) {
            const int which = r / I_GU; r -= which * I_GU;
            const int ffn = which / 3, kind = which % 3;
            if (kind < 2) {
                const int kb = r / 88, nb = r % 88, n0 = 32 * nb, k0 = 64 * kb;
                const float* W = ffn ? (kind ? inp(F, 23) : inp(F, 22)) : (kind ? inp(F, 9) : inp(F, 8)); const float* nw = ffn ? inp(F, 21) : inp(F, 7);
                bf16* base = WSP(bf16, ffn ? WS_WGU2 : WS_WGU1);
                const int drow = 256 * (n0 >> 7) + (n0 & 127) + 128 * kind;
                tr_item(W, FF, 1024, k0, n0, nw, base + (size_t)drow * 1024, scr, lane);
            } else {
                const int kb = r / 32, nb = r % 32, n0 = 32 * nb, k0 = 64 * kb;
                const float* W = ffn ? inp(F, 24) : inp(F, 10);
                bf16* base = WSP(bf16, ffn ? WS_WD2 : WS_WD1);
                tr_item(W, 1024, FF, k0, n0, nullptr, base + (size_t)n0 * FF, scr, lane);
            }
            continue;
        }
        r -= 6 * I_GU;
        if (r < I_IN) { const int kb = r / 120, nb = r % 120, n0 = 32 * nb, k0 = 64 * kb;
            tr_item(inp(F, 12), NIN, 1024, k0, n0, inp(F, 11), WSP(bf16, WS_WIN) + (size_t)n0 * 1024, scr, lane); continue; }
        r -= I_IN;
        { const int kb = r / 32, nb = r % 32, n0 = 32 * nb, k0 = 64 * kb;
          tr_item(inp(F, 20), 1024, 1024, k0, n0, nullptr, WSP(bf16, WS_WOUT) + (size_t)n0 * 1024, scr, lane); }
    }
}
__device__ __forceinline__ void p0_prologue(Frame& F, int defer) {
    const int gw = F.vcu * NWAVES + F.wave, NGW = F.G * NWAVES, lane = F.lane;
    p0_weight_items(F, 0, defer ? P0_ITEMS_FIRST : P0_NITEMS, gw, NGW);
    bf16* HB = WSP(bf16, WS_HB); float* RS1 = WSP(float, WS_SS1); float* HX0 = WSP(float, WS_HX0);
    {
        const float* x0 = inp(F, 0); const float* xm = inp(F, 5); const float* xs = inp(F, 1);
#define ROWSRC(m) ((m) < MP ? x0 + (size_t)(m) * D : (m) < ROW_SMP ? xm + (size_t)((m) - ROW_META) * D : (m) < ROW_SMP + NSMP ? xs + (size_t)((m) - ROW_SMP) * D : nullptr)
        f32x4 nx[4];
        { const float* src = gw < M ? ROWSRC(gw) : nullptr;
#pragma unroll
          for (int j = 0; j < 4; ++j) nx[j] = src ? ((const GAS f32x4*)src)[lane + 64 * j] : (f32x4){0.f, 0.f, 0.f, 0.f}; }
        for (int m = gw; m < M; m += NGW) {
            f32x4 v[4]; float s = 0.f;
#pragma unroll
            for (int j = 0; j < 4; ++j) v[j] = nx[j];
            { const int mn = m + NGW; const float* src = mn < M ? ROWSRC(mn) : nullptr;
#pragma unroll
              for (int j = 0; j < 4; ++j) nx[j] = src ? ((const GAS f32x4*)src)[lane + 64 * j] : (f32x4){0.f, 0.f, 0.f, 0.f}; }
#pragma unroll
            for (int j = 0; j < 4; ++j) s += (v[j][0] * v[j][0] + v[j][1] * v[j][1]) + (v[j][2] * v[j][2] + v[j][3] * v[j][3]);
            s = wave_sum(s);
            GAS unsigned long long* o8 = (GAS unsigned long long*)(HB + (size_t)m * D) + lane;
#pragma unroll
            for (int j = 0; j < 4; ++j) o8[64 * j] = (unsigned long long)pk2(v[j][0], v[j][1]) | ((unsigned long long)pk2(v[j][2], v[j][3]) << 32);
            if (lane == 0) RS1[m] = 1.0f / sqrtf(s * (1.0f / 1024.0f) + EPS);
            if (m >= MP) {
#pragma unroll
                for (int j = 0; j < 4; ++j) ((GAS f32x4*)(HX0 + (size_t)(m - MP) * D))[lane + 64 * j] = v[j];
            }
        }
#undef ROWSRC
    }
    if (gw == 0) { float* LB = WSP(float, WS_LB); const float* l = inp(F, 6);
        for (int c = lane; c < 512; c += 64) LB[c] = 1.0f / (1.0f + __expf(l[512 + c] - l[c])); }
}
template <int ppu> __device__ __forceinline__ void fix_extra(Frame& F, int split, const float* slab, const float* RX, float* DX, bf16* HB, const float* SS, float* RSTD, float scale) {
    const int lane = F.lane;
    if (split) {
        LAS float* red = (LAS float*)F.lds;
        for (int lr = F.vcu; lr < 256; lr += F.G) {
            if (F.wave < 4) {
                const int j = F.wave;
                const float* sp = slab + (size_t)j * ppu * 65536 + (size_t)lr * 256 + 4 * lane; f32x4 sum = (f32x4){0.f, 0.f, 0.f, 0.f};
#pragma unroll
                for (int p = 0; p < ppu; ++p) sum = sum + *(const GAS f32x4*)(sp + (size_t)p * 65536);
                const f32x4 v = ((const GAS f32x4*)(RX + (size_t)lr * 1024))[lane + 64 * j] + sum * scale;
                const float ss = wave_sum((v[0] * v[0] + v[1] * v[1]) + (v[2] * v[2] + v[3] * v[3]));
                ((GAS f32x4*)(DX + (size_t)lr * 1024))[lane + 64 * j] = v;
                ((GAS unsigned long long*)(HB + (size_t)(MP + lr) * 1024))[lane + 64 * j] = (unsigned long long)pk2(v[0], v[1]) | ((unsigned long long)pk2(v[2], v[3]) << 32);
                if (lane == 0) red[j] = ss;
            }
            __syncthreads();
            if (F.tid == 0) RSTD[MP + lr] = 1.0f / sqrtf(((red[0] + red[1]) + (red[2] + red[3])) * (1.0f / 1024.0f) + EPS);
            __syncthreads();
        }
    }
    const int gt = F.vcu * (NWAVES * 64) + F.tid, NT = F.G * NWAVES * 64, nrows = split ? MP : M;
    for (int r = gt; r < nrows; r += NT) RSTD[r] = pg8::row_rstd(SS, r);
}
template <int ppu> __device__ __forceinline__ void p8_final(Frame& F, int split, const float* slab) {
    const int gw = F.vcu * NWAVES + F.wave, NGW = F.G * NWAVES, lane = F.lane;
    const float* SS4 = WSP(float, WS_SS4); const float* nf = inp(F, 25);
    f32x4 w[4];
#pragma unroll
    for (int j = 0; j < 4; ++j) w[j] = ((const GAS f32x4*)nf)[lane + 64 * j];
    for (int m = split ? MP + gw : gw; m < MP + NSMP; m += NGW) {
        if (m < MP) {
            float* p = OUTP(O_YP) + (size_t)m * D;
            const float rs = pg8::row_rstd(SS4, m);
#pragma unroll
            for (int j = 0; j < 4; ++j) { f32x4 v = ((const GAS f32x4*)p)[lane + 64 * j]; v = v * rs * w[j]; ((GAS f32x4*)p)[lane + 64 * j] = v; }
        } else {
            const int s = m - MP, lr = NMETA + s; const float* src = WSP(float, WS_HX) + (size_t)lr * D; float* dst = OUTP(O_YS) + (size_t)s * D;
            f32x4 v[4]; float ss = 0.f;
#pragma unroll
            for (int j = 0; j < 4; ++j) { v[j] = ((const GAS f32x4*)src)[lane + 64 * j];
                if (split) { const float* sp = slab + (size_t)j * ppu * 65536 + (size_t)lr * 256 + 4 * lane; f32x4 sum = (f32x4){0.f, 0.f, 0.f, 0.f};
#pragma unroll
                    for (int p = 0; p < ppu; ++p) sum = sum + *(const GAS f32x4*)(sp + (size_t)p * 65536);
                    v[j] = v[j] + sum * 0.5f; }
                ss += (v[j][0] * v[j][0] + v[j][1] * v[j][1]) + (v[j][2] * v[j][2] + v[j][3] * v[j][3]); }
            const float rs = split ? 1.0f / sqrtf(wave_sum(ss) * (1.0f / 1024.0f) + EPS) : pg8::row_rstd(SS4, ROW_SMP + s);
#pragma unroll
            for (int j = 0; j < 4; ++j) ((GAS f32x4*)dst)[lane + 64 * j] = v[j] * rs * w[j];
        }
    }
}
__device__ __forceinline__ int rowreg(int reg, int lane) { return (reg & 3) + 8 * (reg >> 2) + 4 * (lane >> 5); }
template <int K> __device__ __forceinline__ void mma32_ll(f32x16& acc, const LAS bf16* A, int lda, const LAS bf16* B, int ldb, int lane) {
    const LAS bf16* pa = A + (lane & 31) * lda + 8 * (lane >> 5); const LAS bf16* pb = B + (lane & 31) * ldb + 8 * (lane >> 5);
#pragma unroll
    for (int k0 = 0; k0 < K; k0 += 16) { const bf16x8 a = *(const LAS bf16x8*)(pa + k0); const bf16x8 b = *(const LAS bf16x8*)(pb + k0); acc = __builtin_amdgcn_mfma_f32_32x32x16_bf16(a, b, acc, 0, 0, 0); }
}
template <int K> __device__ __forceinline__ void mma32_lg(f32x16& acc, const LAS bf16* A, int lda, const bf16* Bg, int ldb, int lane) {
    const LAS bf16* pa = A + (lane & 31) * lda + 8 * (lane >> 5); const bf16* pb = Bg + (size_t)(lane & 31) * ldb + 8 * (lane >> 5);
#pragma unroll
    for (int kc = 0; kc < K; kc += 64) {
        bf16x8 b[4];
#pragma unroll
        for (int k = 0; k < 4; ++k) b[k] = *(const GAS bf16x8*)(pb + kc + 16 * k);
#pragma unroll
        for (int k = 0; k < 4; ++k) { const bf16x8 a = *(const LAS bf16x8*)(pa + kc + 16 * k); acc = __builtin_amdgcn_mfma_f32_32x32x16_bf16(a, b[k], acc, 0, 0, 0); }
        asm volatile("" ::: "memory");
    }
}
__device__ __forceinline__ void load_frags8(const bf16* Bg, int ldb, int lane, bf16x8 (&b)[8]) {
    const bf16* pb = Bg + (size_t)(lane & 31) * ldb + 8 * (lane >> 5);
#pragma unroll
    for (int k = 0; k < 8; ++k) b[k] = *(const GAS bf16x8*)(pb + 16 * k);
}
__device__ __forceinline__ void mma32_lf8(f32x16& acc, const LAS bf16* A, int lda, const bf16x8 (&b)[8], int lane) {
    const LAS bf16* pa = A + (lane & 31) * lda + 8 * (lane >> 5);
#pragma unroll
    for (int k = 0; k < 8; ++k) { const bf16x8 a = *(const LAS bf16x8*)(pa + 16 * k); acc = __builtin_amdgcn_mfma_f32_32x32x16_bf16(a, b[k], acc, 0, 0, 0); }
}
#define ZERO16 ((f32x16){0.f,0.f,0.f,0.f,0.f,0.f,0.f,0.f,0.f,0.f,0.f,0.f,0.f,0.f,0.f,0.f})

struct HgP { int rowbase, h, nvalid, ent, eidx; };
__device__ __forceinline__ HgP hg_params(int i) {
    HgP p;
    if (i < 1024) { const int b = i >> 7, h = (i >> 5) & 3, c = i & 31; p.rowbase = b * SEQ + c * CH; p.h = h; p.nvalid = CH; p.ent = (b * 4 + h) * 32 + c; p.eidx = b * 32 + c; }
    else { const int h = i - 1024; p.rowbase = ROW_META; p.h = h; p.nvalid = NMETA; p.ent = 1024 + h; p.eidx = 256; }
    return p;
}
struct HgRaw { f32x4 fz[4]; v4u vb[2]; v4u qz[2]; v4u gb[2]; };
template <int PASS> __device__ __forceinline__ void hg_load(Frame& F, const HgP& p, HgRaw& r) {
    const int tid = F.tid;
    const float* FZ = WSP(float, WS_FZ) + (size_t)p.rowbase * 512 + 128 * p.h;
#pragma unroll
    for (int i = 0; i < 4; ++i) { const int idx = tid + 512 * i; r.fz[i] = *(const GAS f32x4*)(FZ + (size_t)(idx >> 5) * 512 + (idx & 31) * 4); }
    const bf16* VB = WSP(bf16, WS_VB) + (size_t)p.rowbase * 512 + 128 * p.h;
#pragma unroll
    for (int i = 0; i < 2; ++i) { const int idx = tid + 512 * i; r.vb[i] = *(const GAS v4u*)(VB + (size_t)(idx >> 4) * 512 + (idx & 15) * 8); }
    if (PASS == 3) { const bf16* QZ = WSP(bf16, WS_QZ) + (size_t)p.rowbase * 1024 + 128 * p.h;
#pragma unroll
        for (int i = 0; i < 2; ++i) { const int idx = tid + 512 * i; r.qz[i] = *(const GAS v4u*)(QZ + (size_t)(idx >> 4) * 1024 + (idx & 15) * 8); }
        const bf16* GB = WSP(bf16, WS_GB) + (size_t)p.rowbase * 512 + 128 * p.h;
#pragma unroll
        for (int i = 0; i < 2; ++i) { const int idx = tid + 512 * i; r.gb[i] = *(const GAS v4u*)(GB + (size_t)(idx >> 4) * 512 + (idx & 15) * 8); } }
}
template <int PASS> __device__ __forceinline__ void hgrn_item(Frame& F, const HgP p, HgRaw& raw, bool has_next, const HgP pn) {
    LAS unsigned char* L = F.lds;
    LAS float* TOT = (LAS float*)L;
    LAS float* FZL = (LAS float*)(L + 2048);
    LAS bf16* VL = (LAS bf16*)(L + 35840);
    LAS bf16* QN = (LAS bf16*)(L + 53248);
    LAS bf16* KN = (LAS bf16*)(L + 70656);
    LAS bf16* VT = (LAS bf16*)(L + 88064);
    LAS bf16* KT = (LAS bf16*)(L + 106496);
    LAS bf16* PP = (LAS bf16*)(L + 106496);
    LAS float* PART = (LAS float*)(L + 124928);
    LAS float* RS = (LAS float*)(L + 125952);
    const int tid = F.tid, lane = F.lane, w = F.wave, c = tid & 127, rg = tid >> 7;
    const int rowbase = p.rowbase, h = p.h;
#pragma unroll
    for (int i = 0; i < 4; ++i) { const int idx = tid + 512 * i; *(LAS f32x4*)(FZL + (idx >> 5) * 132 + (idx & 31) * 4) = raw.fz[i]; }
#pragma unroll
    for (int i = 0; i < 2; ++i) { const int idx = tid + 512 * i; *(LAS v4u*)(VL + (idx >> 4) * 136 + (idx & 15) * 8) = raw.vb[i]; if (PASS == 3) *(LAS v4u*)(QN + (idx >> 4) * 136 + (idx & 15) * 8) = raw.qz[i]; }
    v4u gbr[2]; if (PASS == 3) { gbr[0] = raw.gb[0]; gbr[1] = raw.gb[1]; }
    if (has_next) hg_load<PASS>(F, pn, raw);
    const float lbc = WSP(float, WS_LB)[128 * h + c];
    __syncthreads();
    float bl[16], kk[16], run = 0.f;
#pragma unroll
    for (int i = 0; i < 16; ++i) {
        const int t = rg * 16 + i; const float fz = FZL[t * 132 + c];
        const float sg = sigm(fz), f = lbc + (1.0f - lbc) * sg; float lf = __logf(f), k = (1.0f - lbc) * (1.0f - sg);
        if (t >= p.nvalid) { lf = 0.f; k = 0.f; }
        run += lf; bl[i] = run; kk[i] = k;
    }
    TOT[rg * 128 + c] = run;
    __syncthreads();
    const float t0 = TOT[c], t1 = TOT[128 + c], t2 = TOT[256 + c], t3 = TOT[384 + c];
    const float pre = rg == 0 ? 0.f : rg == 1 ? t0 : rg == 2 ? t0 + t1 : (t0 + t1) + t2;
    const float r = t0 + t1, blast = (t0 + t1) + (t2 + t3);
    unsigned pvv[8];
#pragma unroll
    for (int i = 0; i < 16; i += 2) pvv[i >> 1] = (unsigned)VL[(rg * 16 + i) * 136 + c] | ((unsigned)VL[(rg * 16 + i + 1) * 136 + c] << 16);
    *(LAS v4u*)(VT + c * 72 + rg * 16) = (v4u){pvv[0], pvv[1], pvv[2], pvv[3]}; *(LAS v4u*)(VT + c * 72 + rg * 16 + 8) = (v4u){pvv[4], pvv[5], pvv[6], pvv[7]};
    if (PASS == 1) {
        unsigned pkk[8];
#pragma unroll
        for (int i = 0; i < 16; i += 2) pkk[i >> 1] = pk2(kk[i] * __expf(r - (pre + bl[i])), kk[i + 1] * __expf(r - (pre + bl[i + 1])));
        *(LAS v4u*)(KT + c * 72 + rg * 16) = (v4u){pkk[0], pkk[1], pkk[2], pkk[3]}; *(LAS v4u*)(KT + c * 72 + rg * 16 + 8) = (v4u){pkk[4], pkk[5], pkk[6], pkk[7]};
        if (rg == 0) { WSP(float, WS_ER)[(size_t)p.eidx * 512 + 128 * h + c] = __expf(r); WSP(float, WS_EL)[(size_t)p.eidx * 512 + 128 * h + c] = __expf(blast - r); }
        __syncthreads();
        bf16* UT = UTHP + (size_t)p.ent * UTH_ENT;
        LAS bf16* OUT = (LAS bf16*)(L + 2048);
        const int vt = w >> 1;
#pragma unroll
        for (int q = 0; q < 2; ++q) {
            const int kt = (w & 1) * 2 + q;
            f32x16 acc = ZERO16;
            mma32_ll<64>(acc, VT + vt * 32 * 72, 72, KT + kt * 32 * 72, 72, lane);
#pragma unroll
            for (int reg = 0; reg < 16; ++reg) OUT[(vt * 32 + rowreg(reg, lane)) * 136 + kt * 32 + (lane & 31)] = (bf16)f2bf(acc[reg]);
        }
        __syncthreads();
#pragma unroll
        for (int i = 0; i < 4; ++i) { const int idx = tid + 512 * i, row = idx >> 4, pc = idx & 15; *(GAS v4u*)(UT + (size_t)row * 128 + pc * 8) = *(const LAS v4u*)(OUT + row * 136 + pc * 8); }
        __syncthreads();
    } else {
#pragma unroll
        for (int i = 0; i < 2; ++i) { const int idx = tid + 512 * i; *(LAS v4u*)((LAS bf16*)(L + 2048) + (idx >> 4) * 136 + (idx & 15) * 8) = gbr[i]; }
#pragma unroll
        for (int i = 0; i < 16; ++i) {
            const int t = rg * 16 + i; const float b = pre + bl[i];
            QN[t * 136 + c] = (bf16)f2bf(bf2f(QN[t * 136 + c]) * __expf(b - r));
            KN[t * 136 + c] = (bf16)f2bf(kk[i] * __expf(r - b));
        }
        __syncthreads();
        bf16x8 sfr[8];
        load_frags8(UTHP + (size_t)p.ent * UTH_ENT + (size_t)(w & 3) * 32 * 128, 128, lane, sfr);
        if (w < 4) {
            const int tm = w >> 1, sn = w & 1;
            f32x16 acc = ZERO16;
            if (!(tm == 0 && sn == 1)) mma32_ll<128>(acc, QN + tm * 32 * 136, 136, KN + sn * 32 * 136, 136, lane);
#pragma unroll
            for (int reg = 0; reg < 16; ++reg) { const int t = tm * 32 + rowreg(reg, lane), s = sn * 32 + (lane & 31);
                PP[t * 72 + s] = (s <= t) ? (bf16)f2bf(acc[reg]) : (bf16)0; }
        }
        __syncthreads();
        const int tm = w >> 2, vn = w & 3;
        f32x16 acc = ZERO16;
        mma32_ll<64>(acc, PP + tm * 32 * 72, 72, VT + vn * 32 * 72, 72, lane);
        mma32_lf8(acc, QN + tm * 32 * 136, 136, sfr, lane);
        { float sqv[16]; int rsel;
#pragma unroll
          for (int reg = 0; reg < 16; ++reg) sqv[reg] = acc[reg] * acc[reg];
          const float sq = rowsum16(sqv, lane, rsel); if ((lane & 1) == 0) PART[(tm * 32 + rowreg(rsel, lane)) * 4 + vn] = sq; }
        __syncthreads();
        if (tid < 64) RS[tid] = 1.0f / sqrtf(((PART[tid * 4] + PART[tid * 4 + 1]) + (PART[tid * 4 + 2] + PART[tid * 4 + 3])) * (1.0f / 128.0f) + EPS);
        __syncthreads();
        bf16* QZ = WSP(bf16, WS_QZ);
        LAS bf16* OUT = (LAS bf16*)(L + 2048);
#pragma unroll
        for (int reg = 0; reg < 16; ++reg) { const int t = tm * 32 + rowreg(reg, lane), v = vn * 32 + (lane & 31);
            OUT[t * 136 + v] = (bf16)f2bf(acc[reg] * RS[t] * bf2f(OUT[t * 136 + v])); }
        __syncthreads();
#pragma unroll
        for (int i = 0; i < 2; ++i) { const int idx = tid + 512 * i, row = idx >> 4, pc = idx & 15; *(GAS v4u*)(QZ + (size_t)(rowbase + row) * 1024 + 128 * h + pc * 8) = *(const LAS v4u*)(OUT + row * 136 + pc * 8); }
        __syncthreads();
    }
}

struct MbP { int rowbase, g, nvalid, ent0, estride; const bf16* prev; };
__device__ __forceinline__ bool mb_valid(int o, bool with_meta) { return o < 512 || (with_meta && o >= 516 && o < 518); }
__device__ __forceinline__ MbP mb_params(Frame& F, int j) {
    MbP p; const bf16* XBC = WSP(bf16, WS_XBC);
    if (j < 512) { const int b = j >> 6, g = (j >> 5) & 1, c = j & 31, rb = b * SEQ + c * CH; p.rowbase = rb; p.g = g; p.nvalid = CH; p.ent0 = (b * 8 + 4 * g) * 32 + c; p.estride = 32;
        p.prev = c > 0 ? XBC + (size_t)(rb - 3) * 1024 : XBC + (size_t)(ROW_META + 13) * 1024; }
    else { const int g = j - 516; p.rowbase = ROW_META; p.g = g; p.nvalid = NMETA; p.ent0 = 2048 + 4 * g; p.estride = 1; p.prev = nullptr; }
    return p;
}
struct MbRaw { v4u rx[4]; v4u halo; float dt; };
__device__ __forceinline__ int mb_bccol(int g, int pc) { return pc < 16 ? 512 + 128 * g + pc * 8 : 768 + 128 * g + (pc - 16) * 8; }
template <int PASS> __device__ __forceinline__ void mb_load(Frame& F, const MbP& p, MbRaw& r) {
    const int tid = F.tid; const bf16* X = WSP(bf16, WS_XBC) + (size_t)p.rowbase * 1024;
#pragma unroll
    for (int i = 0; i < 4; ++i) { const int idx = tid + 512 * i, row = idx >> 5, pc = idx & 31;
        r.rx[i] = *(const GAS v4u*)(X + (size_t)row * 1024 + 256 * p.g + pc * 8); }
    r.halo = (v4u){0u, 0u, 0u, 0u};
    if (p.prev && tid < 192) { const int hr = tid >> 6, pc = tid & 63; r.halo = *(const GAS v4u*)(p.prev + (size_t)hr * 1024 + (pc < 32 ? 256 * p.g + pc * 8 : mb_bccol(p.g, pc - 32))); }
    r.dt = 0.f;
    if (tid < 256) { const int t = tid & 63; if (t < p.nvalid) r.dt = WSP(float, WS_DT)[(size_t)(p.rowbase + t) * 8 + 4 * p.g + (tid >> 6)]; }
}
template <int PASS> __device__ __forceinline__ void mamba_item(Frame& F, const MbP p, MbRaw& raw, bool has_next, const MbP pn) {
    LAS unsigned char* L = F.lds;
    LAS float* CUM = (LAS float*)L;
    LAS float* DTV = (LAS float*)(L + 1024);
    LAS bf16* XT = (LAS bf16*)(L + 2048);
    LAS bf16* BT = (LAS bf16*)(L + 38912);
    LAS bf16* BN = (LAS bf16*)(L + 38912);
    LAS bf16* CN = (LAS bf16*)(L + 56320);
    LAS bf16* RAW = (LAS bf16*)(L + 73728);
    const int tid = F.tid, lane = F.lane, w = F.wave, g = p.g, rowbase = p.rowbase;
    if (w < 4) {
        const int head = 4 * g + w;
        const float dt = raw.dt;
        const float A = -__expf(inp(F, 17)[head]);
        float cum = dt * A;
#pragma unroll
        for (int o = 1; o < 64; o <<= 1) { const float n = __shfl_up(cum, o); if (lane >= o) cum += n; }
        const float last = __builtin_bit_cast(float, __builtin_amdgcn_readlane(__builtin_bit_cast(int, cum), 63));
        if (PASS == 1) { CUM[w * 64 + lane] = dt * __expf(last - cum); if (lane == 0) WSP(float, WS_DCY)[p.ent0 + w * p.estride] = __expf(last); }
        else { CUM[w * 64 + lane] = cum; DTV[w * 64 + lane] = dt; }
    }
#pragma unroll
    for (int i = 0; i < 4; ++i) { const int idx = tid + 512 * i; *(LAS v4u*)(RAW + ((idx >> 5) + 3) * 256 + (idx & 31) * 8) = raw.rx[i]; }
    if (tid < 192 && (tid & 63) < 32) *(LAS v4u*)(RAW + (tid >> 6) * 256 + (tid & 63) * 8) = raw.halo;
    __syncthreads();
    v4u rbc[4];
    {   const bf16* X = WSP(bf16, WS_XBC) + (size_t)rowbase * 1024;
#pragma unroll
        for (int i = 0; i < 4; ++i) { const int idx = tid + 512 * i, row = idx >> 5, pc = idx & 31;
            rbc[i] = (PASS == 3 || pc < 16) ? *(const GAS v4u*)(X + (size_t)row * 1024 + mb_bccol(g, pc)) : (v4u){0u, 0u, 0u, 0u}; } }
    const int ch = tid & 255, half = tid >> 8;
    const float* cw = inp(F, 14); const float* cbp = inp(F, 15);
    {
        const int col = 256 * g + ch;
        const float w0 = cw[col], w1 = cw[1024 + col], w2 = cw[2048 + col], w3 = cw[3072 + col], cb = cbp[col];
        float r0 = bf2f(RAW[(half * 32 + 0) * 256 + ch]), r1 = bf2f(RAW[(half * 32 + 1) * 256 + ch]), r2 = bf2f(RAW[(half * 32 + 2) * 256 + ch]);
        unsigned pk[16];
#pragma unroll
        for (int i = 0; i < 32; i += 2) {
            const int t = half * 32 + i;
            const float r3 = bf2f(RAW[(t + 3) * 256 + ch]), r4 = bf2f(RAW[(t + 4) * 256 + ch]);
            float a0 = silu(cb + w0 * r0 + w1 * r1 + w2 * r2 + w3 * r3), a1 = silu(cb + w0 * r1 + w1 * r2 + w2 * r3 + w3 * r4);
            if (PASS == 1) { a0 *= CUM[(ch >> 6) * 64 + t]; a1 *= CUM[(ch >> 6) * 64 + t + 1]; }
            pk[i >> 1] = pk2(a0, a1); r0 = r2; r1 = r3; r2 = r4;
        }
        LAS v4u* d = (LAS v4u*)(XT + ch * 72 + half * 32);
        d[0] = (v4u){pk[0], pk[1], pk[2], pk[3]}; d[1] = (v4u){pk[4], pk[5], pk[6], pk[7]}; d[2] = (v4u){pk[8], pk[9], pk[10], pk[11]}; d[3] = (v4u){pk[12], pk[13], pk[14], pk[15]};
    }
    __syncthreads();
#pragma unroll
    for (int i = 0; i < 4; ++i) { const int idx = tid + 512 * i; *(LAS v4u*)(RAW + ((idx >> 5) + 3) * 256 + (idx & 31) * 8) = rbc[i]; }
    if (tid < 192 && (tid & 63) >= 32) *(LAS v4u*)(RAW + (tid >> 6) * 256 + ((tid & 63) - 32) * 8) = raw.halo;
    if (has_next) mb_load<PASS>(F, pn, raw);
    __syncthreads();
    if (PASS == 3 || ch < 128) {
        const int col = ch < 128 ? 512 + 128 * g + ch : 768 + 128 * g + (ch - 128);
        const float w0 = cw[col], w1 = cw[1024 + col], w2 = cw[2048 + col], w3 = cw[3072 + col], cb = cbp[col];
        float r0 = bf2f(RAW[(half * 32 + 0) * 256 + ch]), r1 = bf2f(RAW[(half * 32 + 1) * 256 + ch]), r2 = bf2f(RAW[(half * 32 + 2) * 256 + ch]);
        unsigned pk[16];
#pragma unroll
        for (int i = 0; i < 32; i += 2) {
            const int t = half * 32 + i;
            const float r3 = bf2f(RAW[(t + 3) * 256 + ch]), r4 = bf2f(RAW[(t + 4) * 256 + ch]);
            const float a0 = silu(cb + w0 * r0 + w1 * r1 + w2 * r2 + w3 * r3), a1 = silu(cb + w0 * r1 + w1 * r2 + w2 * r3 + w3 * r4);
            if (PASS == 1) pk[i >> 1] = pk2(a0, a1);
            else { LAS bf16* dst = ch < 128 ? BN + ch : CN + (ch - 128); dst[t * 136] = (bf16)f2bf(a0); dst[(t + 1) * 136] = (bf16)f2bf(a1); }
            r0 = r2; r1 = r3; r2 = r4;
        }
        if (PASS == 1) { LAS v4u* d = (LAS v4u*)(BT + ch * 72 + half * 32);
            d[0] = (v4u){pk[0], pk[1], pk[2], pk[3]}; d[1] = (v4u){pk[4], pk[5], pk[6], pk[7]}; d[2] = (v4u){pk[8], pk[9], pk[10], pk[11]}; d[3] = (v4u){pk[12], pk[13], pk[14], pk[15]}; }
    }
    __syncthreads();
    bf16* UM = WSP(bf16, WS_UM);
    if (PASS == 1) {
        LAS bf16* OUT = (LAS bf16*)(L + 73728);
#pragma unroll
        for (int r = 0; r < 2; ++r) {
            const int hl = w >> 2, hd = 2 * r + hl, pt = (w >> 1) & 1;
#pragma unroll
            for (int q = 0; q < 2; ++q) {
                const int nt = (w & 1) * 2 + q;
                f32x16 acc = ZERO16;
                mma32_ll<64>(acc, XT + (hd * 64 + pt * 32) * 72, 72, BT + nt * 32 * 72, 72, lane);
#pragma unroll
                for (int reg = 0; reg < 16; ++reg) OUT[(hl * 64 + pt * 32 + rowreg(reg, lane)) * 136 + nt * 32 + (lane & 31)] = (bf16)f2bf(acc[reg]);
            }
            __syncthreads();
#pragma unroll
            for (int i = 0; i < 4; ++i) { const int idx = tid + 512 * i, hh = idx >> 10, row = (idx >> 4) & 63, pc = idx & 15;
                *(GAS v4u*)(UM + (size_t)(p.ent0 + (2 * r + hh) * p.estride) * UM_ENT + (size_t)row * 128 + pc * 8) = *(const LAS v4u*)(OUT + (hh * 64 + row) * 136 + pc * 8); }
            __syncthreads();
        }
    } else {
        LAS float* CB = (LAS float*)(L + 73728);
        LAS bf16* WW = (LAS bf16*)(L + 90624);
        LAS float* PART = (LAS float*)(L + 127488);
        LAS float* RS = (LAS float*)(L + 129536);
        bf16x8 hfr[8];
        load_frags8(UM + (size_t)(p.ent0 + (w >> 1) * p.estride) * UM_ENT + (size_t)(w & 1) * 32 * 128, 128, lane, hfr);
        v4u zr[4];
        { const bf16* Zg = WSP(bf16, WS_QZ) + (size_t)rowbase * 1024 + 512 + 256 * g;
#pragma unroll
          for (int i = 0; i < 4; ++i) { const int idx = tid + 512 * i; zr[i] = *(const GAS v4u*)(Zg + (size_t)(idx >> 5) * 1024 + (idx & 31) * 8); } }
        if (w < 4) {
            const int tm = w >> 1, sn = w & 1;
            if (!(tm == 0 && sn == 1)) {
                f32x16 acc = ZERO16;
                mma32_ll<128>(acc, CN + tm * 32 * 136, 136, BN + sn * 32 * 136, 136, lane);
#pragma unroll
                for (int reg = 0; reg < 16; ++reg) CB[(tm * 32 + rowreg(reg, lane)) * 66 + sn * 32 + (lane & 31)] = acc[reg];
            }
        }
        __syncthreads();
        {
            const int hd = tid >> 7, rem = tid & 127, t = rem >> 1, s0 = (rem & 1) * 32;
            const float ct = CUM[hd * 64 + t];
            unsigned pw[16];
#pragma unroll
            for (int j = 0; j < 32; j += 2) {
                const int s = s0 + j;
                const float a = (s <= t) ? CB[t * 66 + s] * __expf(ct - CUM[hd * 64 + s]) * DTV[hd * 64 + s] : 0.f;
                const float b = (s + 1 <= t) ? CB[t * 66 + s + 1] * __expf(ct - CUM[hd * 64 + s + 1]) * DTV[hd * 64 + s + 1] : 0.f;
                pw[j >> 1] = pk2(a, b);
            }
            __syncthreads();
#pragma unroll
            for (int i = 0; i < 4; ++i) { const int idx = tid + 512 * i, zt = idx >> 5, pc = idx & 31;
                *(LAS v4u*)((zt < 32 ? (LAS bf16*)(L + 38912) + zt * 264 : (LAS bf16*)(L + 73728) + (zt - 32) * 264) + pc * 8) = zr[i]; }
            LAS v4u* d = (LAS v4u*)(WW + (hd * 64 + t) * 72 + s0);
            d[0] = (v4u){pw[0], pw[1], pw[2], pw[3]}; d[1] = (v4u){pw[4], pw[5], pw[6], pw[7]}; d[2] = (v4u){pw[8], pw[9], pw[10], pw[11]}; d[3] = (v4u){pw[12], pw[13], pw[14], pw[15]};
        }
        __syncthreads();
        const int hd = w >> 1, pnn = w & 1, head = 4 * g + hd;
        const float Dk = inp(F, 18)[head];
        bf16* QZ = WSP(bf16, WS_QZ);
        const int chn = hd * 64 + pnn * 32 + (lane & 31);
        unsigned yzp[2][8];
#pragma unroll
        for (int tm = 0; tm < 2; ++tm) {
            const LAS bf16* ZL = tm == 0 ? (const LAS bf16*)(L + 38912) : (const LAS bf16*)(L + 73728);
            float sqv[16];
            f32x16 acc = ZERO16;
            mma32_lf8(acc, CN + tm * 32 * 136, 136, hfr, lane);
#pragma unroll
            for (int reg = 0; reg < 16; ++reg) acc[reg] *= __expf(CUM[hd * 64 + tm * 32 + rowreg(reg, lane)]);
            mma32_ll<64>(acc, WW + (hd * 64 + tm * 32) * 72, 72, XT + (hd * 64 + pnn * 32) * 72, 72, lane);
#pragma unroll
            for (int reg = 0; reg < 16; ++reg) {
                const int t = tm * 32 + rowreg(reg, lane);
                const float y = acc[reg] + Dk * bf2f(XT[chn * 72 + t]);
                const float v = y * bf2f(ZL[rowreg(reg, lane) * 264 + chn]);
                if (reg & 1) yzp[tm][reg >> 1] |= f2bf(v) << 16; else yzp[tm][reg >> 1] = f2bf(v);
                sqv[reg] = v * v;
            }
            { int rsel; const float sq = rowsum16(sqv, lane, rsel); if ((lane & 1) == 0) PART[(tm * 32 + rowreg(rsel, lane)) * 8 + w] = sq; }
            asm volatile("" ::: "memory");
        }
        __syncthreads();
        if (tid < 64) { float s = 0.f;
#pragma unroll
            for (int j = 0; j < 8; ++j) s += PART[tid * 8 + j];
            RS[tid] = 1.0f / sqrtf(s * (1.0f / 256.0f) + EPS); }
        __syncthreads();
        const float nw = inp(F, 19)[256 * g + chn];
        LAS bf16* OUT = (LAS bf16*)(L + 2048);
#pragma unroll
        for (int tm = 0; tm < 2; ++tm)
#pragma unroll
            for (int reg = 0; reg < 16; ++reg) { const int t = tm * 32 + rowreg(reg, lane);
                const float v = bf2f((unsigned short)((reg & 1) ? (yzp[tm][reg >> 1] >> 16) : (yzp[tm][reg >> 1] & 0xffffu)));
                OUT[t * 264 + chn] = (bf16)f2bf(v * RS[t] * nw); }
        __syncthreads();
#pragma unroll
        for (int i = 0; i < 4; ++i) { const int idx = tid + 512 * i, row = idx >> 5, pc = idx & 31; *(GAS v4u*)(QZ + (size_t)(rowbase + row) * 1024 + 512 + 256 * g + pc * 8) = *(const LAS v4u*)(OUT + row * 264 + pc * 8); }
        __syncthreads();
    }
}
__device__ __forceinline__ void unpack8(const v4u u, float (&f)[8]) {
    f[0] = bf2f((unsigned short)(u.x & 0xffffu)); f[1] = bf2f((unsigned short)(u.x >> 16)); f[2] = bf2f((unsigned short)(u.y & 0xffffu)); f[3] = bf2f((unsigned short)(u.y >> 16));
    f[4] = bf2f((unsigned short)(u.z & 0xffffu)); f[5] = bf2f((unsigned short)(u.z >> 16)); f[6] = bf2f((unsigned short)(u.w & 0xffffu)); f[7] = bf2f((unsigned short)(u.w >> 16));
}
__device__ __forceinline__ void p4b_scan(Frame& F) {
    const int gt = F.vcu * (NWAVES * 64) + F.tid, NT = F.G * NWAVES * 64;
    const float* ER = WSP(float, WS_ER); const float* EL = WSP(float, WS_EL); const float* DCY = WSP(float, WS_DCY);
    for (int idx = gt; idx < 131072; idx += NT) {
        float S[8];
#pragma unroll
        for (int j = 0; j < 8; ++j) S[j] = 0.f;
        if (idx < 65536) {
            const int bh = idx >> 11, rem = idx & 2047, v = rem >> 4, kd8 = (rem & 15) * 8, b = bh >> 2, h = bh & 3;
            bf16* UTH = UTHP + (size_t)v * 128 + kd8;
            {
                float uu[8]; unpack8(*(const GAS v4u*)(UTH + (size_t)(1024 + h) * UTH_ENT), uu);
                const float* el = EL + (size_t)256 * 512 + 128 * h + kd8;
#pragma unroll
                for (int j = 0; j < 8; ++j) S[j] = el[j] * uu[j];
            }
            for (int c0 = 0; c0 < NCH; c0 += 4) {
                v4u u[4]; f32x4 er[4][2], el[4][2];
#pragma unroll
                for (int q = 0; q < 4; ++q) { const size_t e = (size_t)(b * 32 + c0 + q);
                    u[q] = *(const GAS v4u*)(UTH + (size_t)(bh * 32 + c0 + q) * UTH_ENT);
                    er[q][0] = *(const GAS f32x4*)(ER + e * 512 + 128 * h + kd8); er[q][1] = *(const GAS f32x4*)(ER + e * 512 + 128 * h + kd8 + 4);
                    el[q][0] = *(const GAS f32x4*)(EL + e * 512 + 128 * h + kd8); el[q][1] = *(const GAS f32x4*)(EL + e * 512 + 128 * h + kd8 + 4); }
#pragma unroll
                for (int q = 0; q < 4; ++q) { float uu[8], sp[8]; unpack8(u[q], uu);
#pragma unroll
                    for (int j = 0; j < 8; ++j) { sp[j] = er[q][j >> 2][j & 3] * S[j]; S[j] = el[q][j >> 2][j & 3] * (sp[j] + uu[j]); }
                    *(GAS v4u*)(UTH + (size_t)(bh * 32 + c0 + q) * UTH_ENT) = (v4u){pk2(sp[0], sp[1]), pk2(sp[2], sp[3]), pk2(sp[4], sp[5]), pk2(sp[6], sp[7])}; }
            }
            float* o = OUTP(O_HGP) + ((size_t)bh * 128 + kd8) * 128 + v;
#pragma unroll
            for (int j = 0; j < 8; ++j) o[(size_t)j * 128] = S[j];
        } else {
            const int i2 = idx - 65536, bhd = i2 >> 10, rem = i2 & 1023, p_ = rem >> 4, n8 = (rem & 15) * 8, head = bhd & 7;
            bf16* UM = WSP(bf16, WS_UM) + (size_t)p_ * 128 + n8;
            {   float uu[8]; unpack8(*(const GAS v4u*)(UM + (size_t)(2048 + head) * UM_ENT), uu);
#pragma unroll
                for (int j = 0; j < 8; ++j) S[j] = uu[j]; }
            for (int c0 = 0; c0 < NCH; c0 += 4) {
                v4u u[4]; float d[4];
#pragma unroll
                for (int q = 0; q < 4; ++q) { u[q] = *(const GAS v4u*)(UM + (size_t)(bhd * 32 + c0 + q) * UM_ENT); d[q] = DCY[bhd * 32 + c0 + q]; }
#pragma unroll
                for (int q = 0; q < 4; ++q) { float uu[8], sp[8]; unpack8(u[q], uu);
#pragma unroll
                    for (int j = 0; j < 8; ++j) { sp[j] = S[j]; S[j] = d[q] * S[j] + uu[j]; }
                    *(GAS v4u*)(UM + (size_t)(bhd * 32 + c0 + q) * UM_ENT) = (v4u){pk2(sp[0], sp[1]), pk2(sp[2], sp[3]), pk2(sp[4], sp[5]), pk2(sp[6], sp[7])}; }
            }
            float* o = OUTP(O_SSP) + ((size_t)bhd * 64 + p_) * 128 + n8;
            *(GAS f32x4*)o = (f32x4){S[0], S[1], S[2], S[3]}; *(GAS f32x4*)(o + 4) = (f32x4){S[4], S[5], S[6], S[7]};
        }
    }
}
__device__ __forceinline__ void hgrn_decode(Frame& F, int smp, int h) {
    LAS float* OS = (LAS float*)F.lds;
    LAS float* RED = (LAS float*)(F.lds + 8192);
    const int tid = F.tid, row = ROW_SMP + smp, v4 = (tid & 31) * 4, kg = tid >> 5;
    const float* FZ = WSP(float, WS_FZ); const bf16* VB = WSP(bf16, WS_VB); bf16* QZ = WSP(bf16, WS_QZ); const float* LB = WSP(float, WS_LB);
    const float* Sin = inp(F, 2) + (size_t)(smp * 4 + h) * 16384; float* Sout = OUTP(O_HGS) + (size_t)(smp * 4 + h) * 16384;
    f32x4 vv; { const unsigned long long raw = *(const GAS unsigned long long*)(VB + (size_t)row * 512 + 128 * h + v4);
        vv = (f32x4){bf2f((unsigned short)raw), bf2f((unsigned short)(raw >> 16)), bf2f((unsigned short)(raw >> 32)), bf2f((unsigned short)(raw >> 48))}; }
    f32x4 o = (f32x4){0.f, 0.f, 0.f, 0.f};
    f32x4 st[8]; float fzv[8], lbv[8], qv[8];
#pragma unroll
    for (int j = 0; j < 8; ++j) { const int kd = kg * 8 + j;
        st[j] = *(const GAS f32x4*)(Sin + (size_t)kd * 128 + v4);
        fzv[j] = FZ[(size_t)row * 512 + 128 * h + kd]; lbv[j] = LB[128 * h + kd]; qv[j] = bf2f(QZ[(size_t)row * 1024 + 128 * h + kd]); }
#pragma unroll
    for (int j = 0; j < 8; ++j) {
        const int kd = kg * 8 + j;
        const float sg = sigm(fzv[j]), f = lbv[j] + (1.0f - lbv[j]) * sg, k = (1.0f - lbv[j]) * (1.0f - sg);
        const f32x4 sn = st[j] * f + vv * k;
        *(GAS f32x4*)(Sout + (size_t)kd * 128 + v4) = sn;
        o = o + sn * qv[j];
    }
    *(LAS f32x4*)(OS + kg * 128 + v4) = o;
    __syncthreads();
    float ov = 0.f;
    if (tid < 128) {
#pragma unroll
        for (int j = 0; j < 16; ++j) ov += OS[j * 128 + tid];
        const float sq = wave_sum(ov * ov); if (F.lane == 0) RED[F.wave] = sq;
    }
    __syncthreads();
    if (tid < 128) {
        const float rs = 1.0f / sqrtf((RED[0] + RED[1]) * (1.0f / 128.0f) + EPS);
        const float g = bf2f(WSP(bf16, WS_GB)[(size_t)row * 512 + 128 * h + tid]);
        QZ[(size_t)row * 1024 + 128 * h + tid] = (bf16)f2bf(ov * rs * g);
    }
    __syncthreads();
}
__device__ __forceinline__ void mamba_decode(Frame& F, int smp, int g) {
    LAS float* XS = (LAS float*)F.lds;
    LAS float* YS = (LAS float*)(F.lds + 2048);
    LAS float* RED = (LAS float*)(F.lds + 3072);
    const int tid = F.tid, row = ROW_SMP + smp;
    const bf16* XBC = WSP(bf16, WS_XBC); bf16* QZ = WSP(bf16, WS_QZ);
    {
        const int ch = tid, col = ch < 256 ? 256 * g + ch : ch < 384 ? 512 + 128 * g + (ch - 256) : 768 + 128 * g + (ch - 384);
        const float* cw = inp(F, 14); const float* sc = inp(F, 4) + (size_t)smp * 3 * 1024;
        const float s0 = sc[col], s1 = sc[1024 + col], s2 = sc[2048 + col], cur = bf2f(XBC[(size_t)row * 1024 + col]);
        XS[ch] = silu(inp(F, 15)[col] + cw[col] * s0 + cw[1024 + col] * s1 + cw[2048 + col] * s2 + cw[3072 + col] * cur);
        float* cs = OUTP(O_CVS) + (size_t)smp * 3 * 1024; cs[col] = s1; cs[1024 + col] = s2;
    }
    __syncthreads();
    {
        const int hd = tid >> 7, r = tid & 127, n4 = (r & 31) * 4, pg = r >> 5, head = 4 * g + hd;
        const float dt = WSP(float, WS_DT)[(size_t)row * 8 + head], dA = __expf(-dt * __expf(inp(F, 17)[head])), Dk = inp(F, 18)[head];
        const f32x4 Bv = *(const LAS f32x4*)(XS + 256 + n4), Cv = *(const LAS f32x4*)(XS + 384 + n4);
        const float* Sin = inp(F, 3) + (size_t)(smp * 8 + head) * 8192; float* Sout = OUTP(O_SSS) + (size_t)(smp * 8 + head) * 8192;
        float yv[16]; f32x4 st[16];
#pragma unroll
        for (int j = 0; j < 16; ++j) st[j] = *(const GAS f32x4*)(Sin + (size_t)(pg * 16 + j) * 128 + n4);
#pragma unroll
        for (int j = 0; j < 16; ++j) {
            const int p = pg * 16 + j; const float x = XS[hd * 64 + p];
            const f32x4 sn = st[j] * dA + Bv * (dt * x);
            *(GAS f32x4*)(Sout + (size_t)p * 128 + n4) = sn;
            yv[j] = (sn[0] * Cv[0] + sn[1] * Cv[1]) + (sn[2] * Cv[2] + sn[3] * Cv[3]);
        }
        { int rsel; const float y = rowsum16(yv, F.lane, rsel); if ((r & 1) == 0) { const int p = pg * 16 + rsel; YS[hd * 64 + p] = y + Dk * XS[hd * 64 + p]; } }
    }
    __syncthreads();
    float yz = 0.f;
    if (tid < 256) {
        yz = YS[tid] * bf2f(QZ[(size_t)row * 1024 + 512 + 256 * g + tid]);
        const float sq = wave_sum(yz * yz); if (F.lane == 0) RED[F.wave] = sq;
    }
    __syncthreads();
    if (tid < 256) {
        const float rs = 1.0f / sqrtf(((RED[0] + RED[1]) + (RED[2] + RED[3])) * (1.0f / 256.0f) + EPS);
        QZ[(size_t)row * 1024 + 512 + 256 * g + tid] = (bf16)f2bf(yz * rs * inp(F, 19)[256 * g + tid]);
    }
    __syncthreads();
}
__device__ __forceinline__ void p4a(Frame& F, bool decode) {
    if (decode) {
        for (int j = F.vcu; j < 512; j += F.G) hgrn_decode(F, j >> 2, j & 3);
        for (int j = F.vcu; j < 256; j += F.G) mamba_decode(F, j >> 1, j & 1);
    }
    {   HgRaw raw; int i = F.vcu; if (i < 1028) { const HgP p0 = hg_params(i); hg_load<1>(F, p0, raw); }
        for (; i < 1028; i += F.G) { const int in = i + F.G; hgrn_item<1>(F, hg_params(i), raw, in < 1028, hg_params(in < 1028 ? in : i)); } }
    {   MbRaw raw; int j = F.vcu; if (mb_valid(j, true)) { const MbP p0 = mb_params(F, j); mb_load<1>(F, p0, raw); }
        for (; mb_valid(j, true); j += F.G) { const int jn = j + F.G; const bool hn = mb_valid(jn, true); mamba_item<1>(F, mb_params(F, j), raw, hn, mb_params(F, hn ? jn : j)); } }
}
__device__ __forceinline__ void p4c(Frame& F) {
    {   HgRaw raw; int i = F.vcu; if (i < 1024) { const HgP p0 = hg_params(i); hg_load<3>(F, p0, raw); }
        for (; i < 1024; i += F.G) { const int in = i + F.G; hgrn_item<3>(F, hg_params(i), raw, in < 1024, hg_params(in < 1024 ? in : i)); } }
    {   MbRaw raw; int j = F.vcu; if (j < 512) { const MbP p0 = mb_params(F, j); mb_load<3>(F, p0, raw); }
        for (; j < 512; j += F.G) { const int jn = j + F.G; mamba_item<3>(F, mb_params(F, j), raw, jn < 512, mb_params(F, jn < 512 ? jn : j)); } }
}
#ifndef MK_PER_PHASE
#define MK_PER_PHASE 0
#endif
#ifndef GP_ALIGN
#define GP_ALIGN true
#endif
#ifndef GP_SP2
#define GP_SP2 true
#endif
#ifndef GP_SP2_FINAL
#define GP_SP2_FINAL false
#endif
#ifndef WGM_GU
#define WGM_GU 4
#endif
#ifndef WGM_IN
#define WGM_IN 4
#endif
#ifndef WGM_DN
#define WGM_DN 4
#endif
constexpr int N_PHASES = 13;
struct Args { const float* in[26]; float* out; unsigned char* ws; int ph_lo, ph_hi; };
static_assert(sizeof(Args) == 26 * 8 + 8 + 8 + 8, "Args has no padding");
template <bool SPLIT> __global__ void __launch_bounds__(NWAVES * 64, 2) hymba_fwd(Args args) {
    extern __shared__ __attribute__((aligned(16))) unsigned char lds[];
    Frame F;
    F.lds = (LAS unsigned char*)lds;
    F.MISC = (volatile LAS unsigned*)(F.lds + MISC_OFF);
    F.tid = threadIdx.x; F.lane = F.tid & 63; F.wave = __builtin_amdgcn_readfirstlane(F.tid >> 6);
    F.G = gridDim.x; { const int bx = blockIdx.x; F.vcu = (F.G % 8 == 0) ? (bx % 8) * (F.G / 8) + bx / 8 : bx; }
    F.ws = (GAS unsigned char*)args.ws; F.out = (GAS float*)args.out; F.ctl = (gu32*)(args.ws + WS_CTL);
    for (int u = F.tid; u < (LDS_BYTES - LDSCTL_OFF) / 4; u += NWAVES * 64) ((LAS unsigned*)(F.lds + LDSCTL_OFF))[u] = 0u;
    __syncthreads();
    if (F.tid < 26) ((LAS unsigned long long*)(F.lds + TAB_OFF))[F.tid] = (unsigned long long)args.in[F.tid];
    __syncthreads();
    XcdBarrier bar; bar.bar = (unsigned*)(F.ctl + CW_BAR); bar.x = 0; bar.st = nullptr;
    if (!MK_PER_PHASE) bar = xcd_barrier_post((unsigned*)(F.ctl + CW_BAR), F.MISC + 8);
    const int lo = args.ph_lo, hi = args.ph_hi;
#ifndef PH_MASK
#define PH_MASK 0x1fff
#endif
#define IN(k) (((PH_MASK >> (k)) & 1) && lo <= (k) && (k) < hi)
#ifndef PH_REPEAT
#define PH_REPEAT 0
#endif
#define SEAM(k) do { if (IN(k) && IN((k) + 1)) xcd_barrier(bar); } while (0)
#define PHASE_LOCAL() asm volatile("" : "+s"(F.ws), "+s"(F.out), "+v"(F.tid), "+v"(F.lane), "+s"(F.wave), "+s"(F.vcu), "+s"(F.G))
#define REP(k) for (int rep_ = 0; rep_ < 1 + ((PH_REPEAT >> (k)) & 1); ++rep_)
#define HB WSP(bf16, WS_HB)
#define HH WSP(bf16, WS_H)
#define QZ WSP(bf16, WS_QZ)
#define SS1 WSP(float, WS_SS1)
#define SS2 WSP(float, WS_SS2)
#define SS3 WSP(float, WS_SS3)
#define SS4 WSP(float, WS_SS4)
#define RS2 (WSP(float, WS_SS1) + 32768)
#define RS3 (WSP(float, WS_SS1) + 65536)
#define YP (OUTP(O_YP))
#define HX0 WSP(float, WS_HX0)
#define HX WSP(float, WS_HX)

    constexpr int split = SPLIT ? 1 : 0;
#define SLABS WSP(float, WS_XBC)
    if (IN(0)) REP(0) { if (rep_ == 1) xcd_barrier(bar); PHASE_LOCAL(); p0_prologue(F, split); } SEAM(0);
    if (IN(1)) REP(1) { if (rep_ == 1) xcd_barrier(bar); PHASE_LOCAL();
        pg8::Gemm g{HB, WSP(bf16, WS_WGU1), M, 2 * FF, D, D}; pg8::MixOrder S; S.init(65, 2 * FF, D, F.G, (int)blockIdx.x, 0, WGM_GU);
        pg8::EpiSwiglu E{HH, SS1, LDH, FF / 64};
        pg8::gemm_phase<pg8::EpiSwiglu, pg8::MixOrder, GP_ALIGN, GP_SP2>(F.lds, g, S, E, nullptr);
        if (split && rep_ == 0) {
            const int idle0 = 1430 - 5 * 256;
            if ((int)blockIdx.x >= idle0) { __syncthreads(); p0_weight_items(F, P0_ITEMS_FIRST, P0_NITEMS, ((int)blockIdx.x - idle0) * NWAVES + F.wave, (256 - idle0) * NWAVES); }
        }
    } SEAM(1);
    if (IN(2)) REP(2) { if (rep_ == 1) xcd_barrier(bar); PHASE_LOCAL();
        pg8::Gemm g{HH, WSP(bf16, WS_WD1), M, D, FF, LDH}; pg8::MixOrder S; S.init(split ? 64 : 65, D, FF, F.G, (int)blockIdx.x, split, WGM_DN);
        pg8::EpiResid E{HB, nullptr, HX0, HX, HB, SS2, 0.5f, nullptr};
        pg8::gemm_phase<pg8::EpiResid, pg8::MixOrder, GP_ALIGN, GP_SP2>(F.lds, g, S, E, SLABS);
    } SEAM(2);
    if (IN(3)) REP(3) { if (rep_ == 1) xcd_barrier(bar); PHASE_LOCAL(); fix_extra<FF / 128>(F, split, SLABS, HX0, HX, HB, SS2, RS2, 0.5f); } SEAM(3);
    if (IN(4)) REP(4) { if (rep_ == 1) xcd_barrier(bar); PHASE_LOCAL();
        pg8::Gemm g{HB, WSP(bf16, WS_WIN), M, NINP, D, D}; pg8::MixOrder S; S.init(65, NINP, D, F.G, (int)blockIdx.x, 0, WGM_IN);
        pg8::EpiInproj E{RS2, QZ, WSP(float, WS_FZ), WSP(bf16, WS_VB), WSP(bf16, WS_GB), WSP(bf16, WS_XBC), WSP(float, WS_DT), inp(F, 13), inp(F, 16), OUTP(O_CVP), OUTP(O_CVS)};
        pg8::gemm_phase<pg8::EpiInproj, pg8::MixOrder, GP_ALIGN, GP_SP2>(F.lds, g, S, E, nullptr);
    } SEAM(4);
    if (IN(5)) REP(5) { if (rep_ == 1) xcd_barrier(bar); PHASE_LOCAL(); p4a(F, rep_ == 0); } SEAM(5);
    if (IN(6)) REP(6) { if (rep_ == 1) xcd_barrier(bar); PHASE_LOCAL(); p4b_scan(F); } SEAM(6);
    if (IN(7)) REP(7) { if (rep_ == 1) xcd_barrier(bar); PHASE_LOCAL(); p4c(F); } SEAM(7);
    if (IN(8)) REP(8) { if (rep_ == 1) xcd_barrier(bar); PHASE_LOCAL();
        pg8::Gemm g{QZ, WSP(bf16, WS_WOUT), M, D, D, D}; pg8::MixOrder S; S.init(split ? 64 : 65, D, D, F.G, (int)blockIdx.x, split, WGM_DN);
        pg8::EpiResid E{HB, nullptr, HX, HX, HB, SS3, 1.0f, nullptr};
        pg8::gemm_phase<pg8::EpiResid, pg8::MixOrder, GP_ALIGN, GP_SP2>(F.lds, g, S, E, SLABS);
    } SEAM(8);
    if (IN(9)) REP(9) { if (rep_ == 1) xcd_barrier(bar); PHASE_LOCAL(); fix_extra<D / 128>(F, split, SLABS, HX, HX, HB, SS3, RS3, 1.0f);
        if (split) { GAS v4u* z = (GAS v4u*)(F.ws + WS_UM); for (int i = F.vcu * (NWAVES * 64) + F.tid; i < 131072; i += F.G * NWAVES * 64) z[i] = (v4u){0u, 0u, 0u, 0u}; } }
    if (IN(10)) REP(10) { if (rep_ == 1) xcd_barrier(bar); PHASE_LOCAL();
        pg8::Gemm g{HB, WSP(bf16, WS_WGU2), M, 2 * FF, D, D}; pg8::MixOrder S; S.init(65, 2 * FF, D, F.G, (int)blockIdx.x, 0, WGM_GU);
        pg8::EpiSwiglu E{HH, RS3, LDH, FF / 64};
        pg8::gemm_phase<pg8::EpiSwiglu, pg8::MixOrder, GP_ALIGN, GP_SP2>(F.lds, g, S, E, nullptr);
    } SEAM(10);
    if (IN(11)) REP(11) { if (rep_ == 1) xcd_barrier(bar); PHASE_LOCAL();
        pg8::Gemm g{HH, WSP(bf16, WS_WD2), M, D, FF, LDH}; pg8::MixOrder S; S.init(split ? 64 : 65, D, FF, F.G, (int)blockIdx.x, split, WGM_DN);
        if constexpr (SPLIT) {
            pg8::EpiResid E{HB, nullptr, HX, HX, HB, SS4, 0.5f, (unsigned long long*)(F.ws + WS_UM)};
            pg8::gemm_phase<pg8::EpiResid, pg8::MixOrder, GP_ALIGN, GP_SP2>(F.lds, g, S, E, SLABS);
            pg8::Unit u; S.next(0, u);
            VM_WAIT(); __syncthreads();
            unsigned long long* gp = (unsigned long long*)(F.ws + WS_UM) + (size_t)u.pm * 256 * 16;
            const bf16* hb = HB + (size_t)u.pm * 256 * 1024 + u.pn * 256 + 4 * F.lane;
            float* yb = YP + (size_t)u.pm * 256 * 1024 + u.pn * 256 + 4 * F.lane;
            const f32x4 w = *(const GAS f32x4*)(inp(F, 25) + u.pn * 256 + 4 * F.lane);
            float tot[8];
            { unsigned long long x[8]; unsigned spins = 0;
              for (;;) { bool ok = true;
#pragma unroll
                  for (int j = 0; j < 8; ++j) { x[j] = __hip_atomic_load(gp + (size_t)F.wave * 512 + F.lane + 64 * j, __ATOMIC_RELAXED, __HIP_MEMORY_SCOPE_AGENT); ok = ok && ((unsigned)(x[j] >> 32) == 1u); }
                  if (__all(ok) || ++spins > (1u << 18)) break; __builtin_amdgcn_s_sleep(4); }
#pragma unroll
              for (int j = 0; j < 8; ++j) { float v = __builtin_bit_cast(float, (unsigned)x[j]); v += __shfl_xor(v, 1); v += __shfl_xor(v, 2); v += __shfl_xor(v, 4); v += __shfl_xor(v, 8); tot[j] = v; } }
            unsigned long long o[32];
#pragma unroll
            for (int i = 0; i < 32; ++i) o[i] = *(const GAS unsigned long long*)(hb + (size_t)(F.wave * 32 + i) * 1024);
#pragma unroll
            for (int r = 0; r < 32; ++r) { const float rs = __builtin_amdgcn_rsqf(__builtin_bit_cast(float, __builtin_amdgcn_readlane(__builtin_bit_cast(int, tot[r >> 2]), (r & 3) * 16)) * (1.0f / 1024.0f) + EPS);
                const unsigned lo = (unsigned)o[r], hi = (unsigned)(o[r] >> 32);
                const f32x4 v = (f32x4){__builtin_bit_cast(float, lo << 16), __builtin_bit_cast(float, lo & 0xffff0000u), __builtin_bit_cast(float, hi << 16), __builtin_bit_cast(float, hi & 0xffff0000u)};
                *(GAS f32x4*)(yb + (size_t)(F.wave * 32 + r) * 1024) = v * rs * w; }
        } else {
            pg8::EpiResid E{HB, YP, HX, HX, nullptr, SS4, 0.5f, nullptr};
            pg8::gemm_phase<pg8::EpiResid, pg8::MixOrder, GP_ALIGN, GP_SP2>(F.lds, g, S, E, SLABS);
        }
    } SEAM(11);
    if (IN(12)) REP(12) { if (rep_ == 1) xcd_barrier(bar); PHASE_LOCAL(); p8_final<FF / 128>(F, split, SLABS); }
#undef SLABS
#undef IN
#undef SEAM
#undef HB
#undef HH
#undef QZ
#undef SS1
#undef SS2
#undef SS3
#undef SS4
#undef RS2
#undef RS3
#undef YP
#undef HX0
#undef HX
}

extern "C" void kernel_launch(void* const* d_in, const int* in_sizes, int n_in, void* d_out, int out_size, void* d_ws, size_t ws_size, hipStream_t stream) {
    static int grid = 0;
    if (grid == 0) {
        if (n_in != 26 || in_sizes[0] != MP * D || (size_t)out_size != O_END || ws_size < WS_END) {
            fprintf(stderr, "kernel_launch: unexpected shapes: n_in %d in0 %d out %d ws %zu; nothing launched\n", n_in, n_in > 0 ? in_sizes[0] : -1, out_size, ws_size); grid = -1; return; }
        int dev = 0, cus = 0, per_cu = 0;
        if (hipGetDevice(&dev) != hipSuccess || hipDeviceGetAttribute(&cus, hipDeviceAttributeMultiprocessorCount, dev) != hipSuccess) { fprintf(stderr, "kernel_launch: device query failed\n"); grid = -1; return; }
        if (hipFuncSetAttribute((const void*)hymba_fwd<true>, hipFuncAttributeMaxDynamicSharedMemorySize, LDS_BYTES) != hipSuccess || hipFuncSetAttribute((const void*)hymba_fwd<false>, hipFuncAttributeMaxDynamicSharedMemorySize, LDS_BYTES) != hipSuccess) { fprintf(stderr, "kernel_launch: hipFuncSetAttribute failed\n"); grid = -1; return; }
        if (hipOccupancyMaxActiveBlocksPerMultiprocessor(&per_cu, cus == 256 ? (const void*)hymba_fwd<true> : (const void*)hymba_fwd<false>, NWAVES * 64, LDS_BYTES) != hipSuccess || per_cu < 1)
            fprintf(stderr, "kernel_launch: note: occupancy query reports %d workgroups per CU\n", per_cu);
        (void)hipGetLastError();
        grid = cus;
    }
    if (grid < 0) return;
    if (hipMemsetAsync((char*)d_ws + WS_CTL, 0, CTL_ZERO_BYTES, stream) != hipSuccess) { fprintf(stderr, "kernel_launch: memset failed\n"); return; }
    Args a{};
    for (int i = 0; i < 26; ++i) a.in[i] = (const float*)d_in[i];
    a.out = (float*)d_out; a.ws = (unsigned char*)d_ws;
#if MK_PER_PHASE
    for (int p = 0; p < N_PHASES; ++p) { a.ph_lo = p; a.ph_hi = p + 1; if (grid == 256) hipLaunchKernelGGL(hymba_fwd<true>, dim3(grid), dim3(NWAVES * 64), LDS_BYTES, stream, a); else hipLaunchKernelGGL(hymba_fwd<false>, dim3(grid), dim3(NWAVES * 64), LDS_BYTES, stream, a); }
#else
    a.ph_lo = 0; a.ph_hi = N_PHASES;
    if (grid == 256) hipLaunchKernelGGL(hymba_fwd<true>, dim3(grid), dim3(NWAVES * 64), LDS_BYTES, stream, a);
    else hipLaunchKernelGGL(hymba_fwd<false>, dim3(grid), dim3(NWAVES * 64), LDS_BYTES, stream, a);
#endif
    const hipError_t le = hipPeekAtLastError();
    if (le != hipSuccess) fprintf(stderr, "kernel_launch: launch failed: %s\n", hipGetErrorName(le));
}
```

```cpp
#include <hip/hip_runtime.h>
#include <cstdio>
#include <cstdint>
namespace pg8 {
#define PG8_LAS __attribute__((address_space(3)))
typedef unsigned short bf16_t;
typedef short bf16x8 __attribute__((ext_vector_type(8)));
typedef float f32x4 __attribute__((ext_vector_type(4)));
typedef unsigned u32x4 __attribute__((ext_vector_type(4)));
constexpr int BM = 256, BK = 64, HALF = 128, HTB = HALF * BK * 2  , STAGE_BYTES = 8 * HTB, NXCD = 8, WGM = 8;

__host__ __device__ __forceinline__ int lds_byte(int r, int c) { const int st = (r >> 4) * 2 + (c >> 5), rr = r & 15, cc = c & 31, ob = rr * 64 + cc * 2; return st * 1024 + (ob ^ (((ob >> 9) & 1) << 5)); }
__host__ __device__ __forceinline__ void stage_rc(int b, int& R, int& C) { const int st = b / 1024, sb = b % 1024, swz = sb ^ (((sb >> 9) & 1) << 5); R = (st >> 1) * 16 + swz / 64; C = (st & 1) * 32 + (swz % 64) / 2; }
__host__ __device__ __forceinline__ int perm32(int rho) { const int n = rho >> 4, i = rho & 15; return 8 * (i >> 2) + 4 * n + (i & 3); }

struct Unit { int pm, pn, k0, nt, kind, slot; };
struct Gemm { const bf16_t* A; const bf16_t* Bt; int M, N, K, lda; };

struct MixOrder {
    int nM, nN, nwg, G, c, ppu, npieces, rounds, wgm;
    __host__ __device__ __forceinline__ void init(int nM_, int N, int K, int G_, int c_, int split, int wgm_) { wgm = wgm_; nM = nM_; nN = N / BM; nwg = nM * nN; G = G_; c = c_; ppu = K / (2 * BK); npieces = split ? nN * ppu : 0; rounds = (nwg + G - 1) / G; }
    __host__ __device__ __forceinline__ bool next(int i, Unit& u) const {
        if (i >= rounds) { const int p = (i - rounds) * G + c; if (p >= npieces) return false; u.pm = nM; u.pn = p / ppu; u.k0 = 2 * (p % ppu); u.nt = 2; u.kind = 1; u.slot = p; return true; }
        const long L = (long)i * G + c; if (L >= nwg) return false;
        int wgid = (int)L; { const int q = nwg / NXCD, r = nwg % NXCD, xcd = wgid % NXCD, off = wgid / NXCD; wgid = (xcd < r ? xcd * (q + 1) : r * (q + 1) + (xcd - r) * q) + off; }
        const int nig = wgm * nN, gid = wgid / nig, fm = gid * wgm, gsz = (nM - fm) < wgm ? (nM - fm) : wgm;
        u.pm = fm + ((wgid % nig) % gsz); u.pn = (wgid % nig) / gsz; u.k0 = 0; u.nt = 2 * ppu; u.kind = 0; u.slot = 0; return true;
    }
};

__device__ __forceinline__ unsigned cvt_pk_bf16(float lo, float hi) { unsigned r; asm volatile("v_cvt_pk_bf16_f32 %0, %1, %2" : "=v"(r) : "v"(lo), "v"(hi)); return r; }
typedef float f32x2 __attribute__((ext_vector_type(2)));
constexpr float EPSN = 1e-6f;
__device__ __forceinline__ float row_rstd(const float* SS, int row) {
    const f32x4* p = (const f32x4*)(SS + (size_t)row * 16);
    const f32x4 a = p[0], b = p[1], c = p[2], d = p[3];
    const float s = (((a[0] + a[1]) + (a[2] + a[3])) + ((b[0] + b[1]) + (b[2] + b[3]))) + (((c[0] + c[1]) + (c[2] + c[3])) + ((d[0] + d[1]) + (d[2] + d[3])));
    return __builtin_amdgcn_rsqf(s * (1.0f / 1024.0f) + EPSN);
}
__device__ __forceinline__ float silu_f(float x) { return x * __builtin_amdgcn_rcpf(1.0f + __expf(-x)); }
typedef unsigned u32x2 __attribute__((ext_vector_type(2)));

struct EpiSwiglu {
    static constexpr bool PERM = true, AFTER_DRAIN = false;
    bf16_t* H; const float* RSTD; int ldh, nkt;
    __device__ __forceinline__ void operator()(const f32x4 (&acc)[2][2][4][2], const Unit& u, int wr, int wc, int fr, int fq) const {
        const int row0 = u.pm * BM + wr * 64 + fr, col0 = u.pn * 128 + wc * 32 + 8 * fq;
        float rs8[8];
#pragma unroll
        for (int i = 0; i < 8; ++i) rs8[i] = RSTD[row0 + (i >> 2) * HALF + (i & 3) * 16];
#pragma unroll
        for (int ai = 0; ai < 2; ++ai)
#pragma unroll
            for (int m = 0; m < 4; ++m) {
                const int row = row0 + ai * HALF + m * 16;
                const float rs = rs8[ai * 4 + m];
                float h[8];
#pragma unroll
                for (int n = 0; n < 2; ++n)
#pragma unroll
                    for (int j = 0; j < 4; ++j) { const float g = acc[ai][0][m][n][j] * rs, up = acc[ai][1][m][n][j] * rs; h[n * 4 + j] = silu_f(g) * up; }
                u32x4 w; w.x = cvt_pk_bf16(h[0], h[1]); w.y = cvt_pk_bf16(h[2], h[3]); w.z = cvt_pk_bf16(h[4], h[5]); w.w = cvt_pk_bf16(h[6], h[7]);
                if (ldh) *(u32x4*)(H + (size_t)row * ldh + col0) = w;
                else *(u32x4*)(H + ((size_t)((row >> 8) * nkt + (col0 >> 6)) * 256 + (row & 255)) * 64 + (col0 & 63)) = w;
            }
    }
};

struct EpiResid {
    static constexpr bool PERM = false, AFTER_DRAIN = false;
    const bf16_t* RB; float* D0;
    const float* RX; float* DX;
    bf16_t* HB; float* SS; float scale; unsigned long long* gran;
    __device__ __forceinline__ void operator()(const f32x4 (&acc)[2][2][4][2], const Unit& u, int wr, int wc, int fr, int fq) const {
        const int col0 = u.pn * BM + wc * 32 + 4 * fq;
        if (u.pm < 64) {
            const bf16_t* rb = RB + (size_t)u.pm * BM * 1024; float* db = D0 ? D0 + (size_t)u.pm * BM * 1024 : nullptr;
            u32x2 rn[2][2];
            { const size_t off0 = (size_t)(wr * 64 + fr) * 1024 + col0;
#pragma unroll
              for (int bj = 0; bj < 2; ++bj)
#pragma unroll
                  for (int n = 0; n < 2; ++n) rn[bj][n] = *(const u32x2*)(rb + off0 + bj * HALF + n * 16); }
#pragma unroll
            for (int ai = 0; ai < 2; ++ai)
#pragma unroll
                for (int m = 0; m < 4; ++m) {
                    int lrow = ai * HALF + wr * 64 + m * 16 + fr;
                    asm volatile("" : "+v"(lrow));
                    const size_t off = (size_t)lrow * 1024 + col0;
                    u32x2 rc[2][2];
#pragma unroll
                    for (int bj = 0; bj < 2; ++bj)
#pragma unroll
                        for (int n = 0; n < 2; ++n) rc[bj][n] = rn[bj][n];
                    if (ai * 4 + m < 7) { const int nx = ai * 4 + m + 1; int lnx = (nx >> 2) * HALF + wr * 64 + (nx & 3) * 16 + fr; asm volatile("" : "+v"(lnx));
                        const size_t offn = (size_t)lnx * 1024 + col0;
#pragma unroll
                        for (int bj = 0; bj < 2; ++bj)
#pragma unroll
                            for (int n = 0; n < 2; ++n) rn[bj][n] = *(const u32x2*)(rb + offn + bj * HALF + n * 16); }
                    float sq = 0.f;
#pragma unroll
                    for (int bj = 0; bj < 2; ++bj)
#pragma unroll
                        for (int n = 0; n < 2; ++n) {
                            const u32x2 rr = rc[bj][n];
                            const f32x4 r = (f32x4){__builtin_bit_cast(float, rr.x << 16), __builtin_bit_cast(float, rr.x & 0xffff0000u), __builtin_bit_cast(float, rr.y << 16), __builtin_bit_cast(float, rr.y & 0xffff0000u)};
                            const f32x4 o = r + acc[ai][bj][m][n] * scale;
                            if (db) *(f32x4*)(db + off + bj * HALF + n * 16) = o;
                            sq += (o[0] * o[0] + o[1] * o[1]) + (o[2] * o[2] + o[3] * o[3]);
                            if (HB) { u32x2 w; w.x = cvt_pk_bf16(o[0], o[1]); w.y = cvt_pk_bf16(o[2], o[3]); *(u32x2*)(HB + ((size_t)u.pm * BM + lrow) * 1024 + col0 + bj * HALF + n * 16) = w; }
                        }
                    sq += __shfl_xor(sq, 16); sq += __shfl_xor(sq, 32);
                    if (fq == 0) { if (gran) __hip_atomic_store(gran + ((size_t)u.pm * BM + lrow) * 16 + u.pn * 4 + wc, (1ull << 32) | (unsigned long long)__builtin_bit_cast(unsigned, sq), __ATOMIC_RELAXED, __HIP_MEMORY_SCOPE_AGENT);
                        else SS[((size_t)u.pm * BM + lrow) * 16 + u.pn * 4 + wc] = sq; }
                    asm volatile("" ::: "memory");
                }
        } else {
#pragma unroll
            for (int ai = 0; ai < 2; ++ai)
#pragma unroll
                for (int m = 0; m < 4; ++m) {
                    int lrow = ai * HALF + wr * 64 + m * 16 + fr;
                    asm volatile("" : "+v"(lrow));
                    const size_t off = (size_t)lrow * 1024 + col0;
                    float sq = 0.f;
#pragma unroll
                    for (int bj = 0; bj < 2; ++bj)
#pragma unroll
                        for (int n = 0; n < 2; ++n) {
                            const f32x4 o = *(const f32x4*)(RX + off + bj * HALF + n * 16) + acc[ai][bj][m][n] * scale;
                            *(f32x4*)(DX + off + bj * HALF + n * 16) = o;
                            sq += (o[0] * o[0] + o[1] * o[1]) + (o[2] * o[2] + o[3] * o[3]);
                            if (HB) { u32x2 w; w.x = cvt_pk_bf16(o[0], o[1]); w.y = cvt_pk_bf16(o[2], o[3]); *(u32x2*)(HB + ((size_t)u.pm * BM + lrow) * 1024 + col0 + bj * HALF + n * 16) = w; }
                        }
                    sq += __shfl_xor(sq, 16); sq += __shfl_xor(sq, 32);
                    if (fq == 0) SS[((size_t)u.pm * BM + lrow) * 16 + u.pn * 4 + wc] = sq;
                    asm volatile("" ::: "memory");
                }
        }
    }
};

struct EpiInproj {
    static constexpr bool PERM = true, AFTER_DRAIN = false;
    const float* RSTD; bf16_t* QZ; float* FZ; bf16_t* VB; bf16_t* GB; bf16_t* XBC; float* DT;
    const float* hgn; const float* dtb; float* convp; float* convs;
    __device__ __forceinline__ void operator()(const f32x4 (&acc)[2][2][4][2], const Unit& u, int wr, int wc, int fr, int fq) const {
        const int type = u.pn;
        const int row0 = u.pm * BM + wr * 64 + fr;
        float rs8[8];
#pragma unroll
        for (int i = 0; i < 8; ++i) rs8[i] = RSTD[row0 + (i >> 2) * HALF + (i & 3) * 16];
#pragma unroll
        for (int ai = 0; ai < 2; ++ai)
#pragma unroll
            for (int m = 0; m < 4; ++m) {
                const int row = row0 + ai * HALF + m * 16;
                const float rs = rs8[ai * 4 + m];
#pragma unroll
                for (int bj = 0; bj < 2; ++bj) {
                    const int c0 = 128 * bj + 32 * wc + 8 * fq;
                    float v[8];
#pragma unroll
                    for (int n = 0; n < 2; ++n)
#pragma unroll
                        for (int j = 0; j < 4; ++j) v[n * 4 + j] = acc[ai][bj][m][n][j] * rs;
                    if (type < 2 || (type >= 8 && type < 10)) {
                        const int col = (type < 2 ? 256 * type : 512 + 256 * (type - 8)) + c0;
#pragma unroll
                        for (int j = 0; j < 8; ++j) v[j] = silu_f(v[j]);
                        u32x4 w; w.x = cvt_pk_bf16(v[0], v[1]); w.y = cvt_pk_bf16(v[2], v[3]); w.z = cvt_pk_bf16(v[4], v[5]); w.w = cvt_pk_bf16(v[6], v[7]);
                        *(u32x4*)(QZ + (size_t)row * 1024 + col) = w;
                    } else if (type < 4) {
                        const int col = 256 * (type - 2) + c0;
                        *(f32x4*)(FZ + (size_t)row * 512 + col) = (f32x4){v[0], v[1], v[2], v[3]};
                        *(f32x4*)(FZ + (size_t)row * 512 + col + 4) = (f32x4){v[4], v[5], v[6], v[7]};
                    } else if (type < 6) {
                        const int col = 256 * (type - 4) + c0;
                        u32x4 w; w.x = cvt_pk_bf16(v[0], v[1]); w.y = cvt_pk_bf16(v[2], v[3]); w.z = cvt_pk_bf16(v[4], v[5]); w.w = cvt_pk_bf16(v[6], v[7]);
                        *(u32x4*)(VB + (size_t)row * 512 + col) = w;
                    } else if (type < 8) {
                        const int col = 256 * (type - 6) + c0;
                        const f32x4 n0 = *(const f32x4*)(hgn + col), n1 = *(const f32x4*)(hgn + col + 4);
#pragma unroll
                        for (int j = 0; j < 4; ++j) { v[j] = silu_f(v[j]) * n0[j]; v[4 + j] = silu_f(v[4 + j]) * n1[j]; }
                        u32x4 w; w.x = cvt_pk_bf16(v[0], v[1]); w.y = cvt_pk_bf16(v[2], v[3]); w.z = cvt_pk_bf16(v[4], v[5]); w.w = cvt_pk_bf16(v[6], v[7]);
                        *(u32x4*)(GB + (size_t)row * 512 + col) = w;
                    } else if (type < 14) {
                        const int col = 256 * (type - 10) + c0;
                        u32x4 w; w.x = cvt_pk_bf16(v[0], v[1]); w.y = cvt_pk_bf16(v[2], v[3]); w.z = cvt_pk_bf16(v[4], v[5]); w.w = cvt_pk_bf16(v[6], v[7]);
                        *(u32x4*)(XBC + (size_t)row * 1024 + col) = w;
                        float* cs = nullptr;
                        if (row < 16384) { const int t = row & 2047; if (t >= 2045) cs = convp + ((size_t)(row >> 11) * 3 + (t - 2045)) * 1024 + col; }
                        else if (row >= 16400 && row < 16528) cs = convs + ((size_t)(row - 16400) * 3 + 2) * 1024 + col;
                        if (cs) { *(f32x4*)cs = (f32x4){v[0], v[1], v[2], v[3]}; *(f32x4*)(cs + 4) = (f32x4){v[4], v[5], v[6], v[7]}; }
                    } else {
                        if (bj == 0 && wc == 0 && fq == 0) {
                            float d[8];
#pragma unroll
                            for (int j = 0; j < 8; ++j) { const float x = v[j] + dtb[j]; d[j] = x > 20.f ? x : log1pf(__expf(x)); }
                            *(f32x4*)(DT + (size_t)row * 8) = (f32x4){d[0], d[1], d[2], d[3]};
                            *(f32x4*)(DT + (size_t)row * 8 + 4) = (f32x4){d[4], d[5], d[6], d[7]};
                        }
                    }
                }
            }
    }
};
template <class Epi, class Sched, bool ALIGN_EPI = false, bool SP2 = false>
__device__ __forceinline__ void gemm_phase(PG8_LAS unsigned char* lds, const Gemm g, const Sched& S, const Epi& E, float* slab) {
    int tid_ = threadIdx.x; asm volatile("" : "+v"(tid_));
    const int tid = tid_, wid = __builtin_amdgcn_readfirstlane(tid >> 6), lane = tid & 63, wr = wid >> 2, wc = wid & 3, fr = lane & 15, fq = lane >> 4;
    const int K = g.K;
    unsigned voffA[2], voffB[2]; int aoff, boff;
#define PG8_LANE_OFFSETS(T_) do { _Pragma("unroll") for (int i = 0; i < 2; ++i) { int R, C; stage_rc((T_) * 16 + i * 8192, R, C); const int Rb = Epi::PERM ? ((R & ~31) + perm32(R & 31)) : R; \
        voffA[i] = (unsigned)(R * (g.lda ? g.lda : BK) + C) * 2u; voffB[i] = (unsigned)(Rb * K + C) * 2u; } \
        aoff = lds_byte((((T_) >> 8) & 1) * 64 + ((T_) & 15), (((T_) >> 4) & 3) * 8); boff = lds_byte((((T_) >> 6) & 3) * 32 + ((T_) & 15), (((T_) >> 4) & 3) * 8); } while (0)
    PG8_LANE_OFFSETS(tid);
    const size_t kstep = (size_t)(BK * 2), kstepA = g.lda ? (size_t)(BK * 2) : (size_t)(BM * BK * 2);
    const size_t hstep = (size_t)HALF * K * 2, hstepA = g.lda ? (size_t)HALF * g.lda * 2 : (size_t)(HALF * BK * 2);
    const size_t tstep = 2 * hstep, tstepA = g.lda ? 2 * hstepA : (size_t)(K / BK) * (BM * BK * 2);
    const unsigned ldsw = (unsigned)wid * 1024u;
#define PG8_SA(b, h) (((b) * 2 + (h)) * HTB)
#define PG8_SB(b, h) ((4 + (b) * 2 + (h)) * HTB)
#define PG8_STAGE(bufoff, gbase, voff) do { _Pragma("unroll") for (int _i = 0; _i < 2; ++_i) \
        __builtin_amdgcn_global_load_lds((const unsigned*)((const char*)(gbase) + (voff)[_i]), (PG8_LAS unsigned*)(lds + (bufoff) + ldsw + _i * 8192), 16, 0, 0); } while (0)
#define PG8_LDA(dst, b, h) do { _Pragma("unroll") for (int m = 0; m < 4; ++m) _Pragma("unroll") for (int k = 0; k < 2; ++k) dst[m][k] = *(const PG8_LAS bf16x8*)(lds + PG8_SA(b, h) + aoff + m * 2048 + k * 1024); } while (0)
#define PG8_LDB(dst, b, h) do { _Pragma("unroll") for (int n = 0; n < 2; ++n) _Pragma("unroll") for (int k = 0; k < 2; ++k) dst[n][k] = *(const PG8_LAS bf16x8*)(lds + PG8_SB(b, h) + boff + n * 2048 + k * 1024); } while (0)
#define PG8_MMA(ai, bj, At, Bt) do { __builtin_amdgcn_s_setprio(1); _Pragma("unroll") for (int m = 0; m < 4; ++m) _Pragma("unroll") for (int n = 0; n < 2; ++n) _Pragma("unroll") for (int k = 0; k < 2; ++k) \
        acc[ai][bj][m][n] = __builtin_amdgcn_mfma_f32_16x16x32_bf16(Bt[n][k], At[m][k], acc[ai][bj][m][n], 0, 0, 0); __builtin_amdgcn_s_setprio(0); } while (0)
#define PG8_WAIT_V(n) asm volatile("s_waitcnt vmcnt(" #n ")" ::: "memory")
#define PG8_WAIT_L(n) asm volatile("s_waitcnt lgkmcnt(" #n ")" ::: "memory")
#define PG8_BAR __builtin_amdgcn_s_barrier()
#define PG8_SCHED __builtin_amdgcn_sched_barrier(0)
    Unit cur, nxt; int ui = 0;
    if (!S.next(0, cur)) return;
    f32x4 acc[2][2][4][2];
#pragma unroll
    for (int a = 0; a < 2; ++a)
#pragma unroll
        for (int b = 0; b < 2; ++b)
#pragma unroll
            for (int m = 0; m < 4; ++m)
#pragma unroll
                for (int n = 0; n < 2; ++n) acc[a][b][m][n] = (f32x4){0.f, 0.f, 0.f, 0.f};
    bf16x8 At[4][2], B0[2][2], B1[2][2];
    const char* cA = (const char*)g.A + (size_t)cur.pm * tstepA + (size_t)cur.k0 * kstepA; const char* cB = (const char*)g.Bt + (size_t)cur.pn * tstep + (size_t)cur.k0 * kstep;
    if constexpr (SP2) {
        PG8_STAGE(PG8_SB(0, 0), cB, voffB); PG8_STAGE(PG8_SB(0, 1), cB + hstep, voffB); PG8_STAGE(PG8_SA(0, 0), cA, voffA); PG8_STAGE(PG8_SA(0, 1), cA + hstepA, voffA);
        if (wr == 1) PG8_BAR;
        PG8_WAIT_V(2); PG8_BAR;
        PG8_STAGE(PG8_SB(1, 0), cB + kstep, voffB); PG8_STAGE(PG8_SA(1, 0), cA + kstepA, voffA); PG8_STAGE(PG8_SB(1, 1), cB + hstep + kstep, voffB);
        PG8_WAIT_V(6); PG8_BAR;
    } else {
        PG8_STAGE(PG8_SB(0, 0), cB, voffB); PG8_STAGE(PG8_SA(0, 0), cA, voffA); PG8_STAGE(PG8_SB(0, 1), cB + hstep, voffB); PG8_STAGE(PG8_SA(0, 1), cA + hstepA, voffA);
        if (wr == 1) PG8_BAR;
        PG8_WAIT_V(4); PG8_BAR;
        PG8_STAGE(PG8_SB(1, 0), cB + kstep, voffB); PG8_STAGE(PG8_SA(1, 0), cA + kstepA, voffA); PG8_STAGE(PG8_SB(1, 1), cB + hstep + kstep, voffB);
        PG8_WAIT_V(6); PG8_BAR;
    }
    for (;;) {
        const bool has_next = S.next(ui + 1, nxt);
        const char* nA = has_next ? (const char*)g.A + (size_t)nxt.pm * tstepA + (size_t)nxt.k0 * kstepA : cA; const char* nB = has_next ? (const char*)g.Bt + (size_t)nxt.pn * tstep + (size_t)nxt.k0 * kstep : cB;
        const int nt = cur.nt;
        for (int t = 0; t < nt; t += 2) {
            const bool last = (t == nt - 2);
            const char* a1 = cA + (size_t)(t + 1) * kstepA;
            const char* a2 = last ? nA : cA + (size_t)(t + 2) * kstepA; const char* b2 = last ? nB : cB + (size_t)(t + 2) * kstep;
            const char* a3 = a2 + kstepA; const char* b3 = b2 + kstep;
            if constexpr (SP2) {
            PG8_LDB(B0, 0, 0); PG8_LDB(B1, 0, 1); PG8_SCHED; PG8_LDA(At, 0, 0); PG8_STAGE(PG8_SA(1, 1), a1 + hstepA, voffA);
            PG8_WAIT_V(8); PG8_WAIT_L(0); PG8_BAR; PG8_MMA(0, 0, At, B0); PG8_MMA(0, 1, At, B1); PG8_BAR; PG8_SCHED;
            PG8_LDA(At, 0, 1); PG8_STAGE(PG8_SB(0, 0), b2, voffB); PG8_STAGE(PG8_SB(0, 1), b2 + hstep, voffB); PG8_STAGE(PG8_SA(0, 0), a2, voffA);
            PG8_WAIT_V(8); PG8_WAIT_L(0); PG8_BAR; PG8_MMA(1, 0, At, B0); PG8_MMA(1, 1, At, B1); PG8_BAR; PG8_SCHED;
            PG8_LDB(B0, 1, 0); PG8_LDB(B1, 1, 1); PG8_SCHED; PG8_LDA(At, 1, 0); PG8_STAGE(PG8_SA(0, 1), a2 + hstepA, voffA);
            PG8_WAIT_V(8); PG8_WAIT_L(0); PG8_BAR; PG8_MMA(0, 0, At, B0); PG8_MMA(0, 1, At, B1); PG8_BAR; PG8_SCHED;
            PG8_LDA(At, 1, 1); PG8_STAGE(PG8_SB(1, 0), b3, voffB); PG8_STAGE(PG8_SB(1, 1), b3 + hstep, voffB); PG8_STAGE(PG8_SA(1, 0), a3, voffA);
            PG8_WAIT_V(8); PG8_WAIT_L(0); PG8_BAR; PG8_MMA(1, 0, At, B0); PG8_MMA(1, 1, At, B1); PG8_BAR; PG8_SCHED;
            } else {
            PG8_LDB(B0, 0, 0); PG8_SCHED; PG8_LDA(At, 0, 0); PG8_STAGE(PG8_SA(1, 1), a1 + hstepA, voffA);
            PG8_WAIT_L(8); PG8_BAR; PG8_WAIT_L(0); PG8_MMA(0, 0, At, B0); PG8_BAR; PG8_SCHED;
            PG8_LDB(B1, 0, 1); PG8_STAGE(PG8_SB(0, 0), b2, voffB);
            PG8_BAR; PG8_WAIT_L(0); PG8_MMA(0, 1, At, B1); PG8_BAR;
            PG8_LDA(At, 0, 1); PG8_STAGE(PG8_SA(0, 0), a2, voffA);
            PG8_BAR; PG8_WAIT_L(0); PG8_MMA(1, 0, At, B0); PG8_BAR; PG8_SCHED;
            PG8_STAGE(PG8_SB(0, 1), b2 + hstep, voffB);
            PG8_WAIT_V(6); PG8_BAR; PG8_MMA(1, 1, At, B1); PG8_BAR;
            PG8_LDB(B0, 1, 0); PG8_SCHED; PG8_LDA(At, 1, 0); PG8_STAGE(PG8_SA(0, 1), a2 + hstepA, voffA);
            PG8_WAIT_L(8); PG8_BAR; PG8_WAIT_L(0); PG8_MMA(0, 0, At, B0); PG8_BAR; PG8_SCHED;
            PG8_LDB(B1, 1, 1); PG8_STAGE(PG8_SB(1, 0), b3, voffB);
            PG8_BAR; PG8_WAIT_L(0); PG8_MMA(0, 1, At, B1); PG8_BAR;
            PG8_LDA(At, 1, 1); PG8_STAGE(PG8_SA(1, 0), a3, voffA);
            PG8_BAR; PG8_WAIT_L(0); PG8_MMA(1, 0, At, B0); PG8_BAR; PG8_SCHED;
            PG8_STAGE(PG8_SB(1, 1), b3 + hstep, voffB);
            PG8_WAIT_V(6); PG8_BAR; PG8_MMA(1, 1, At, B1); PG8_BAR;
            }
        }
        if constexpr (ALIGN_EPI) { if (wr == 0) PG8_BAR; }
        if (cur.kind == 1) {
            float* sb = slab + (size_t)cur.slot * 65536;
#pragma unroll
            for (int a = 0; a < 2; ++a)
#pragma unroll
                for (int m = 0; m < 4; ++m) {
                    int lrow = a * HALF + wr * 64 + m * 16 + fr; asm volatile("" : "+v"(lrow));
                    float* rp = sb + (size_t)lrow * 256 + wc * 32 + 4 * fq;
#pragma unroll
                    for (int b = 0; b < 2; ++b)
#pragma unroll
                        for (int n = 0; n < 2; ++n) *(f32x4*)(rp + b * HALF + n * 16) = acc[a][b][m][n];
                }
        } else {
            E(acc, cur, wr, wc, fr, fq);
        }
        if (!has_next) break;
#pragma unroll
        for (int a = 0; a < 2; ++a)
#pragma unroll
            for (int b = 0; b < 2; ++b)
#pragma unroll
                for (int m = 0; m < 4; ++m)
#pragma unroll
                    for (int n = 0; n < 2; ++n) acc[a][b][m][n] = (f32x4){0.f, 0.f, 0.f, 0.f};
        cur = nxt; cA = nA; cB = nB; ++ui;
        if constexpr (ALIGN_EPI) { if (wr == 1) PG8_BAR; }
    }
    PG8_WAIT_V(0);
    if constexpr (!ALIGN_EPI) { if (wr == 0) PG8_BAR; }
    PG8_BAR;
#undef PG8_LANE_OFFSETS
#undef PG8_SA
#undef PG8_SB
#undef PG8_STAGE
#undef PG8_LDA
#undef PG8_LDB
#undef PG8_MMA
#undef PG8_WAIT_V
#undef PG8_WAIT_L
#undef PG8_BAR
#undef PG8_SCHED
}
}
constexpr int NWAVES = 8;
constexpr int D = 1024, NBATCH = 8, SEQ = 2048, NMETA = 16, NSMP = 128, FF = 2816;
constexpr int MP = NBATCH * SEQ;
constexpr int ROW_META = MP, ROW_SMP = MP + NMETA;
constexpr int M = 16640;
constexpr int NIN = 3592, NINP = 3840;
constexpr int LDH = 0;
constexpr int CH = 64, NCH = SEQ / CH;
constexpr float EPS = 1e-6f;
constexpr size_t O_YP = 0, O_YS = O_YP + (size_t)MP * D, O_HGP = O_YS + (size_t)NSMP * D, O_SSP = O_HGP + (size_t)NBATCH * 4 * 128 * 128, O_CVP = O_SSP + (size_t)NBATCH * 8 * 64 * 128,
                 O_HGS = O_CVP + (size_t)NBATCH * 3 * 1024, O_SSS = O_HGS + (size_t)NSMP * 4 * 128 * 128, O_CVS = O_SSS + (size_t)NSMP * 8 * 64 * 128, O_END = O_CVS + (size_t)NSMP * 3 * 1024;
constexpr size_t KiB = 1024, MiB = 1u << 20;
constexpr size_t WS_CTL = 0, CTL_ZERO_BYTES = 1 * MiB;
constexpr size_t WS_WGU1 = 1 * MiB, WS_WD1 = 12 * MiB, WS_WIN = 17 * MiB + 512 * KiB, WS_WOUT = 25 * MiB, WS_WGU2 = 27 * MiB, WS_WD2 = 38 * MiB;
constexpr size_t WS_HB = 44 * MiB;
constexpr size_t WS_R = 77 * MiB;
constexpr size_t WS_H = WS_R;
constexpr size_t WS_QZ = 77 * MiB;
constexpr size_t WS_FZ = 110 * MiB;
constexpr size_t WS_VB = 143 * MiB;
constexpr size_t WS_GB = 160 * MiB;
constexpr size_t WS_XBC = 177 * MiB;
constexpr size_t WS_UM = 210 * MiB;
constexpr size_t WS_DT = 243 * MiB;
constexpr size_t WS_ER = 244 * MiB, WS_EL = 245 * MiB;
constexpr size_t WS_DCY = 246 * MiB;
constexpr size_t WS_LB = 246 * MiB + 512 * KiB;
constexpr size_t WS_HX0 = 247 * MiB, WS_HX = 248 * MiB;
constexpr size_t WS_SS1 = 249 * MiB, WS_SS2 = 250 * MiB + 256 * KiB, WS_SS3 = 251 * MiB + 512 * KiB, WS_SS4 = 252 * MiB + 768 * KiB;
constexpr size_t WS_END = 256 * MiB;
constexpr size_t UTH_ENT = 128 * 128;
constexpr size_t UM_ENT = 64 * 128;
static_assert(WS_HB + (size_t)M * 1024 * 2 <= WS_R && (1024 + 4) * UTH_ENT * 2 <= (size_t)MP * D * 4, "hb / UTH (in the y_prompt output region)");
static_assert(WS_H + (size_t)M * FF * 2 <= WS_XBC && WS_QZ + (size_t)M * 2048 <= WS_FZ && WS_FZ + (size_t)M * 2048 <= WS_VB && WS_VB + (size_t)M * 1024 <= WS_GB && WS_GB + (size_t)M * 1024 <= WS_XBC, "map 1");
static_assert(WS_XBC + (size_t)M * 2048 <= WS_UM && WS_UM + (2048 + 8) * UM_ENT * 2 <= WS_DT && WS_DT + (size_t)M * 32 <= WS_ER && WS_SS4 + (size_t)M * 64 <= WS_END, "map 2");
constexpr int CW_BAR = 4096;
constexpr int RING_BYTES = 131072, LDSCTL_OFF = RING_BYTES, MISC_OFF = LDSCTL_OFF + 320, LDS_BYTES = 147456;

#define GAS __attribute__((address_space(1)))
#define LAS __attribute__((address_space(3)))
typedef unsigned short bf16;
typedef unsigned v4u __attribute__((ext_vector_type(4)));
typedef float f32x4 __attribute__((ext_vector_type(4)));
typedef float f32x16 __attribute__((ext_vector_type(16)));
typedef short bf16x8 __attribute__((ext_vector_type(8)));
typedef GAS unsigned gu32;
#define RLX_AGENT __ATOMIC_RELAXED, __HIP_MEMORY_SCOPE_AGENT
#define LDS_WAIT() asm volatile("s_waitcnt lgkmcnt(0)" ::: "memory")
#define VM_WAIT() asm volatile("s_waitcnt vmcnt(0)" ::: "memory")
typedef __bf16 bf16x2_t __attribute__((ext_vector_type(2)));
__device__ __forceinline__ unsigned pk2(float lo, float hi) { bf16x2_t v; v.x = (__bf16)lo; v.y = (__bf16)hi; return __builtin_bit_cast(unsigned, v); }
__device__ __forceinline__ unsigned f2bf(float f) { return (unsigned)__builtin_bit_cast(unsigned short, (__bf16)f); }
__device__ __forceinline__ float bf2f(unsigned short b) { return __builtin_bit_cast(float, (unsigned)b << 16); }
__device__ __forceinline__ float sigm(float x) { return __builtin_amdgcn_rcpf(1.0f + __expf(-x)); }
__device__ __forceinline__ float silu(float x) { return x * __builtin_amdgcn_rcpf(1.0f + __expf(-x)); }
#define XB_TMO      128
#define XB_XCNT(j)  (256  + 64 * (j))
#define XB_XSUB(j)  (1280 + 64 * (j))
#define XB_XGEN(j)  (2304 + 64 * (j))
#define XB_TOP      3328
#define XB_TOPGEN   3392
#define XCD_BAR_WORDS 3456
#define XB_SPIN_CAP (1u << 18)

__device__ __forceinline__ unsigned xb_ld(unsigned* p)              { return __hip_atomic_load(p, __ATOMIC_RELAXED, __HIP_MEMORY_SCOPE_AGENT); }
__device__ __forceinline__ unsigned xb_add(unsigned* p, unsigned v) { return __hip_atomic_fetch_add(p, v, __ATOMIC_RELAXED, __HIP_MEMORY_SCOPE_AGENT); }
__device__ __forceinline__ unsigned xb_xcc_id() { return (unsigned)__builtin_amdgcn_s_getreg((3 << 11) | 20) & 0xFu; }
#define XB_SPIN(cond, bar) do { unsigned _sp = 0; while (cond) { __builtin_amdgcn_s_sleep(1); \
    if ((++_sp & 255u) == 0u) { if (xb_ld(&(bar)[XB_TMO])) break; if (_sp > XB_SPIN_CAP) { atomicAdd(&(bar)[XB_TMO], 1u); break; } } } } while (0)

struct XcdBarrier {
    unsigned* bar; unsigned x;
    volatile LAS unsigned* st;
};

__device__ __forceinline__ XcdBarrier xcd_barrier_post(unsigned* bar, volatile LAS unsigned* st) {
    XcdBarrier b; b.bar = bar; b.x = xb_xcc_id(); b.st = st;
    if (threadIdx.x == 0) (void)xb_add(&bar[XB_XCNT(b.x)], 1u);
    return b;
}
__device__ __forceinline__ void xcd_barrier_complete(unsigned* bar, unsigned x, unsigned& nloc, unsigned& nx) {
    const unsigned G = gridDim.x * gridDim.y * gridDim.z;
    unsigned sum, cnt, mine, sp = 0u;
    for (;;) {
        sum = 0u; cnt = 0u; mine = 0u;
#pragma unroll
        for (unsigned j = 0; j < 16; ++j) { const unsigned c = xb_ld(&bar[XB_XCNT(j)]); sum += c; cnt += (c > 0u) ? 1u : 0u; mine = (j == x) ? c : mine; }
        if (sum == G) break;
        __builtin_amdgcn_s_sleep(1);
        if ((++sp & 255u) == 0u) { if (xb_ld(&bar[XB_TMO])) break; if (sp > XB_SPIN_CAP) { atomicAdd(&bar[XB_TMO], 1u); break; } }
    }
    nloc = mine > 0u ? mine : 1u; nx = cnt > 0u ? cnt : 1u;
}

__device__ __forceinline__ void xcd_barrier(const XcdBarrier& b) {
    asm volatile("s_waitcnt vmcnt(0)" ::: "memory");
    __syncthreads();
    if (threadIdx.x == 0) {
        unsigned* bar = b.bar;
        __builtin_amdgcn_s_waitcnt(0);
        unsigned nloc = b.st[0], nx = b.st[1];
        if (nloc == 0u) { xcd_barrier_complete(bar, b.x, nloc, nx); b.st[0] = nloc; b.st[1] = nx; }
        const unsigned old = xb_add(&bar[XB_XSUB(b.x)], 1u);
        const unsigned gen = old / nloc;
        if (old + 1u == (gen + 1u) * nloc) {
            __builtin_amdgcn_fence(__ATOMIC_RELEASE, "agent");
            asm volatile("s_waitcnt vmcnt(0)" ::: "memory");
            const unsigned og = xb_add(&bar[XB_TOP], 1u);
            const unsigned tg = og / nx;
            if (og + 1u == (tg + 1u) * nx) xb_add(&bar[XB_TOPGEN], 1u);
            else XB_SPIN(xb_ld(&bar[XB_TOPGEN]) == tg, bar);
            xb_add(&bar[XB_XGEN(b.x)], 1u);
            __builtin_amdgcn_fence(__ATOMIC_ACQUIRE, "agent");
            asm volatile("s_waitcnt vmcnt(0)" ::: "memory");
        } else {
            XB_SPIN(xb_ld(&bar[XB_XGEN(b.x)]) == gen, bar);
            __builtin_amdgcn_fence(__ATOMIC_ACQUIRE, "agent");
            asm volatile("s_waitcnt vmcnt(0)" ::: "memory");
        }
    }
    __syncthreads();
}
struct Frame {
    LAS unsigned char* lds;
    volatile LAS unsigned* MISC;
    gu32* ctl;
    int tid, lane, wave, vcu, G;
    GAS float* out; GAS unsigned char* ws;
};
#define WSP(T, off) ((T*)(F.ws + (off)))
#define OUTP(off) ((float*)(F.out + (off)))
#define UTHP ((bf16*)OUTP(O_YP))
constexpr int TAB_OFF = MISC_OFF + 256;
__device__ __forceinline__ const float* inp(const Frame& F, int k) {
    const unsigned long long v = ((const LAS unsigned long long*)(F.lds + TAB_OFF))[k];
    const unsigned lo = __builtin_amdgcn_readfirstlane((unsigned)v), hi = __builtin_amdgcn_readfirstlane((unsigned)(v >> 32));
    return (const float*)(const GAS float*)(((unsigned long long)hi << 32) | lo);
}
__device__ __forceinline__ float wave_sum(float v) {
#pragma unroll
    for (int o = 1; o < 64; o <<= 1) v += __shfl_xor(v, o);
    return v;
}
__device__ __forceinline__ float half_sum32(float v) {
#pragma unroll
    for (int o = 1; o < 32; o <<= 1) v += __shfl_xor(v, o);
    return v;
}
__device__ __forceinline__ float rowsum16(const float (&v)[16], int lane, int& rsel) {
    const bool b4 = (lane & 16) != 0, b3 = (lane & 8) != 0, b2 = (lane & 4) != 0, b1 = (lane & 2) != 0;
    float a[8], b[4], c2[2];
#pragma unroll
    for (int j = 0; j < 8; ++j) { const float t = __shfl_xor(b4 ? v[j] : v[j + 8], 16); a[j] = (b4 ? v[j + 8] : v[j]) + t; }
#pragma unroll
    for (int j = 0; j < 4; ++j) { const float t = __shfl_xor(b3 ? a[j] : a[j + 4], 8); b[j] = (b3 ? a[j + 4] : a[j]) + t; }
#pragma unroll
    for (int j = 0; j < 2; ++j) { const float t = __shfl_xor(b2 ? b[j] : b[j + 2], 4); c2[j] = (b2 ? b[j + 2] : b[j]) + t; }
    float d = (b1 ? c2[1] : c2[0]) + __shfl_xor(b1 ? c2[0] : c2[1], 2);
    d += __shfl_xor(d, 1);
    rsel = (b4 ? 8 : 0) + (b3 ? 4 : 0) + (b2 ? 2 : 0) + (b1 ? 1 : 0);
    return d;
}
__device__ __forceinline__ void tr_item(const float* W, int N, int K, int k0, int n0, const float* nw, bf16* dst, LAS float* scr, int lane) {
    float v[32];
    const int n = n0 + (lane & 31);
#pragma unroll
    for (int i = 0; i < 32; ++i) { const int kk = 2 * i + (lane >> 5); v[i] = (n < N) ? W[(size_t)(k0 + kk) * N + n] : 0.f; }
    if (nw) {
#pragma unroll
        for (int i = 0; i < 32; ++i) v[i] *= nw[k0 + 2 * i + (lane >> 5)];
    }
#pragma unroll
    for (int i = 0; i < 32; ++i) scr[(2 * i + (lane >> 5)) * 33 + (lane & 31)] = v[i];
    LDS_WAIT(); asm volatile("" ::: "memory");
    const int c = lane & 7;
#pragma unroll
    for (int j = 0; j < 4; ++j) { const int nn = (lane >> 3) + 8 * j; const LAS float* s = scr + (8 * c) * 33 + nn;
        v4u o; o.x = pk2(s[0 * 33], s[1 * 33]); o.y = pk2(s[2 * 33], s[3 * 33]); o.z = pk2(s[4 * 33], s[5 * 33]); o.w = pk2(s[6 * 33], s[7 * 33]);
        *(GAS v4u*)(dst + (size_t)nn * K + k0 + 8 * c) = o; }
    LDS_WAIT(); asm volatile("" ::: "memory");
}
constexpr int P0_I_GU = 16 * 88, P0_I_IN = 16 * 120, P0_I_OUT = 16 * 32, P0_NITEMS = 6 * P0_I_GU + P0_I_IN + P0_I_OUT, P0_ITEMS_FIRST = 2 * P0_I_GU;
__device__ __forceinline__ void p0_weight_items(Frame& F, int lo, int hi, int iw, int nw_) {
    LAS float* scr = (LAS float*)(F.lds + F.wave * 16384);
    const int lane = F.lane;
    constexpr int I_GU = P0_I_GU, I_DN = 44 * 32, I_IN = P0_I_IN;
    static_assert(I_DN == I_GU, "items");
    for (int it = lo + iw; it < hi; it += nw_) {
        int r = it;
        if (r < 6 * I_GU) {
            const int which = r / I_GU; r -= which * I_GU;
            const int ffn = which / 3, kind = which % 3;
            if (kind < 2) {
                const int kb = r / 88, nb = r % 88, n0 = 32 * nb, k0 = 64 * kb;
                const float* W = ffn ? (kind ? inp(F, 23) : inp(F, 22)) : (kind ? inp(F, 9) : inp(F, 8)); const float* nw = ffn ? inp(F, 21) : inp(F, 7);
                bf16* base = WSP(bf16, ffn ? WS_WGU2 : WS_WGU1);
                const int drow = 256 * (n0 >> 7) + (n0 & 127) + 128 * kind;
                tr_item(W, FF, 1024, k0, n0, nw, base + (size_t)drow * 1024, scr, lane);
            } else {
                const int kb = r / 32, nb = r % 32, n0 = 32 * nb, k0 = 64 * kb;
                const float* W = ffn ? inp(F, 24) : inp(F, 10);
                bf16* base = WSP(bf16, ffn ? WS_WD2 : WS_WD1);
                tr_item(W, 1024, FF, k0, n0, nullptr, base + (size_t)n0 * FF, scr, lane);
            }
            continue;
        }
        r -= 6 * I_GU;
        if (r < I_IN) { const int kb = r / 120, nb = r % 120, n0 = 32 * nb, k0 = 64 * kb;
            tr_item(inp(F, 12), NIN, 1024, k0, n0, inp(F, 11), WSP(bf16, WS_WIN) + (size_t)n0 * 1024, scr, lane); continue; }
        r -= I_IN;
        { const int kb = r / 32, nb = r % 32, n0 = 32 * nb, k0 = 64 * kb;
          tr_item(inp(F, 20), 1024, 1024, k0, n0, nullptr, WSP(bf16, WS_WOUT) + (size_t)n0 * 1024, scr, lane); }
    }
}
__device__ __forceinline__ void p0_prologue(Frame& F, int defer) {
    const int gw = F.vcu * NWAVES + F.wave, NGW = F.G * NWAVES, lane = F.lane;
    p0_weight_items(F, 0, defer ? P0_ITEMS_FIRST : P0_NITEMS, gw, NGW);
    bf16* HB = WSP(bf16, WS_HB); float* RS1 = WSP(float, WS_SS1); float* HX0 = WSP(float, WS_HX0);
    {
        const float* x0 = inp(F, 0); const float* xm = inp(F, 5); const float* xs = inp(F, 1);
#define ROWSRC(m) ((m) < MP ? x0 + (size_t)(m) * D : (m) < ROW_SMP ? xm + (size_t)((m) - ROW_META) * D : (m) < ROW_SMP + NSMP ? xs + (size_t)((m) - ROW_SMP) * D : nullptr)
        f32x4 nx[4];
        { const float* src = gw < M ? ROWSRC(gw) : nullptr;
#pragma unroll
          for (int j = 0; j < 4; ++j) nx[j] = src ? ((const GAS f32x4*)src)[lane + 64 * j] : (f32x4){0.f, 0.f, 0.f, 0.f}; }
        for (int m = gw; m < M; m += NGW) {
            f32x4 v[4]; float s = 0.f;
#pragma unroll
            for (int j = 0; j < 4; ++j) v[j] = nx[j];
            { const int mn = m + NGW; const float* src = mn < M ? ROWSRC(mn) : nullptr;
#pragma unroll
              for (int j = 0; j < 4; ++j) nx[j] = src ? ((const GAS f32x4*)src)[lane + 64 * j] : (f32x4){0.f, 0.f, 0.f, 0.f}; }
#pragma unroll
            for (int j = 0; j < 4; ++j) s += (v[j][0] * v[j][0] + v[j][1] * v[j][1]) + (v[j][2] * v[j][2] + v[j][3] * v[j][3]);
            s = wave_sum(s);
            GAS unsigned long long* o8 = (GAS unsigned long long*)(HB + (size_t)m * D) + lane;
#pragma unroll
            for (int j = 0; j < 4; ++j) o8[64 * j] = (unsigned long long)pk2(v[j][0], v[j][1]) | ((unsigned long long)pk2(v[j][2], v[j][3]) << 32);
            if (lane == 0) RS1[m] = 1.0f / sqrtf(s * (1.0f / 1024.0f) + EPS);
            if (m >= MP) {
#pragma unroll
                for (int j = 0; j < 4; ++j) ((GAS f32x4*)(HX0 + (size_t)(m - MP) * D))[lane + 64 * j] = v[j];
            }
        }
#undef ROWSRC
    }
    if (gw == 0) { float* LB = WSP(float, WS_LB); const float* l = inp(F, 6);
        for (int c = lane; c < 512; c += 64) LB[c] = 1.0f / (1.0f + __expf(l[512 + c] - l[c])); }
}
template <int ppu> __device__ __forceinline__ void fix_extra(Frame& F, int split, const float* slab, const float* RX, float* DX, bf16* HB, const float* SS, float* RSTD, float scale) {
    const int lane = F.lane;
    if (split) {
        LAS float* red = (LAS float*)F.lds;
        for (int lr = F.vcu; lr < 256; lr += F.G) {
            if (F.wave < 4) {
                const int j = F.wave;
                const float* sp = slab + (size_t)j * ppu * 65536 + (size_t)lr * 256 + 4 * lane; f32x4 sum = (f32x4){0.f, 0.f, 0.f, 0.f};
#pragma unroll
                for (int p = 0; p < ppu; ++p) sum = sum + *(const GAS f32x4*)(sp + (size_t)p * 65536);
                const f32x4 v = ((const GAS f32x4*)(RX + (size_t)lr * 1024))[lane + 64 * j] + sum * scale;
                const float ss = wave_sum((v[0] * v[0] + v[1] * v[1]) + (v[2] * v[2] + v[3] * v[3]));
                ((GAS f32x4*)(DX + (size_t)lr * 1024))[lane + 64 * j] = v;
                ((GAS unsigned long long*)(HB + (size_t)(MP + lr) * 1024))[lane + 64 * j] = (unsigned long long)pk2(v[0], v[1]) | ((unsigned long long)pk2(v[2], v[3]) << 32);
                if (lane == 0) red[j] = ss;
            }
            __syncthreads();
            if (F.tid == 0) RSTD[MP + lr] = 1.0f / sqrtf(((red[0] + red[1]) + (red[2] + red[3])) * (1.0f / 1024.0f) + EPS);
            __syncthreads();
        }
    }
    const int gt = F.vcu * (NWAVES * 64) + F.tid, NT = F.G * NWAVES * 64, nrows = split ? MP : M;
    for (int r = gt; r < nrows; r += NT) RSTD[r] = pg8::row_rstd(SS, r);
}
template <int ppu> __device__ __forceinline__ void p8_final(Frame& F, int split, const float* slab) {
    const int gw = F.vcu * NWAVES + F.wave, NGW = F.G * NWAVES, lane = F.lane;
    const float* SS4 = WSP(float, WS_SS4); const float* nf = inp(F, 25);
    f32x4 w[4];
#pragma unroll
    for (int j = 0; j < 4; ++j) w[j] = ((const GAS f32x4*)nf)[lane + 64 * j];
    for (int m = split ? MP + gw : gw; m < MP + NSMP; m += NGW) {
        if (m < MP) {
            float* p = OUTP(O_YP) + (size_t)m * D;
            const float rs = pg8::row_rstd(SS4, m);
#pragma unroll
            for (int j = 0; j < 4; ++j) { f32x4 v = ((const GAS f32x4*)p)[lane + 64 * j]; v = v * rs * w[j]; ((GAS f32x4*)p)[lane + 64 * j] = v; }
        } else {
            const int s = m - MP, lr = NMETA + s; const float* src = WSP(float, WS_HX) + (size_t)lr * D; float* dst = OUTP(O_YS) + (size_t)s * D;
            f32x4 v[4]; float ss = 0.f;
#pragma unroll
            for (int j = 0; j < 4; ++j) { v[j] = ((const GAS f32x4*)src)[lane + 64 * j];
                if (split) { const float* sp = slab + (size_t)j * ppu * 65536 + (size_t)lr * 256 + 4 * lane; f32x4 sum = (f32x4){0.f, 0.f, 0.f, 0.f};
#pragma unroll
                    for (int p = 0; p < ppu; ++p) sum = sum + *(const GAS f32x4*)(sp + (size_t)p * 65536);
                    v[j] = v[j] + sum * 0.5f; }
                ss += (v[j][0] * v[j][0] + v[j][1] * v[j][1]) + (v[j][2] * v[j][2] + v[j][3] * v[j][3]); }
            const float rs = split ? 1.0f / sqrtf(wave_sum(ss) * (1.0f / 1024.0f) + EPS) : pg8::row_rstd(SS4, ROW_SMP + s);
#pragma unroll
            for (int j = 0; j < 4; ++j) ((GAS f32x4*)dst)[lane + 64 * j] = v[j] * rs * w[j];
        }
    }
}
__device__ __forceinline__ int rowreg(int reg, int lane) { return (reg & 3) + 8 * (reg >> 2) + 4 * (lane >> 5); }
template <int K> __device__ __forceinline__ void mma32_ll(f32x16& acc, const LAS bf16* A, int lda, const LAS bf16* B, int ldb, int lane) {
    const LAS bf16* pa = A + (lane & 31) * lda + 8 * (lane >> 5); const LAS bf16* pb = B + (lane & 31) * ldb + 8 * (lane >> 5);
#pragma unroll
    for (int k0 = 0; k0 < K; k0 += 16) { const bf16x8 a = *(const LAS bf16x8*)(pa + k0); const bf16x8 b = *(const LAS bf16x8*)(pb + k0); acc = __builtin_amdgcn_mfma_f32_32x32x16_bf16(a, b, acc, 0, 0, 0); }
}
template <int K> __device__ __forceinline__ void mma32_lg(f32x16& acc, const LAS bf16* A, int lda, const bf16* Bg, int ldb, int lane) {
    const LAS bf16* pa = A + (lane & 31) * lda + 8 * (lane >> 5); const bf16* pb = Bg + (size_t)(lane & 31) * ldb + 8 * (lane >> 5);
#pragma unroll
    for (int kc = 0; kc < K; kc += 64) {
        bf16x8 b[4];
#pragma unroll
        for (int k = 0; k < 4; ++k) b[k] = *(const GAS bf16x8*)(pb + kc + 16 * k);
#pragma unroll
        for (int k = 0; k < 4; ++k) { const bf16x8 a = *(const LAS bf16x8*)(pa + kc + 16 * k); acc = __builtin_amdgcn_mfma_f32_32x32x16_bf16(a, b[k], acc, 0, 0, 0); }
        asm volatile("" ::: "memory");
    }
}
__device__ __forceinline__ void load_frags8(const bf16* Bg, int ldb, int lane, bf16x8 (&b)[8]) {
    const bf16* pb = Bg + (size_t)(lane & 31) * ldb + 8 * (lane >> 5);
#pragma unroll
    for (int k = 0; k < 8; ++k) b[k] = *(const GAS bf16x8*)(pb + 16 * k);
}
__device__ __forceinline__ void mma32_lf8(f32x16& acc, const LAS bf16* A, int lda, const bf16x8 (&b)[8], int lane) {
    const LAS bf16* pa = A + (lane & 31) * lda + 8 * (lane >> 5);
#pragma unroll
    for (int k = 0; k < 8; ++k) { const bf16x8 a = *(const LAS bf16x8*)(pa + 16 * k); acc = __builtin_amdgcn_mfma_f32_32x32x16_bf16(a, b[k], acc, 0, 0, 0); }
}
#define ZERO16 ((f32x16){0.f,0.f,0.f,0.f,0.f,0.f,0.f,0.f,0.f,0.f,0.f,0.f,0.f,0.f,0.f,0.f})

struct HgP { int rowbase, h, nvalid, ent, eidx; };
__device__ __forceinline__ HgP hg_params(int i) {
    HgP p;
    if (i < 1024) { const int b = i >> 7, h = (i >> 5) & 3, c = i & 31; p.rowbase = b * SEQ + c * CH; p.h = h; p.nvalid = CH; p.ent = (b * 4 + h) * 32 + c; p.eidx = b * 32 + c; }
    else { const int h = i - 1024; p.rowbase = ROW_META; p.h = h; p.nvalid = NMETA; p.ent = 1024 + h; p.eidx = 256; }
    return p;
}
struct HgRaw { f32x4 fz[4]; v4u vb[2]; v4u qz[2]; v4u gb[2]; };
template <int PASS> __device__ __forceinline__ void hg_load(Frame& F, const HgP& p, HgRaw& r) {
    const int tid = F.tid;
    const float* FZ = WSP(float, WS_FZ) + (size_t)p.rowbase * 512 + 128 * p.h;
#pragma unroll
    for (int i = 0; i < 4; ++i) { const int idx = tid + 512 * i; r.fz[i] = *(const GAS f32x4*)(FZ + (size_t)(idx >> 5) * 512 + (idx & 31) * 4); }
    const bf16* VB = WSP(bf16, WS_VB) + (size_t)p.rowbase * 512 + 128 * p.h;
#pragma unroll
    for (int i = 0; i < 2; ++i) { const int idx = tid + 512 * i; r.vb[i] = *(const GAS v4u*)(VB + (size_t)(idx >> 4) * 512 + (idx & 15) * 8); }
    if (PASS == 3) { const bf16* QZ = WSP(bf16, WS_QZ) + (size_t)p.rowbase * 1024 + 128 * p.h;
#pragma unroll
        for (int i = 0; i < 2; ++i) { const int idx = tid + 512 * i; r.qz[i] = *(const GAS v4u*)(QZ + (size_t)(idx >> 4) * 1024 + (idx & 15) * 8); }
        const bf16* GB = WSP(bf16, WS_GB) + (size_t)p.rowbase * 512 + 128 * p.h;
#pragma unroll
        for (int i = 0; i < 2; ++i) { const int idx = tid + 512 * i; r.gb[i] = *(const GAS v4u*)(GB + (size_t)(idx >> 4) * 512 + (idx & 15) * 8); } }
}
template <int PASS> __device__ __forceinline__ void hgrn_item(Frame& F, const HgP p, HgRaw& raw, bool has_next, const HgP pn) {
    LAS unsigned char* L = F.lds;
    LAS float* TOT = (LAS float*)L;
    LAS float* FZL = (LAS float*)(L + 2048);
    LAS bf16* VL = (LAS bf16*)(L + 35840);
    LAS bf16* QN = (LAS bf16*)(L + 53248);
    LAS bf16* KN = (LAS bf16*)(L + 70656);
    LAS bf16* VT = (LAS bf16*)(L + 88064);
    LAS bf16* KT = (LAS bf16*)(L + 106496);
    LAS bf16* PP = (LAS bf16*)(L + 106496);
    LAS float* PART = (LAS float*)(L + 124928);
    LAS float* RS = (LAS float*)(L + 125952);
    const int tid = F.tid, lane = F.lane, w = F.wave, c = tid & 127, rg = tid >> 7;
    const int rowbase = p.rowbase, h = p.h;
#pragma unroll
    for (int i = 0; i < 4; ++i) { const int idx = tid + 512 * i; *(LAS f32x4*)(FZL + (idx >> 5) * 132 + (idx & 31) * 4) = raw.fz[i]; }
#pragma unroll
    for (int i = 0; i < 2; ++i) { const int idx = tid + 512 * i; *(LAS v4u*)(VL + (idx >> 4) * 136 + (idx & 15) * 8) = raw.vb[i]; if (PASS == 3) *(LAS v4u*)(QN + (idx >> 4) * 136 + (idx & 15) * 8) = raw.qz[i]; }
    v4u gbr[2]; if (PASS == 3) { gbr[0] = raw.gb[0]; gbr[1] = raw.gb[1]; }
    if (has_next) hg_load<PASS>(F, pn, raw);
    const float lbc = WSP(float, WS_LB)[128 * h + c];
    __syncthreads();
    float bl[16], kk[16], run = 0.f;
#pragma unroll
    for (int i = 0; i < 16; ++i) {
        const int t = rg * 16 + i; const float fz = FZL[t * 132 + c];
        const float sg = sigm(fz), f = lbc + (1.0f - lbc) * sg; float lf = __logf(f), k = (1.0f - lbc) * (1.0f - sg);
        if (t >= p.nvalid) { lf = 0.f; k = 0.f; }
        run += lf; bl[i] = run; kk[i] = k;
    }
    TOT[rg * 128 + c] = run;
    __syncthreads();
    const float t0 = TOT[c], t1 = TOT[128 + c], t2 = TOT[256 + c], t3 = TOT[384 + c];
    const float pre = rg == 0 ? 0.f : rg == 1 ? t0 : rg == 2 ? t0 + t1 : (t0 + t1) + t2;
    const float r = t0 + t1, blast = (t0 + t1) + (t2 + t3);
    unsigned pvv[8];
#pragma unroll
    for (int i = 0; i < 16; i += 2) pvv[i >> 1] = (unsigned)VL[(rg * 16 + i) * 136 + c] | ((unsigned)VL[(rg * 16 + i + 1) * 136 + c] << 16);
    *(LAS v4u*)(VT + c * 72 + rg * 16) = (v4u){pvv[0], pvv[1], pvv[2], pvv[3]}; *(LAS v4u*)(VT + c * 72 + rg * 16 + 8) = (v4u){pvv[4], pvv[5], pvv[6], pvv[7]};
    if (PASS == 1) {
        unsigned pkk[8];
#pragma unroll
        for (int i = 0; i < 16; i += 2) pkk[i >> 1] = pk2(kk[i] * __expf(r - (pre + bl[i])), kk[i + 1] * __expf(r - (pre + bl[i + 1])));
        *(LAS v4u*)(KT + c * 72 + rg * 16) = (v4u){pkk[0], pkk[1], pkk[2], pkk[3]}; *(LAS v4u*)(KT + c * 72 + rg * 16 + 8) = (v4u){pkk[4], pkk[5], pkk[6], pkk[7]};
        if (rg == 0) { WSP(float, WS_ER)[(size_t)p.eidx * 512 + 128 * h + c] = __expf(r); WSP(float, WS_EL)[(size_t)p.eidx * 512 + 128 * h + c] = __expf(blast - r); }
        __syncthreads();
        bf16* UT = UTHP + (size_t)p.ent * UTH_ENT;
        LAS bf16* OUT = (LAS bf16*)(L + 2048);
        const int vt = w >> 1;
#pragma unroll
        for (int q = 0; q < 2; ++q) {
            const int kt = (w & 1) * 2 + q;
            f32x16 acc = ZERO16;
            mma32_ll<64>(acc, VT + vt * 32 * 72, 72, KT + kt * 32 * 72, 72, lane);
#pragma unroll
            for (int reg = 0; reg < 16; ++reg) OUT[(vt * 32 + rowreg(reg, lane)) * 136 + kt * 32 + (lane & 31)] = (bf16)f2bf(acc[reg]);
        }
        __syncthreads();
#pragma unroll
        for (int i = 0; i < 4; ++i) { const int idx = tid + 512 * i, row = idx >> 4, pc = idx & 15; *(GAS v4u*)(UT + (size_t)row * 128 + pc * 8) = *(const LAS v4u*)(OUT + row * 136 + pc * 8); }
        __syncthreads();
    } else {
#pragma unroll
        for (int i = 0; i < 2; ++i) { const int idx = tid + 512 * i; *(LAS v4u*)((LAS bf16*)(L + 2048) + (idx >> 4) * 136 + (idx & 15) * 8) = gbr[i]; }
#pragma unroll
        for (int i = 0; i < 16; ++i) {
            const int t = rg * 16 + i; const float b = pre + bl[i];
            QN[t * 136 + c] = (bf16)f2bf(bf2f(QN[t * 136 + c]) * __expf(b - r));
            KN[t * 136 + c] = (bf16)f2bf(kk[i] * __expf(r - b));
        }
        __syncthreads();
        bf16x8 sfr[8];
        load_frags8(UTHP + (size_t)p.ent * UTH_ENT + (size_t)(w & 3) * 32 * 128, 128, lane, sfr);
        if (w < 4) {
            const int tm = w >> 1, sn = w & 1;
            f32x16 acc = ZERO16;
            if (!(tm == 0 && sn == 1)) mma32_ll<128>(acc, QN + tm * 32 * 136, 136, KN + sn * 32 * 136, 136, lane);
#pragma unroll
            for (int reg = 0; reg < 16; ++reg) { const int t = tm * 32 + rowreg(reg, lane), s = sn * 32 + (lane & 31);
                PP[t * 72 + s] = (s <= t) ? (bf16)f2bf(acc[reg]) : (bf16)0; }
        }
        __syncthreads();
        const int tm = w >> 2, vn = w & 3;
        f32x16 acc = ZERO16;
        mma32_ll<64>(acc, PP + tm * 32 * 72, 72, VT + vn * 32 * 72, 72, lane);
        mma32_lf8(acc, QN + tm * 32 * 136, 136, sfr, lane);
        { float sqv[16]; int rsel;
#pragma unroll
          for (int reg = 0; reg < 16; ++reg) sqv[reg] = acc[reg] * acc[reg];
          const float sq = rowsum16(sqv, lane, rsel); if ((lane & 1) == 0) PART[(tm * 32 + rowreg(rsel, lane)) * 4 + vn] = sq; }
        __syncthreads();
        if (tid < 64) RS[tid] = 1.0f / sqrtf(((PART[tid * 4] + PART[tid * 4 + 1]) + (PART[tid * 4 + 2] + PART[tid * 4 + 3])) * (1.0f / 128.0f) + EPS);
        __syncthreads();
        bf16* QZ = WSP(bf16, WS_QZ);
        LAS bf16* OUT = (LAS bf16*)(L + 2048);
#pragma unroll
        for (int reg = 0; reg < 16; ++reg) { const int t = tm * 32 + rowreg(reg, lane), v = vn * 32 + (lane & 31);
            OUT[t * 136 + v] = (bf16)f2bf(acc[reg] * RS[t] * bf2f(OUT[t * 136 + v])); }
        __syncthreads();
#pragma unroll
        for (int i = 0; i < 2; ++i) { const int idx = tid + 512 * i, row = idx >> 4, pc = idx & 15; *(GAS v4u*)(QZ + (size_t)(rowbase + row) * 1024 + 128 * h + pc * 8) = *(const LAS v4u*)(OUT + row * 136 + pc * 8); }
        __syncthreads();
    }
}

struct MbP { int rowbase, g, nvalid, ent0, estride; const bf16* prev; };
__device__ __forceinline__ bool mb_valid(int o, bool with_meta) { return o < 512 || (with_meta && o >= 516 && o < 518); }
__device__ __forceinline__ MbP mb_params(Frame& F, int j) {
    MbP p; const bf16* XBC = WSP(bf16, WS_XBC);
    if (j < 512) { const int b = j >> 6, g = (j >> 5) & 1, c = j & 31, rb = b * SEQ + c * CH; p.rowbase = rb; p.g = g; p.nvalid = CH; p.ent0 = (b * 8 + 4 * g) * 32 + c; p.estride = 32;
        p.prev = c > 0 ? XBC + (size_t)(rb - 3) * 1024 : XBC + (size_t)(ROW_META + 13) * 1024; }
    else { const int g = j - 516; p.rowbase = ROW_META; p.g = g; p.nvalid = NMETA; p.ent0 = 2048 + 4 * g; p.estride = 1; p.prev = nullptr; }
    return p;
}
struct MbRaw { v4u rx[4]; v4u halo; float dt; };
__device__ __forceinline__ int mb_bccol(int g, int pc) { return pc < 16 ? 512 + 128 * g + pc * 8 : 768 + 128 * g + (pc - 16) * 8; }
template <int PASS> __device__ __forceinline__ void mb_load(Frame& F, const MbP& p, MbRaw& r) {
    const int tid = F.tid; const bf16* X = WSP(bf16, WS_XBC) + (size_t)p.rowbase * 1024;
#pragma unroll
    for (int i = 0; i < 4; ++i) { const int idx = tid + 512 * i, row = idx >> 5, pc = idx & 31;
        r.rx[i] = *(const GAS v4u*)(X + (size_t)row * 1024 + 256 * p.g + pc * 8); }
    r.halo = (v4u){0u, 0u, 0u, 0u};
    if (p.prev && tid < 192) { const int hr = tid >> 6, pc = tid & 63; r.halo = *(const GAS v4u*)(p.prev + (size_t)hr * 1024 + (pc < 32 ? 256 * p.g + pc * 8 : mb_bccol(p.g, pc - 32))); }
    r.dt = 0.f;
    if (tid < 256) { const int t = tid & 63; if (t < p.nvalid) r.dt = WSP(float, WS_DT)[(size_t)(p.rowbase + t) * 8 + 4 * p.g + (tid >> 6)]; }
}
template <int PASS> __device__ __forceinline__ void mamba_item(Frame& F, const MbP p, MbRaw& raw, bool has_next, const MbP pn) {
    LAS unsigned char* L = F.lds;
    LAS float* CUM = (LAS float*)L;
    LAS float* DTV = (LAS float*)(L + 1024);
    LAS bf16* XT = (LAS bf16*)(L + 2048);
    LAS bf16* BT = (LAS bf16*)(L + 38912);
    LAS bf16* BN = (LAS bf16*)(L + 38912);
    LAS bf16* CN = (LAS bf16*)(L + 56320);
    LAS bf16* RAW = (LAS bf16*)(L + 73728);
    const int tid = F.tid, lane = F.lane, w = F.wave, g = p.g, rowbase = p.rowbase;
    if (w < 4) {
        const int head = 4 * g + w;
        const float dt = raw.dt;
        const float A = -__expf(inp(F, 17)[head]);
        float cum = dt * A;
#pragma unroll
        for (int o = 1; o < 64; o <<= 1) { const float n = __shfl_up(cum, o); if (lane >= o) cum += n; }
        const float last = __builtin_bit_cast(float, __builtin_amdgcn_readlane(__builtin_bit_cast(int, cum), 63));
        if (PASS == 1) { CUM[w * 64 + lane] = dt * __expf(last - cum); if (lane == 0) WSP(float, WS_DCY)[p.ent0 + w * p.estride] = __expf(last); }
        else { CUM[w * 64 + lane] = cum; DTV[w * 64 + lane] = dt; }
    }
#pragma unroll
    for (int i = 0; i < 4; ++i) { const int idx = tid + 512 * i; *(LAS v4u*)(RAW + ((idx >> 5) + 3) * 256 + (idx & 31) * 8) = raw.rx[i]; }
    if (tid < 192 && (tid & 63) < 32) *(LAS v4u*)(RAW + (tid >> 6) * 256 + (tid & 63) * 8) = raw.halo;
    __syncthreads();
    v4u rbc[4];
    {   const bf16* X = WSP(bf16, WS_XBC) + (size_t)rowbase * 1024;
#pragma unroll
        for (int i = 0; i < 4; ++i) { const int idx = tid + 512 * i, row = idx >> 5, pc = idx & 31;
            rbc[i] = (PASS == 3 || pc < 16) ? *(const GAS v4u*)(X + (size_t)row * 1024 + mb_bccol(g, pc)) : (v4u){0u, 0u, 0u, 0u}; } }
    const int ch = tid & 255, half = tid >> 8;
    const float* cw = inp(F, 14); const float* cbp = inp(F, 15);
    {
        const int col = 256 * g + ch;
        const float w0 = cw[col], w1 = cw[1024 + col], w2 = cw[2048 + col], w3 = cw[3072 + col], cb = cbp[col];
        float r0 = bf2f(RAW[(half * 32 + 0) * 256 + ch]), r1 = bf2f(RAW[(half * 32 + 1) * 256 + ch]), r2 = bf2f(RAW[(half * 32 + 2) * 256 + ch]);
        unsigned pk[16];
#pragma unroll
        for (int i = 0; i < 32; i += 2) {
            const int t = half * 32 + i;
            const float r3 = bf2f(RAW[(t + 3) * 256 + ch]), r4 = bf2f(RAW[(t + 4) * 256 + ch]);
            float a0 = silu(cb + w0 * r0 + w1 * r1 + w2 * r2 + w3 * r3), a1 = silu(cb + w0 * r1 + w1 * r2 + w2 * r3 + w3 * r4);
            if (PASS == 1) { a0 *= CUM[(ch >> 6) * 64 + t]; a1 *= CUM[(ch >> 6) * 64 + t + 1]; }
            pk[i >> 1] = pk2(a0, a1); r0 = r2; r1 = r3; r2 = r4;
        }
        LAS v4u* d = (LAS v4u*)(XT + ch * 72 + half * 32);
        d[0] = (v4u){pk[0], pk[1], pk[2], pk[3]}; d[1] = (v4u){pk[4], pk[5], pk[6], pk[7]}; d[2] = (v4u){pk[8], pk[9], pk[10], pk[11]}; d[3] = (v4u){pk[12], pk[13], pk[14], pk[15]};
    }
    __syncthreads();
#pragma unroll
    for (int i = 0; i < 4; ++i) { const int idx = tid + 512 * i; *(LAS v4u*)(RAW + ((idx >> 5) + 3) * 256 + (idx & 31) * 8) = rbc[i]; }
    if (tid < 192 && (tid & 63) >= 32) *(LAS v4u*)(RAW + (tid >> 6) * 256 + ((tid & 63) - 32) * 8) = raw.halo;
    if (has_next) mb_load<PASS>(F, pn, raw);
    __syncthreads();
    if (PASS == 3 || ch < 128) {
        const int col = ch < 128 ? 512 + 128 * g + ch : 768 + 128 * g + (ch - 128);
        const float w0 = cw[col], w1 = cw[1024 + col], w2 = cw[2048 + col], w3 = cw[3072 + col], cb = cbp[col];
        float r0 = bf2f(RAW[(half * 32 + 0) * 256 + ch]), r1 = bf2f(RAW[(half * 32 + 1) * 256 + ch]), r2 = bf2f(RAW[(half * 32 + 2) * 256 + ch]);
        unsigned pk[16];
#pragma unroll
        for (int i = 0; i < 32; i += 2) {
            const int t = half * 32 + i;
            const float r3 = bf2f(RAW[(t + 3) * 256 + ch]), r4 = bf2f(RAW[(t + 4) * 256 + ch]);
            const float a0 = silu(cb + w0 * r0 + w1 * r1 + w2 * r2 + w3 * r3), a1 = silu(cb + w0 * r1 + w1 * r2 + w2 * r3 + w3 * r4);
            if (PASS == 1) pk[i >> 1] = pk2(a0, a1);
            else { LAS bf16* dst = ch < 128 ? BN + ch : CN + (ch - 128); dst[t * 136] = (bf16)f2bf(a0); dst[(t + 1) * 136] = (bf16)f2bf(a1); }
            r0 = r2; r1 = r3; r2 = r4;
        }
        if (PASS == 1) { LAS v4u* d = (LAS v4u*)(BT + ch * 72 + half * 32);
            d[0] = (v4u){pk[0], pk[1], pk[2], pk[3]}; d[1] = (v4u){pk[4], pk[5], pk[6], pk[7]}; d[2] = (v4u){pk[8], pk[9], pk[10], pk[11]}; d[3] = (v4u){pk[12], pk[13], pk[14], pk[15]}; }
    }
    __syncthreads();
    bf16* UM = WSP(bf16, WS_UM);
    if (PASS == 1) {
        LAS bf16* OUT = (LAS bf16*)(L + 73728);
#pragma unroll
        for (int r = 0; r < 2; ++r) {
            const int hl = w >> 2, hd = 2 * r + hl, pt = (w >> 1) & 1;
#pragma unroll
            for (int q = 0; q < 2; ++q) {
                const int nt = (w & 1) * 2 + q;
                f32x16 acc = ZERO16;
                mma32_ll<64>(acc, XT + (hd * 64 + pt * 32) * 72, 72, BT + nt * 32 * 72, 72, lane);
#pragma unroll
                for (int reg = 0; reg < 16; ++reg) OUT[(hl * 64 + pt * 32 + rowreg(reg, lane)) * 136 + nt * 32 + (lane & 31)] = (bf16)f2bf(acc[reg]);
            }
            __syncthreads();
#pragma unroll
            for (int i = 0; i < 4; ++i) { const int idx = tid + 512 * i, hh = idx >> 10, row = (idx >> 4) & 63, pc = idx & 15;
                *(GAS v4u*)(UM + (size_t)(p.ent0 + (2 * r + hh) * p.estride) * UM_ENT + (size_t)row * 128 + pc * 8) = *(const LAS v4u*)(OUT + (hh * 64 + row) * 136 + pc * 8); }
            __syncthreads();
        }
    } else {
        LAS float* CB = (LAS float*)(L + 73728);
        LAS bf16* WW = (LAS bf16*)(L + 90624);
        LAS float* PART = (LAS float*)(L + 127488);
        LAS float* RS = (LAS float*)(L + 129536);
        bf16x8 hfr[8];
        load_frags8(UM + (size_t)(p.ent0 + (w >> 1) * p.estride) * UM_ENT + (size_t)(w & 1) * 32 * 128, 128, lane, hfr);
        v4u zr[4];
        { const bf16* Zg = WSP(bf16, WS_QZ) + (size_t)rowbase * 1024 + 512 + 256 * g;
#pragma unroll
          for (int i = 0; i < 4; ++i) { const int idx = tid + 512 * i; zr[i] = *(const GAS v4u*)(Zg + (size_t)(idx >> 5) * 1024 + (idx & 31) * 8); } }
        if (w < 4) {
            const int tm = w >> 1, sn = w & 1;
            if (!(tm == 0 && sn == 1)) {
                f32x16 acc = ZERO16;
                mma32_ll<128>(acc, CN + tm * 32 * 136, 136, BN + sn * 32 * 136, 136, lane);
#pragma unroll
                for (int reg = 0; reg < 16; ++reg) CB[(tm * 32 + rowreg(reg, lane)) * 66 + sn * 32 + (lane & 31)] = acc[reg];
            }
        }
        __syncthreads();
        {
            const int hd = tid >> 7, rem = tid & 127, t = rem >> 1, s0 = (rem & 1) * 32;
            const float ct = CUM[hd * 64 + t];
            unsigned pw[16];
#pragma unroll
            for (int j = 0; j < 32; j += 2) {
                const int s = s0 + j;
                const float a = (s <= t) ? CB[t * 66 + s] * __expf(ct - CUM[hd * 64 + s]) * DTV[hd * 64 + s] : 0.f;
                const float b = (s + 1 <= t) ? CB[t * 66 + s + 1] * __expf(ct - CUM[hd * 64 + s + 1]) * DTV[hd * 64 + s + 1] : 0.f;
                pw[j >> 1] = pk2(a, b);
            }
            __syncthreads();
#pragma unroll
            for (int i = 0; i < 4; ++i) { const int idx = tid + 512 * i, zt = idx >> 5, pc = idx & 31;
                *(LAS v4u*)((zt < 32 ? (LAS bf16*)(L + 38912) + zt * 264 : (LAS bf16*)(L + 73728) + (zt - 32) * 264) + pc * 8) = zr[i]; }
            LAS v4u* d = (LAS v4u*)(WW + (hd * 64 + t) * 72 + s0);
            d[0] = (v4u){pw[0], pw[1], pw[2], pw[3]}; d[1] = (v4u){pw[4], pw[5], pw[6], pw[7]}; d[2] = (v4u){pw[8], pw[9], pw[10], pw[11]}; d[3] = (v4u){pw[12], pw[13], pw[14], pw[15]};
        }
        __syncthreads();
        const int hd = w >> 1, pnn = w & 1, head = 4 * g + hd;
        const float Dk = inp(F, 18)[head];
        bf16* QZ = WSP(bf16, WS_QZ);
        const int chn = hd * 64 + pnn * 32 + (lane & 31);
        unsigned yzp[2][8];
#pragma unroll
        for (int tm = 0; tm < 2; ++tm) {
            const LAS bf16* ZL = tm == 0 ? (const LAS bf16*)(L + 38912) : (const LAS bf16*)(L + 73728);
            float sqv[16];
            f32x16 acc = ZERO16;
            mma32_lf8(acc, CN + tm * 32 * 136, 136, hfr, lane);
#pragma unroll
            for (int reg = 0; reg < 16; ++reg) acc[reg] *= __expf(CUM[hd * 64 + tm * 32 + rowreg(reg, lane)]);
            mma32_ll<64>(acc, WW + (hd * 64 + tm * 32) * 72, 72, XT + (hd * 64 + pnn * 32) * 72, 72, lane);
#pragma unroll
            for (int reg = 0; reg < 16; ++reg) {
                const int t = tm * 32 + rowreg(reg, lane);
                const float y = acc[reg] + Dk * bf2f(XT[chn * 72 + t]);
                const float v = y * bf2f(ZL[rowreg(reg, lane) * 264 + chn]);
                if (reg & 1) yzp[tm][reg >> 1] |= f2bf(v) << 16; else yzp[tm][reg >> 1] = f2bf(v);
                sqv[reg] = v * v;
            }
            { int rsel; const float sq = rowsum16(sqv, lane, rsel); if ((lane & 1) == 0) PART[(tm * 32 + rowreg(rsel, lane)) * 8 + w] = sq; }
            asm volatile("" ::: "memory");
        }
        __syncthreads();
        if (tid < 64) { float s = 0.f;
#pragma unroll
            for (int j = 0; j < 8; ++j) s += PART[tid * 8 + j];
            RS[tid] = 1.0f / sqrtf(s * (1.0f / 256.0f) + EPS); }
        __syncthreads();
        const float nw = inp(F, 19)[256 * g + chn];
        LAS bf16* OUT = (LAS bf16*)(L + 2048);
#pragma unroll
        for (int tm = 0; tm < 2; ++tm)
#pragma unroll
            for (int reg = 0; reg < 16; ++reg) { const int t = tm * 32 + rowreg(reg, lane);
                const float v = bf2f((unsigned short)((reg & 1) ? (yzp[tm][reg >> 1] >> 16) : (yzp[tm][reg >> 1] & 0xffffu)));
                OUT[t * 264 + chn] = (bf16)f2bf(v * RS[t] * nw); }
        __syncthreads();
#pragma unroll
        for (int i = 0; i < 4; ++i) { const int idx = tid + 512 * i, row = idx >> 5, pc = idx & 31; *(GAS v4u*)(QZ + (size_t)(rowbase + row) * 1024 + 512 + 256 * g + pc * 8) = *(const LAS v4u*)(OUT + row * 264 + pc * 8); }
        __syncthreads();
    }
}
__device__ __forceinline__ void unpack8(const v4u u, float (&f)[8]) {
    f[0] = bf2f((unsigned short)(u.x & 0xffffu)); f[1] = bf2f((unsigned short)(u.x >> 16)); f[2] = bf2f((unsigned short)(u.y & 0xffffu)); f[3] = bf2f((unsigned short)(u.y >> 16));
    f[4] = bf2f((unsigned short)(u.z & 0xffffu)); f[5] = bf2f((unsigned short)(u.z >> 16)); f[6] = bf2f((unsigned short)(u.w & 0xffffu)); f[7] = bf2f((unsigned short)(u.w >> 16));
}
__device__ __forceinline__ void p4b_scan(Frame& F) {
    const int gt = F.vcu * (NWAVES * 64) + F.tid, NT = F.G * NWAVES * 64;
    const float* ER = WSP(float, WS_ER); const float* EL = WSP(float, WS_EL); const float* DCY = WSP(float, WS_DCY);
    for (int idx = gt; idx < 131072; idx += NT) {
        float S[8];
#pragma unroll
        for (int j = 0; j < 8; ++j) S[j] = 0.f;
        if (idx < 65536) {
            const int bh = idx >> 11, rem = idx & 2047, v = rem >> 4, kd8 = (rem & 15) * 8, b = bh >> 2, h = bh & 3;
            bf16* UTH = UTHP + (size_t)v * 128 + kd8;
            {
                float uu[8]; unpack8(*(const GAS v4u*)(UTH + (size_t)(1024 + h) * UTH_ENT), uu);
                const float* el = EL + (size_t)256 * 512 + 128 * h + kd8;
#pragma unroll
                for (int j = 0; j < 8; ++j) S[j] = el[j] * uu[j];
            }
            for (int c0 = 0; c0 < NCH; c0 += 4) {
                v4u u[4]; f32x4 er[4][2], el[4][2];
#pragma unroll
                for (int q = 0; q < 4; ++q) { const size_t e = (size_t)(b * 32 + c0 + q);
                    u[q] = *(const GAS v4u*)(UTH + (size_t)(bh * 32 + c0 + q) * UTH_ENT);
                    er[q][0] = *(const GAS f32x4*)(ER + e * 512 + 128 * h + kd8); er[q][1] = *(const GAS f32x4*)(ER + e * 512 + 128 * h + kd8 + 4);
                    el[q][0] = *(const GAS f32x4*)(EL + e * 512 + 128 * h + kd8); el[q][1] = *(const GAS f32x4*)(EL + e * 512 + 128 * h + kd8 + 4); }
#pragma unroll
                for (int q = 0; q < 4; ++q) { float uu[8], sp[8]; unpack8(u[q], uu);
#pragma unroll
                    for (int j = 0; j < 8; ++j) { sp[j] = er[q][j >> 2][j & 3] * S[j]; S[j] = el[q][j >> 2][j & 3] * (sp[j] + uu[j]); }
                    *(GAS v4u*)(UTH + (size_t)(bh * 32 + c0 + q) * UTH_ENT) = (v4u){pk2(sp[0], sp[1]), pk2(sp[2], sp[3]), pk2(sp[4], sp[5]), pk2(sp[6], sp[7])}; }
            }
            float* o = OUTP(O_HGP) + ((size_t)bh * 128 + kd8) * 128 + v;
#pragma unroll
            for (int j = 0; j < 8; ++j) o[(size_t)j * 128] = S[j];
        } else {
            const int i2 = idx - 65536, bhd = i2 >> 10, rem = i2 & 1023, p_ = rem >> 4, n8 = (rem & 15) * 8, head = bhd & 7;
            bf16* UM = WSP(bf16, WS_UM) + (size_t)p_ * 128 + n8;
            {   float uu[8]; unpack8(*(const GAS v4u*)(UM + (size_t)(2048 + head) * UM_ENT), uu);
#pragma unroll
                for (int j = 0; j < 8; ++j) S[j] = uu[j]; }
            for (int c0 = 0; c0 < NCH; c0 += 4) {
                v4u u[4]; float d[4];
#pragma unroll
                for (int q = 0; q < 4; ++q) { u[q] = *(const GAS v4u*)(UM + (size_t)(bhd * 32 + c0 + q) * UM_ENT); d[q] = DCY[bhd * 32 + c0 + q]; }
#pragma unroll
                for (int q = 0; q < 4; ++q) { float uu[8], sp[8]; unpack8(u[q], uu);
#pragma unroll
                    for (int j = 0; j < 8; ++j) { sp[j] = S[j]; S[j] = d[q] * S[j] + uu[j]; }
                    *(GAS v4u*)(UM + (size_t)(bhd * 32 + c0 + q) * UM_ENT) = (v4u){pk2(sp[0], sp[1]), pk2(sp[2], sp[3]), pk2(sp[4], sp[5]), pk2(sp[6], sp[7])}; }
            }
            float* o = OUTP(O_SSP) + ((size_t)bhd * 64 + p_) * 128 + n8;
            *(GAS f32x4*)o = (f32x4){S[0], S[1], S[2], S[3]}; *(GAS f32x4*)(o + 4) = (f32x4){S[4], S[5], S[6], S[7]};
        }
    }
}
__device__ __forceinline__ void hgrn_decode(Frame& F, int smp, int h) {
    LAS float* OS = (LAS float*)F.lds;
    LAS float* RED = (LAS float*)(F.lds + 8192);
    const int tid = F.tid, row = ROW_SMP + smp, v4 = (tid & 31) * 4, kg = tid >> 5;
    const float* FZ = WSP(float, WS_FZ); const bf16* VB = WSP(bf16, WS_VB); bf16* QZ = WSP(bf16, WS_QZ); const float* LB = WSP(float, WS_LB);
    const float* Sin = inp(F, 2) + (size_t)(smp * 4 + h) * 16384; float* Sout = OUTP(O_HGS) + (size_t)(smp * 4 + h) * 16384;
    f32x4 vv; { const unsigned long long raw = *(const GAS unsigned long long*)(VB + (size_t)row * 512 + 128 * h + v4);
        vv = (f32x4){bf2f((unsigned short)raw), bf2f((unsigned short)(raw >> 16)), bf2f((unsigned short)(raw >> 32)), bf2f((unsigned short)(raw >> 48))}; }
    f32x4 o = (f32x4){0.f, 0.f, 0.f, 0.f};
    f32x4 st[8]; float fzv[8], lbv[8], qv[8];
#pragma unroll
    for (int j = 0; j < 8; ++j) { const int kd = kg * 8 + j;
        st[j] = *(const GAS f32x4*)(Sin + (size_t)kd * 128 + v4);
        fzv[j] = FZ[(size_t)row * 512 + 128 * h + kd]; lbv[j] = LB[128 * h + kd]; qv[j] = bf2f(QZ[(size_t)row * 1024 + 128 * h + kd]); }
#pragma unroll
    for (int j = 0; j < 8; ++j) {
        const int kd = kg * 8 + j;
        const float sg = sigm(fzv[j]), f = lbv[j] + (1.0f - lbv[j]) * sg, k = (1.0f - lbv[j]) * (1.0f - sg);
        const f32x4 sn = st[j] * f + vv * k;
        *(GAS f32x4*)(Sout + (size_t)kd * 128 + v4) = sn;
        o = o + sn * qv[j];
    }
    *(LAS f32x4*)(OS + kg * 128 + v4) = o;
    __syncthreads();
    float ov = 0.f;
    if (tid < 128) {
#pragma unroll
        for (int j = 0; j < 16; ++j) ov += OS[j * 128 + tid];
        const float sq = wave_sum(ov * ov); if (F.lane == 0) RED[F.wave] = sq;
    }
    __syncthreads();
    if (tid < 128) {
        const float rs = 1.0f / sqrtf((RED[0] + RED[1]) * (1.0f / 128.0f) + EPS);
        const float g = bf2f(WSP(bf16, WS_GB)[(size_t)row * 512 + 128 * h + tid]);
        QZ[(size_t)row * 1024 + 128 * h + tid] = (bf16)f2bf(ov * rs * g);
    }
    __syncthreads();
}
__device__ __forceinline__ void mamba_decode(Frame& F, int smp, int g) {
    LAS float* XS = (LAS float*)F.lds;
    LAS float* YS = (LAS float*)(F.lds + 2048);
    LAS float* RED = (LAS float*)(F.lds + 3072);
    const int tid = F.tid, row = ROW_SMP + smp;
    const bf16* XBC = WSP(bf16, WS_XBC); bf16* QZ = WSP(bf16, WS_QZ);
    {
        const int ch = tid, col = ch < 256 ? 256 * g + ch : ch < 384 ? 512 + 128 * g + (ch - 256) : 768 + 128 * g + (ch - 384);
        const float* cw = inp(F, 14); const float* sc = inp(F, 4) + (size_t)smp * 3 * 1024;
        const float s0 = sc[col], s1 = sc[1024 + col], s2 = sc[2048 + col], cur = bf2f(XBC[(size_t)row * 1024 + col]);
        XS[ch] = silu(inp(F, 15)[col] + cw[col] * s0 + cw[1024 + col] * s1 + cw[2048 + col] * s2 + cw[3072 + col] * cur);
        float* cs = OUTP(O_CVS) + (size_t)smp * 3 * 1024; cs[col] = s1; cs[1024 + col] = s2;
    }
    __syncthreads();
    {
        const int hd = tid >> 7, r = tid & 127, n4 = (r & 31) * 4, pg = r >> 5, head = 4 * g + hd;
        const float dt = WSP(float, WS_DT)[(size_t)row * 8 + head], dA = __expf(-dt * __expf(inp(F, 17)[head])), Dk = inp(F, 18)[head];
        const f32x4 Bv = *(const LAS f32x4*)(XS + 256 + n4), Cv = *(const LAS f32x4*)(XS + 384 + n4);
        const float* Sin = inp(F, 3) + (size_t)(smp * 8 + head) * 8192; float* Sout = OUTP(O_SSS) + (size_t)(smp * 8 + head) * 8192;
        float yv[16]; f32x4 st[16];
#pragma unroll
        for (int j = 0; j < 16; ++j) st[j] = *(const GAS f32x4*)(Sin + (size_t)(pg * 16 + j) * 128 + n4);
#pragma unroll
        for (int j = 0; j < 16; ++j) {
            const int p = pg * 16 + j; const float x = XS[hd * 64 + p];
            const f32x4 sn = st[j] * dA + Bv * (dt * x);
            *(GAS f32x4*)(Sout + (size_t)p * 128 + n4) = sn;
            yv[j] = (sn[0] * Cv[0] + sn[1] * Cv[1]) + (sn[2] * Cv[2] + sn[3] * Cv[3]);
        }
        { int rsel; const float y = rowsum16(yv, F.lane, rsel); if ((r & 1) == 0) { const int p = pg * 16 + rsel; YS[hd * 64 + p] = y + Dk * XS[hd * 64 + p]; } }
    }
    __syncthreads();
    float yz = 0.f;
    if (tid < 256) {
        yz = YS[tid] * bf2f(QZ[(size_t)row * 1024 + 512 + 256 * g + tid]);
        const float sq = wave_sum(yz * yz); if (F.lane == 0) RED[F.wave] = sq;
    }
    __syncthreads();
    if (tid < 256) {
        const float rs = 1.0f / sqrtf(((RED[0] + RED[1]) + (RED[2] + RED[3])) * (1.0f / 256.0f) + EPS);
        QZ[(size_t)row * 1024 + 512 + 256 * g + tid] = (bf16)f2bf(yz * rs * inp(F, 19)[256 * g + tid]);
    }
    __syncthreads();
}
__device__ __forceinline__ void p4a(Frame& F, bool decode) {
    if (decode) {
        for (int j = F.vcu; j < 512; j += F.G) hgrn_decode(F, j >> 2, j & 3);
        for (int j = F.vcu; j < 256; j += F.G) mamba_decode(F, j >> 1, j & 1);
    }
    {   HgRaw raw; int i = F.vcu; if (i < 1028) { const HgP p0 = hg_params(i); hg_load<1>(F, p0, raw); }
        for (; i < 1028; i += F.G) { const int in = i + F.G; hgrn_item<1>(F, hg_params(i), raw, in < 1028, hg_params(in < 1028 ? in : i)); } }
    {   MbRaw raw; int j = F.vcu; if (mb_valid(j, true)) { const MbP p0 = mb_params(F, j); mb_load<1>(F, p0, raw); }
        for (; mb_valid(j, true); j += F.G) { const int jn = j + F.G; const bool hn = mb_valid(jn, true); mamba_item<1>(F, mb_params(F, j), raw, hn, mb_params(F, hn ? jn : j)); } }
}
__device__ __forceinline__ void p4c(Frame& F) {
    {   HgRaw raw; int i = F.vcu; if (i < 1024) { const HgP p0 = hg_params(i); hg_load<3>(F, p0, raw); }
        for (; i < 1024; i += F.G) { const int in = i + F.G; hgrn_item<3>(F, hg_params(i), raw, in < 1024, hg_params(in < 1024 ? in : i)); } }
    {   MbRaw raw; int j = F.vcu; if (j < 512) { const MbP p0 = mb_params(F, j); mb_load<3>(F, p0, raw); }
        for (; j < 512; j += F.G) { const int jn = j + F.G; mamba_item<3>(F, mb_params(F, j), raw, jn < 512, mb_params(F, jn < 512 ? jn : j)); } }
}
#ifndef MK_PER_PHASE
#define MK_PER_PHASE 0
#endif
#ifndef GP_ALIGN
#define GP_ALIGN true
#endif
#ifndef GP_SP2
#define GP_SP2 true
#endif
#ifndef GP_SP2_FINAL
#define GP_SP2_FINAL false
#endif
#ifndef WGM_GU
#define WGM_GU 4
#endif
#ifndef WGM_IN
#define WGM_IN 4
#endif
#ifndef WGM_DN
#define WGM_DN 4
#endif
constexpr int N_PHASES = 13;
struct Args { const float* in[26]; float* out; unsigned char* ws; int ph_lo, ph_hi; };
static_assert(sizeof(Args) == 26 * 8 + 8 + 8 + 8, "Args has no padding");
template <bool SPLIT> __global__ void __launch_bounds__(NWAVES * 64, 2) hymba_fwd(Args args) {
    extern __shared__ __attribute__((aligned(16))) unsigned char lds[];
    Frame F;
    F.lds = (LAS unsigned char*)lds;
    F.MISC = (volatile LAS unsigned*)(F.lds + MISC_OFF);
    F.tid = threadIdx.x; F.lane = F.tid & 63; F.wave = __builtin_amdgcn_readfirstlane(F.tid >> 6);
    F.G = gridDim.x; { const int bx = blockIdx.x; F.vcu = (F.G % 8 == 0) ? (bx % 8) * (F.G / 8) + bx / 8 : bx; }
    F.ws = (GAS unsigned char*)args.ws; F.out = (GAS float*)args.out; F.ctl = (gu32*)(args.ws + WS_CTL);
    for (int u = F.tid; u < (LDS_BYTES - LDSCTL_OFF) / 4; u += NWAVES * 64) ((LAS unsigned*)(F.lds + LDSCTL_OFF))[u] = 0u;
    __syncthreads();
    if (F.tid < 26) ((LAS unsigned long long*)(F.lds + TAB_OFF))[F.tid] = (unsigned long long)args.in[F.tid];
    __syncthreads();
    XcdBarrier bar; bar.bar = (unsigned*)(F.ctl + CW_BAR); bar.x = 0; bar.st = nullptr;
    if (!MK_PER_PHASE) bar = xcd_barrier_post((unsigned*)(F.ctl + CW_BAR), F.MISC + 8);
    const int lo = args.ph_lo, hi = args.ph_hi;
#ifndef PH_MASK
#define PH_MASK 0x1fff
#endif
#define IN(k) (((PH_MASK >> (k)) & 1) && lo <= (k) && (k) < hi)
#ifndef PH_REPEAT
#define PH_REPEAT 0
#endif
#define SEAM(k) do { if (IN(k) && IN((k) + 1)) xcd_barrier(bar); } while (0)
#define PHASE_LOCAL() asm volatile("" : "+s"(F.ws), "+s"(F.out), "+v"(F.tid), "+v"(F.lane), "+s"(F.wave), "+s"(F.vcu), "+s"(F.G))
#define REP(k) for (int rep_ = 0; rep_ < 1 + ((PH_REPEAT >> (k)) & 1); ++rep_)
#define HB WSP(bf16, WS_HB)
#define HH WSP(bf16, WS_H)
#define QZ WSP(bf16, WS_QZ)
#define SS1 WSP(float, WS_SS1)
#define SS2 WSP(float, WS_SS2)
#define SS3 WSP(float, WS_SS3)
#define SS4 WSP(float, WS_SS4)
#define RS2 (WSP(float, WS_SS1) + 32768)
#define RS3 (WSP(float, WS_SS1) + 65536)
#define YP (OUTP(O_YP))
#define HX0 WSP(float, WS_HX0)
#define HX WSP(float, WS_HX)

    constexpr int split = SPLIT ? 1 : 0;
#define SLABS WSP(float, WS_XBC)
    if (IN(0)) REP(0) { if (rep_ == 1) xcd_barrier(bar); PHASE_LOCAL(); p0_prologue(F, split); } SEAM(0);
    if (IN(1)) REP(1) { if (rep_ == 1) xcd_barrier(bar); PHASE_LOCAL();
        pg8::Gemm g{HB, WSP(bf16, WS_WGU1), M, 2 * FF, D, D}; pg8::MixOrder S; S.init(65, 2 * FF, D, F.G, (int)blockIdx.x, 0, WGM_GU);
        pg8::EpiSwiglu E{HH, SS1, LDH, FF / 64};
        pg8::gemm_phase<pg8::EpiSwiglu, pg8::MixOrder, GP_ALIGN, GP_SP2>(F.lds, g, S, E, nullptr);
        if (split && rep_ == 0) {
            const int idle0 = 1430 - 5 * 256;
            if ((int)blockIdx.x >= idle0) { __syncthreads(); const int iw = ((int)blockIdx.x - idle0) * NWAVES + F.wave, nw_ = (256 - idle0) * NWAVES;
                p0_weight_items(F, 2 * P0_I_GU, 3 * P0_I_GU, iw, nw_);
                p0_weight_items(F, 6 * P0_I_GU, 6 * P0_I_GU + P0_I_IN, iw, nw_); }
        }
    } SEAM(1);
    if (IN(2)) REP(2) { if (rep_ == 1) xcd_barrier(bar); PHASE_LOCAL();
        pg8::Gemm g{HH, WSP(bf16, WS_WD1), M, D, FF, LDH}; pg8::MixOrder S; S.init(split ? 64 : 65, D, FF, F.G, (int)blockIdx.x, split, WGM_DN);
        pg8::EpiResid E{HB, nullptr, HX0, HX, HB, SS2, 0.5f, nullptr};
        pg8::gemm_phase<pg8::EpiResid, pg8::MixOrder, GP_ALIGN, GP_SP2>(F.lds, g, S, E, SLABS);
    } SEAM(2);
    if (IN(3)) REP(3) { if (rep_ == 1) xcd_barrier(bar); PHASE_LOCAL(); fix_extra<FF / 128>(F, split, SLABS, HX0, HX, HB, SS2, RS2, 0.5f); } SEAM(3);
    if (IN(4)) REP(4) { if (rep_ == 1) xcd_barrier(bar); PHASE_LOCAL();
        pg8::Gemm g{HB, WSP(bf16, WS_WIN), M, NINP, D, D}; pg8::MixOrder S; S.init(65, NINP, D, F.G, (int)blockIdx.x, 0, WGM_IN);
        pg8::EpiInproj E{RS2, QZ, WSP(float, WS_FZ), WSP(bf16, WS_VB), WSP(bf16, WS_GB), WSP(bf16, WS_XBC), WSP(float, WS_DT), inp(F, 13), inp(F, 16), OUTP(O_CVP), OUTP(O_CVS)};
        pg8::gemm_phase<pg8::EpiInproj, pg8::MixOrder, GP_ALIGN, GP_SP2>(F.lds, g, S, E, nullptr);
        if (split && rep_ == 0) {
            const int idle0 = 975 - 3 * 256;
            if ((int)blockIdx.x >= idle0) { __syncthreads(); const int iw = ((int)blockIdx.x - idle0) * NWAVES + F.wave, nw_ = (256 - idle0) * NWAVES;
                p0_weight_items(F, 6 * P0_I_GU + P0_I_IN, P0_NITEMS, iw, nw_);
                p0_weight_items(F, 3 * P0_I_GU, 6 * P0_I_GU, iw, nw_); }
        }
    } SEAM(4);
    if (IN(5)) REP(5) { if (rep_ == 1) xcd_barrier(bar); PHASE_LOCAL(); p4a(F, rep_ == 0); } SEAM(5);
    if (IN(6)) REP(6) { if (rep_ == 1) xcd_barrier(bar); PHASE_LOCAL(); p4b_scan(F); } SEAM(6);
    if (IN(7)) REP(7) { if (rep_ == 1) xcd_barrier(bar); PHASE_LOCAL(); p4c(F); } SEAM(7);
    if (IN(8)) REP(8) { if (rep_ == 1) xcd_barrier(bar); PHASE_LOCAL();
        pg8::Gemm g{QZ, WSP(bf16, WS_WOUT), M, D, D, D}; pg8::MixOrder S; S.init(split ? 64 : 65, D, D, F.G, (int)blockIdx.x, split, WGM_DN);
        pg8::EpiResid E{HB, nullptr, HX, HX, HB, SS3, 1.0f, nullptr};
        pg8::gemm_phase<pg8::EpiResid, pg8::MixOrder, GP_ALIGN, GP_SP2>(F.lds, g, S, E, SLABS);
    } SEAM(8);
    if (IN(9)) REP(9) { if (rep_ == 1) xcd_barrier(bar); PHASE_LOCAL(); fix_extra<D / 128>(F, split, SLABS, HX, HX, HB, SS3, RS3, 1.0f);
        if (split) { GAS v4u* z = (GAS v4u*)(F.ws + WS_UM); for (int i = F.vcu * (NWAVES * 64) + F.tid; i < 131072; i += F.G * NWAVES * 64) z[i] = (v4u){0u, 0u, 0u, 0u}; } }
    if (IN(10)) REP(10) { if (rep_ == 1) xcd_barrier(bar); PHASE_LOCAL();
        pg8::Gemm g{HB, WSP(bf16, WS_WGU2), M, 2 * FF, D, D}; pg8::MixOrder S; S.init(65, 2 * FF, D, F.G, (int)blockIdx.x, 0, WGM_GU);
        pg8::EpiSwiglu E{HH, RS3, LDH, FF / 64};
        pg8::gemm_phase<pg8::EpiSwiglu, pg8::MixOrder, GP_ALIGN, GP_SP2>(F.lds, g, S, E, nullptr);
    } SEAM(10);
    if (IN(11)) REP(11) { if (rep_ == 1) xcd_barrier(bar); PHASE_LOCAL();
        pg8::Gemm g{HH, WSP(bf16, WS_WD2), M, D, FF, LDH}; pg8::MixOrder S; S.init(split ? 64 : 65, D, FF, F.G, (int)blockIdx.x, split, WGM_DN);
        if constexpr (SPLIT) {
            pg8::EpiResid E{HB, nullptr, HX, HX, HB, SS4, 0.5f, (unsigned long long*)(F.ws + WS_UM)};
            pg8::gemm_phase<pg8::EpiResid, pg8::MixOrder, GP_ALIGN, GP_SP2>(F.lds, g, S, E, SLABS);
            pg8::Unit u; S.next(0, u);
            VM_WAIT(); __syncthreads();
            unsigned long long* gp = (unsigned long long*)(F.ws + WS_UM) + (size_t)u.pm * 256 * 16;
            const bf16* hb = HB + (size_t)u.pm * 256 * 1024 + u.pn * 256 + 4 * F.lane;
            float* yb = YP + (size_t)u.pm * 256 * 1024 + u.pn * 256 + 4 * F.lane;
            const f32x4 w = *(const GAS f32x4*)(inp(F, 25) + u.pn * 256 + 4 * F.lane);
            float tot[8];
            { unsigned long long x[8]; unsigned spins = 0;
              for (;;) { bool ok = true;
#pragma unroll
                  for (int j = 0; j < 8; ++j) { x[j] = __hip_atomic_load(gp + (size_t)F.wave * 512 + F.lane + 64 * j, __ATOMIC_RELAXED, __HIP_MEMORY_SCOPE_AGENT); ok = ok && ((unsigned)(x[j] >> 32) == 1u); }
                  if (__all(ok) || ++spins > (1u << 18)) break; __builtin_amdgcn_s_sleep(4); }
#pragma unroll
              for (int j = 0; j < 8; ++j) { float v = __builtin_bit_cast(float, (unsigned)x[j]); v += __shfl_xor(v, 1); v += __shfl_xor(v, 2); v += __shfl_xor(v, 4); v += __shfl_xor(v, 8); tot[j] = v; } }
            unsigned long long o[32];
#pragma unroll
            for (int i = 0; i < 32; ++i) o[i] = *(const GAS unsigned long long*)(hb + (size_t)(F.wave * 32 + i) * 1024);
#pragma unroll
            for (int r = 0; r < 32; ++r) { const float rs = __builtin_amdgcn_rsqf(__builtin_bit_cast(float, __builtin_amdgcn_readlane(__builtin_bit_cast(int, tot[r >> 2]), (r & 3) * 16)) * (1.0f / 1024.0f) + EPS);
                const unsigned lo = (unsigned)o[r], hi = (unsigned)(o[r] >> 32);
                const f32x4 v = (f32x4){__builtin_bit_cast(float, lo << 16), __builtin_bit_cast(float, lo & 0xffff0000u), __builtin_bit_cast(float, hi << 16), __builtin_bit_cast(float, hi & 0xffff0000u)};
                *(GAS f32x4*)(yb + (size_t)(F.wave * 32 + r) * 1024) = v * rs * w; }
        } else {
            pg8::EpiResid E{HB, YP, HX, HX, nullptr, SS4, 0.5f, nullptr};
            pg8::gemm_phase<pg8::EpiResid, pg8::MixOrder, GP_ALIGN, GP_SP2>(F.lds, g, S, E, SLABS);
        }
    } SEAM(11);
    if (IN(12)) REP(12) { if (rep_ == 1) xcd_barrier(bar); PHASE_LOCAL(); p8_final<FF / 128>(F, split, SLABS); }
#undef SLABS
#undef IN
#undef SEAM
#undef HB
#undef HH
#undef QZ
#undef SS1
#undef SS2
#undef SS3
#undef SS4
#undef RS2
#undef RS3
#undef YP
#undef HX0
#undef HX
}

extern "C" void kernel_launch(void* const* d_in, const int* in_sizes, int n_in, void* d_out, int out_size, void* d_ws, size_t ws_size, hipStream_t stream) {
    static int grid = 0;
    if (grid == 0) {
        if (n_in != 26 || in_sizes[0] != MP * D || (size_t)out_size != O_END || ws_size < WS_END) {
            fprintf(stderr, "kernel_launch: unexpected shapes: n_in %d in0 %d out %d ws %zu; nothing launched\n", n_in, n_in > 0 ? in_sizes[0] : -1, out_size, ws_size); grid = -1; return; }
        int dev = 0, cus = 0, per_cu = 0;
        if (hipGetDevice(&dev) != hipSuccess || hipDeviceGetAttribute(&cus, hipDeviceAttributeMultiprocessorCount, dev) != hipSuccess) { fprintf(stderr, "kernel_launch: device query failed\n"); grid = -1; return; }
        if (hipFuncSetAttribute((const void*)hymba_fwd<true>, hipFuncAttributeMaxDynamicSharedMemorySize, LDS_BYTES) != hipSuccess || hipFuncSetAttribute((const void*)hymba_fwd<false>, hipFuncAttributeMaxDynamicSharedMemorySize, LDS_BYTES) != hipSuccess) { fprintf(stderr, "kernel_launch: hipFuncSetAttribute failed\n"); grid = -1; return; }
        if (hipOccupancyMaxActiveBlocksPerMultiprocessor(&per_cu, cus == 256 ? (const void*)hymba_fwd<true> : (const void*)hymba_fwd<false>, NWAVES * 64, LDS_BYTES) != hipSuccess || per_cu < 1)
            fprintf(stderr, "kernel_launch: note: occupancy query reports %d workgroups per CU\n", per_cu);
        (void)hipGetLastError();
        grid = cus;
    }
    if (grid < 0) return;
    if (hipMemsetAsync((char*)d_ws + WS_CTL, 0, CTL_ZERO_BYTES, stream) != hipSuccess) { fprintf(stderr, "kernel_launch: memset failed\n"); return; }
    Args a{};
    for (int i = 0; i < 26; ++i) a.in[i] = (const float*)d_in[i];
    a.out = (float*)d_out; a.ws = (unsigned char*)d_ws;
#if MK_PER_PHASE
    for (int p = 0; p < N_PHASES; ++p) { a.ph_lo = p; a.ph_hi = p + 1; if (grid == 256) hipLaunchKernelGGL(hymba_fwd<true>, dim3(grid), dim3(NWAVES * 64), LDS_BYTES, stream, a); else hipLaunchKernelGGL(hymba_fwd<false>, dim3(grid), dim3(NWAVES * 64), LDS_BYTES, stream, a); }
#else
    a.ph_lo = 0; a.ph_hi = N_PHASES;
    if (grid == 256) hipLaunchKernelGGL(hymba_fwd<true>, dim3(grid), dim3(NWAVES * 64), LDS_BYTES, stream, a);
    else hipLaunchKernelGGL(hymba_fwd<false>, dim3(grid), dim3(NWAVES * 64), LDS_BYTES, stream, a);
#endif
    const hipError_t le = hipPeekAtLastError();
    if (le != hipSuccess) fprintf(stderr, "kernel_launch: launch failed: %s\n", hipGetErrorName(le));
}
```

```cpp
#include <hip/hip_runtime.h>
#include <cstdio>
#include <cstdint>
namespace pg8 {
#define PG8_LAS __attribute__((address_space(3)))
typedef unsigned short bf16_t;
typedef short bf16x8 __attribute__((ext_vector_type(8)));
typedef float f32x4 __attribute__((ext_vector_type(4)));
typedef unsigned u32x4 __attribute__((ext_vector_type(4)));
constexpr int BM = 256, BK = 64, HALF = 128, HTB = HALF * BK * 2  , STAGE_BYTES = 8 * HTB, NXCD = 8, WGM = 8;

__host__ __device__ __forceinline__ int lds_byte(int r, int c) { const int st = (r >> 4) * 2 + (c >> 5), rr = r & 15, cc = c & 31, ob = rr * 64 + cc * 2; return st * 1024 + (ob ^ (((ob >> 9) & 1) << 5)); }
__host__ __device__ __forceinline__ void stage_rc(int b, int& R, int& C) { const int st = b / 1024, sb = b % 1024, swz = sb ^ (((sb >> 9) & 1) << 5); R = (st >> 1) * 16 + swz / 64; C = (st & 1) * 32 + (swz % 64) / 2; }
__host__ __device__ __forceinline__ int perm32(int rho) { const int n = rho >> 4, i = rho & 15; return 8 * (i >> 2) + 4 * n + (i & 3); }

constexpr int SLICE_ROWS = 144;
struct Unit { int pm, pn, k0, nt, kind, slot; };
struct Gemm { const bf16_t* A; const bf16_t* Bt; int M, N, K, lda; };

struct MixOrder {
    int nM, nN, nwg, G, c, ppu, npieces, rounds, wgm, sp_lo = -1;
    __host__ __device__ __forceinline__ void init(int nM_, int N, int K, int G_, int c_, int split, int wgm_) { wgm = wgm_; nM = nM_; nN = N / BM; nwg = nM * nN; G = G_; c = c_; ppu = K / (2 * BK); npieces = split ? nN * ppu : 0; rounds = (nwg + G - 1) / G; }
    __host__ __device__ __forceinline__ bool next(int i, Unit& u) const {
        if (i >= rounds) { const int p = (i - rounds) * G + c; if (p >= npieces) return false; u.pm = nM; u.pn = p / ppu; u.k0 = 2 * (p % ppu); u.nt = 2; u.kind = 1; u.slot = p; return true; }
        const long L = (long)i * G + c; if (L >= nwg) return false;
        int wgid = (int)L; int nMe = nM, nwge = nwg;
        if (sp_lo >= 0) {
            const int span = (nN + 7) & ~7; nMe = nM - 1; nwge = nMe * nN;
            if (wgid >= sp_lo && wgid < sp_lo + nN) { u.pm = nM - 1; u.pn = wgid - sp_lo; u.k0 = 0; u.nt = 2 * ppu; u.kind = 0; u.slot = 0; return true; }
            wgid = wgid < sp_lo ? wgid : wgid < sp_lo + span ? nwge - (span - nN) + (wgid - sp_lo - nN) : wgid - span;
        } { const int q = nwge / NXCD, r = nwge % NXCD, xcd = wgid % NXCD, off = wgid / NXCD; wgid = (xcd < r ? xcd * (q + 1) : r * (q + 1) + (xcd - r) * q) + off; }
        const int nig = wgm * nN, gid = wgid / nig, fm = gid * wgm, gsz = (nMe - fm) < wgm ? (nMe - fm) : wgm;
        u.pm = fm + ((wgid % nig) % gsz); u.pn = (wgid % nig) / gsz; if (gid & 1) u.pn = nN - 1 - u.pn;
        u.k0 = 0; u.nt = 2 * ppu; u.kind = 0; u.slot = 0; return true;
    }
};
struct SliceOrder {
    int pm_, ppu, p;
    __host__ __device__ __forceinline__ bool next(int i, Unit& u) const { if (i != 0 || p < 0) return false; u.pm = pm_; u.pn = p / ppu; u.k0 = 2 * (p % ppu); u.nt = 2; u.kind = 1; u.slot = p; return true; }
};

__device__ __forceinline__ unsigned cvt_pk_bf16(float lo, float hi) { unsigned r; asm volatile("v_cvt_pk_bf16_f32 %0, %1, %2" : "=v"(r) : "v"(lo), "v"(hi)); return r; }
typedef float f32x2 __attribute__((ext_vector_type(2)));
constexpr float EPSN = 1e-6f;
__device__ __forceinline__ float row_rstd(const float* SS, int row) {
    const f32x4* p = (const f32x4*)(SS + (size_t)row * 16);
    const f32x4 a = p[0], b = p[1], c = p[2], d = p[3];
    const float s = (((a[0] + a[1]) + (a[2] + a[3])) + ((b[0] + b[1]) + (b[2] + b[3]))) + (((c[0] + c[1]) + (c[2] + c[3])) + ((d[0] + d[1]) + (d[2] + d[3])));
    return __builtin_amdgcn_rsqf(s * (1.0f / 1024.0f) + EPSN);
}
__device__ __forceinline__ float silu_f(float x) { return x * __builtin_amdgcn_rcpf(1.0f + __expf(-x)); }
typedef unsigned u32x2 __attribute__((ext_vector_type(2)));

struct EpiSwiglu {
    static constexpr bool PERM = true, AFTER_DRAIN = false;
    bf16_t* H; const float* RSTD; int ldh, nkt;
    __device__ __forceinline__ void operator()(const f32x4 (&acc)[2][2][4][2], const Unit& u, int wr, int wc, int fr, int fq) const {
        const int row0 = u.pm * BM + wr * 64 + fr, col0 = u.pn * 128 + wc * 32 + 8 * fq;
        float rs8[8];
#pragma unroll
        for (int i = 0; i < 8; ++i) rs8[i] = RSTD[row0 + (i >> 2) * HALF + (i & 3) * 16];
#pragma unroll
        for (int ai = 0; ai < 2; ++ai)
#pragma unroll
            for (int m = 0; m < 4; ++m) {
                const int row = row0 + ai * HALF + m * 16;
                const float rs = rs8[ai * 4 + m], rs2 = rs * rs, ce = rs * -1.44269504f;
                float h[8];
#pragma unroll
                for (int n = 0; n < 2; ++n)
#pragma unroll
                    for (int j = 0; j < 4; ++j) { const float g = acc[ai][0][m][n][j], up = acc[ai][1][m][n][j]; h[n * 4 + j] = (g * up) * rs2 * __builtin_amdgcn_rcpf(1.0f + __builtin_amdgcn_exp2f(g * ce)); }
                u32x4 w; w.x = cvt_pk_bf16(h[0], h[1]); w.y = cvt_pk_bf16(h[2], h[3]); w.z = cvt_pk_bf16(h[4], h[5]); w.w = cvt_pk_bf16(h[6], h[7]);
                if (ldh) *(u32x4*)(H + (size_t)row * ldh + col0) = w;
                else *(u32x4*)(H + ((size_t)((row >> 8) * nkt + (col0 >> 6)) * 256 + (row & 255)) * 64 + (col0 & 63)) = w;
            }
    }
};

struct EpiResid {
    static constexpr bool PERM = true, AFTER_DRAIN = false;
    const bf16_t* RB; float* D0;
    const float* RX; float* DX;
    bf16_t* HB; float* SS; float scale; unsigned long long* gran;
    __device__ __forceinline__ void operator()(const f32x4 (&acc)[2][2][4][2], const Unit& u, int wr, int wc, int fr, int fq) const {
        const int col0 = u.pn * BM + wc * 32 + 8 * fq;
        if (u.pm < 64) {
            const bf16_t* rb = RB + (size_t)u.pm * BM * 1024; float* db = D0 ? D0 + (size_t)u.pm * BM * 1024 : nullptr;
            u32x4 rn[2];
            { const size_t off0 = (size_t)(wr * 64 + fr) * 1024 + col0;
#pragma unroll
              for (int bj = 0; bj < 2; ++bj) rn[bj] = *(const u32x4*)(rb + off0 + bj * HALF); }
#pragma unroll
            for (int ai = 0; ai < 2; ++ai)
#pragma unroll
                for (int m = 0; m < 4; ++m) {
                    int lrow = ai * HALF + wr * 64 + m * 16 + fr;
                    asm volatile("" : "+v"(lrow));
                    const size_t off = (size_t)lrow * 1024 + col0;
                    u32x4 rc[2];
#pragma unroll
                    for (int bj = 0; bj < 2; ++bj) rc[bj] = rn[bj];
                    if (ai * 4 + m < 7) { const int nx = ai * 4 + m + 1; int lnx = (nx >> 2) * HALF + wr * 64 + (nx & 3) * 16 + fr; asm volatile("" : "+v"(lnx));
                        const size_t offn = (size_t)lnx * 1024 + col0;
#pragma unroll
                        for (int bj = 0; bj < 2; ++bj) rn[bj] = *(const u32x4*)(rb + offn + bj * HALF); }
                    float sq = 0.f;
#pragma unroll
                    for (int bj = 0; bj < 2; ++bj) {
                        const u32x4 rr = rc[bj];
                        const f32x4 r0 = (f32x4){__builtin_bit_cast(float, rr.x << 16), __builtin_bit_cast(float, rr.x & 0xffff0000u), __builtin_bit_cast(float, rr.y << 16), __builtin_bit_cast(float, rr.y & 0xffff0000u)};
                        const f32x4 r1 = (f32x4){__builtin_bit_cast(float, rr.z << 16), __builtin_bit_cast(float, rr.z & 0xffff0000u), __builtin_bit_cast(float, rr.w << 16), __builtin_bit_cast(float, rr.w & 0xffff0000u)};
                        const f32x4 o0 = r0 + acc[ai][bj][m][0] * scale, o1 = r1 + acc[ai][bj][m][1] * scale;
                        if (db) { *(f32x4*)(db + off + bj * HALF) = o0; *(f32x4*)(db + off + bj * HALF + 4) = o1; }
                        sq += ((o0[0] * o0[0] + o0[1] * o0[1]) + (o0[2] * o0[2] + o0[3] * o0[3])) + ((o1[0] * o1[0] + o1[1] * o1[1]) + (o1[2] * o1[2] + o1[3] * o1[3]));
                        if (HB) { u32x4 w; w.x = cvt_pk_bf16(o0[0], o0[1]); w.y = cvt_pk_bf16(o0[2], o0[3]); w.z = cvt_pk_bf16(o1[0], o1[1]); w.w = cvt_pk_bf16(o1[2], o1[3]); *(u32x4*)(HB + ((size_t)u.pm * BM + lrow) * 1024 + col0 + bj * HALF) = w; }
                    }
                    sq += __shfl_xor(sq, 16); sq += __shfl_xor(sq, 32);
                    if (fq == 0) { if (gran) __hip_atomic_store(gran + ((size_t)u.pm * BM + lrow) * 16 + u.pn * 4 + wc, (1ull << 32) | (unsigned long long)__builtin_bit_cast(unsigned, sq), __ATOMIC_RELAXED, __HIP_MEMORY_SCOPE_AGENT);
                        else SS[((size_t)u.pm * BM + lrow) * 16 + u.pn * 4 + wc] = sq; }
                    asm volatile("" ::: "memory");
                }
        } else {
#pragma unroll
            for (int ai = 0; ai < 2; ++ai)
#pragma unroll
                for (int m = 0; m < 4; ++m) {
                    int lrow = ai * HALF + wr * 64 + m * 16 + fr;
                    asm volatile("" : "+v"(lrow));
                    const size_t off = (size_t)lrow * 1024 + col0;
                    float sq = 0.f;
#pragma unroll
                    for (int bj = 0; bj < 2; ++bj) {
                        const f32x4 o0 = *(const f32x4*)(RX + off + bj * HALF) + acc[ai][bj][m][0] * scale, o1 = *(const f32x4*)(RX + off + bj * HALF + 4) + acc[ai][bj][m][1] * scale;
                        *(f32x4*)(DX + off + bj * HALF) = o0; *(f32x4*)(DX + off + bj * HALF + 4) = o1;
                        sq += ((o0[0] * o0[0] + o0[1] * o0[1]) + (o0[2] * o0[2] + o0[3] * o0[3])) + ((o1[0] * o1[0] + o1[1] * o1[1]) + (o1[2] * o1[2] + o1[3] * o1[3]));
                        if (HB) { u32x4 w; w.x = cvt_pk_bf16(o0[0], o0[1]); w.y = cvt_pk_bf16(o0[2], o0[3]); w.z = cvt_pk_bf16(o1[0], o1[1]); w.w = cvt_pk_bf16(o1[2], o1[3]); *(u32x4*)(HB + ((size_t)u.pm * BM + lrow) * 1024 + col0 + bj * HALF) = w; }
                    }
                    sq += __shfl_xor(sq, 16); sq += __shfl_xor(sq, 32);
                    if (fq == 0) SS[((size_t)u.pm * BM + lrow) * 16 + u.pn * 4 + wc] = sq;
                    asm volatile("" ::: "memory");
                }
        }
    }
};

constexpr int CVS_PITCH = 1088;
struct EpiInproj {
    static constexpr bool PERM = true, AFTER_DRAIN = false;
    const float* RSTD; bf16_t* QZ; bf16_t* FZ; bf16_t* VB; bf16_t* GB; bf16_t* XBC; float* DT;
    const float* hgn; const float* dtb; float* convp; float* convs;
    __device__ __forceinline__ void operator()(const f32x4 (&acc)[2][2][4][2], const Unit& u, int wr, int wc, int fr, int fq) const {
        const int type = u.pn;
        const int row0 = u.pm * BM + wr * 64 + fr;
        float rs8[8];
#pragma unroll
        for (int i = 0; i < 8; ++i) rs8[i] = RSTD[row0 + (i >> 2) * HALF + (i & 3) * 16];
        f32x4 pre[4];
        if (type >= 6 && type < 8) {
#pragma unroll
            for (int bj = 0; bj < 2; ++bj) { const int col = 256 * (type - 6) + 128 * bj + 32 * wc + 8 * fq; pre[2 * bj] = *(const f32x4*)(hgn + col); pre[2 * bj + 1] = *(const f32x4*)(hgn + col + 4); }
        } else if (type == 14) { pre[0] = *(const f32x4*)dtb; pre[1] = *(const f32x4*)(dtb + 4); pre[2] = pre[0]; pre[3] = pre[1]; }
        else { pre[0] = pre[1] = pre[2] = pre[3] = (f32x4){0.f, 0.f, 0.f, 0.f}; }
#pragma unroll
        for (int ai = 0; ai < 2; ++ai)
#pragma unroll
            for (int m = 0; m < 4; ++m) {
                const int row = row0 + ai * HALF + m * 16;
                const float rs = rs8[ai * 4 + m];
#pragma unroll
                for (int bj = 0; bj < 2; ++bj) {
                    const int c0 = 128 * bj + 32 * wc + 8 * fq;
                    float v[8];
#pragma unroll
                    for (int n = 0; n < 2; ++n)
#pragma unroll
                        for (int j = 0; j < 4; ++j) v[n * 4 + j] = acc[ai][bj][m][n][j] * rs;
                    if (type < 2 || (type >= 8 && type < 10)) {
                        const int col = (type < 2 ? 256 * type : 512 + 256 * (type - 8)) + c0;
#pragma unroll
                        for (int j = 0; j < 8; ++j) v[j] = silu_f(v[j]);
                        u32x4 w; w.x = cvt_pk_bf16(v[0], v[1]); w.y = cvt_pk_bf16(v[2], v[3]); w.z = cvt_pk_bf16(v[4], v[5]); w.w = cvt_pk_bf16(v[6], v[7]);
                        *(u32x4*)(QZ + (size_t)row * 1024 + col) = w;
                    } else if (type < 4) {
                        const int col = 256 * (type - 2) + c0;
                        u32x4 w; w.x = cvt_pk_bf16(v[0], v[1]); w.y = cvt_pk_bf16(v[2], v[3]); w.z = cvt_pk_bf16(v[4], v[5]); w.w = cvt_pk_bf16(v[6], v[7]);
                        *(u32x4*)(FZ + (size_t)row * 512 + col) = w;
                    } else if (type < 6) {
                        const int col = 256 * (type - 4) + c0;
                        u32x4 w; w.x = cvt_pk_bf16(v[0], v[1]); w.y = cvt_pk_bf16(v[2], v[3]); w.z = cvt_pk_bf16(v[4], v[5]); w.w = cvt_pk_bf16(v[6], v[7]);
                        *(u32x4*)(VB + (size_t)row * 512 + col) = w;
                    } else if (type < 8) {
                        const int col = 256 * (type - 6) + c0;
                        const f32x4 n0 = pre[2 * bj], n1 = pre[2 * bj + 1];
#pragma unroll
                        for (int j = 0; j < 4; ++j) { v[j] = silu_f(v[j]) * n0[j]; v[4 + j] = silu_f(v[4 + j]) * n1[j]; }
                        u32x4 w; w.x = cvt_pk_bf16(v[0], v[1]); w.y = cvt_pk_bf16(v[2], v[3]); w.z = cvt_pk_bf16(v[4], v[5]); w.w = cvt_pk_bf16(v[6], v[7]);
                        *(u32x4*)(GB + (size_t)row * 512 + col) = w;
                    } else if (type < 14) {
                        const int col = 256 * (type - 10) + c0;
                        u32x4 w; w.x = cvt_pk_bf16(v[0], v[1]); w.y = cvt_pk_bf16(v[2], v[3]); w.z = cvt_pk_bf16(v[4], v[5]); w.w = cvt_pk_bf16(v[6], v[7]);
                        *(u32x4*)(XBC + (size_t)row * 1024 + col) = w;
                        float* cs = nullptr;
                        if (row < 16384) { const int t = row & 2047; if (t >= 2045) cs = convp + ((size_t)(row >> 11) * 3 + (t - 2045)) * 1024 + col; }
                        else if (row >= 16400 && row < 16528) cs = convs + (size_t)(row - 16400) * CVS_PITCH + col;
                        if (cs) { *(f32x4*)cs = (f32x4){v[0], v[1], v[2], v[3]}; *(f32x4*)(cs + 4) = (f32x4){v[4], v[5], v[6], v[7]}; }
                    } else {
                        if (bj == 0 && wc == 0 && fq == 0) {
                            float d[8];
#pragma unroll
                            for (int j = 0; j < 8; ++j) { const float x = v[j] + pre[j >> 2][j & 3], e = __expf(-fabsf(x));
                                const float l = e < 0.01f ? e * (1.0f + e * (-0.5f + e * (0.33333334f - 0.25f * e))) : __logf(1.0f + e);
                                d[j] = fmaxf(x, 0.f) + l; }
                            *(f32x4*)(DT + (size_t)row * 8) = (f32x4){d[0], d[1], d[2], d[3]};
                            *(f32x4*)(DT + (size_t)row * 8 + 4) = (f32x4){d[4], d[5], d[6], d[7]};
                        }
                    }
                }
            }
    }
};
template <class Epi, class Sched, bool ALIGN_EPI = false, bool SP2 = false>
__device__ __forceinline__ void gemm_phase(PG8_LAS unsigned char* lds, const Gemm g, const Sched& S, const Epi& E, float* slab, unsigned* done_cnt = nullptr, int done_pm = -1) {
    int tid_ = threadIdx.x; asm volatile("" : "+v"(tid_));
    const int tid = tid_, wid = __builtin_amdgcn_readfirstlane(tid >> 6), lane = tid & 63, wr = wid >> 2, wc = wid & 3, fr = lane & 15, fq = lane >> 4;
    const int K = g.K;
    unsigned voffA[2], voffB[2]; int aoff, boff;
#define PG8_LANE_OFFSETS(T_) do { _Pragma("unroll") for (int i = 0; i < 2; ++i) { int R, C; stage_rc((T_) * 16 + i * 8192, R, C); const int Rb = Epi::PERM ? ((R & ~31) + perm32(R & 31)) : R; \
        voffA[i] = (unsigned)(R * (g.lda ? g.lda : BK) + C) * 2u; voffB[i] = (unsigned)(Rb * K + C) * 2u; } \
        aoff = lds_byte((((T_) >> 8) & 1) * 64 + ((T_) & 15), (((T_) >> 4) & 3) * 8); boff = lds_byte((((T_) >> 6) & 3) * 32 + ((T_) & 15), (((T_) >> 4) & 3) * 8); } while (0)
    PG8_LANE_OFFSETS(tid);
    const size_t kstep = (size_t)(BK * 2), kstepA = g.lda ? (size_t)(BK * 2) : (size_t)(BM * BK * 2);
    const size_t hstep = (size_t)HALF * K * 2, hstepA = g.lda ? (size_t)HALF * g.lda * 2 : (size_t)(HALF * BK * 2);
    const size_t tstep = 2 * hstep, tstepA = g.lda ? 2 * hstepA : (size_t)(K / BK) * (BM * BK * 2);
    const unsigned ldsw = (unsigned)wid * 1024u;
#define PG8_SA(b, h) (((b) * 2 + (h)) * HTB)
#define PG8_SB(b, h) ((4 + (b) * 2 + (h)) * HTB)
#define PG8_STAGE(bufoff, gbase, voff) do { _Pragma("unroll") for (int _i = 0; _i < 2; ++_i) \
        __builtin_amdgcn_global_load_lds((const unsigned*)((const char*)(gbase) + (voff)[_i]), (PG8_LAS unsigned*)(lds + (bufoff) + ldsw + _i * 8192), 16, 0, 0); } while (0)
#define PG8_LDA(dst, b, h) do { _Pragma("unroll") for (int m = 0; m < 4; ++m) _Pragma("unroll") for (int k = 0; k < 2; ++k) dst[m][k] = *(const PG8_LAS bf16x8*)(lds + PG8_SA(b, h) + aoff + m * 2048 + k * 1024); } while (0)
#define PG8_LDB(dst, b, h) do { _Pragma("unroll") for (int n = 0; n < 2; ++n) _Pragma("unroll") for (int k = 0; k < 2; ++k) dst[n][k] = *(const PG8_LAS bf16x8*)(lds + PG8_SB(b, h) + boff + n * 2048 + k * 1024); } while (0)
#define PG8_MMA(ai, bj, At, Bt) do { __builtin_amdgcn_s_setprio(1); _Pragma("unroll") for (int m = 0; m < 4; ++m) _Pragma("unroll") for (int n = 0; n < 2; ++n) _Pragma("unroll") for (int k = 0; k < 2; ++k) \
        acc[ai][bj][m][n] = __builtin_amdgcn_mfma_f32_16x16x32_bf16(Bt[n][k], At[m][k], acc[ai][bj][m][n], 0, 0, 0); __builtin_amdgcn_s_setprio(0); } while (0)
#define PG8_WAIT_V(n) asm volatile("s_waitcnt vmcnt(" #n ")" ::: "memory")
#define PG8_WAIT_L(n) asm volatile("s_waitcnt lgkmcnt(" #n ")" ::: "memory")
#define PG8_BAR __builtin_amdgcn_s_barrier()
#define PG8_SCHED __builtin_amdgcn_sched_barrier(0)
    Unit cur, nxt; int ui = 0;
    if (!S.next(0, cur)) return;
    f32x4 acc[2][2][4][2];
#pragma unroll
    for (int a = 0; a < 2; ++a)
#pragma unroll
        for (int b = 0; b < 2; ++b)
#pragma unroll
            for (int m = 0; m < 4; ++m)
#pragma unroll
                for (int n = 0; n < 2; ++n) acc[a][b][m][n] = (f32x4){0.f, 0.f, 0.f, 0.f};
    bf16x8 At[4][2], B0[2][2], B1[2][2];
    const char* cA = (const char*)g.A + (size_t)cur.pm * tstepA + (size_t)cur.k0 * kstepA; const char* cB = (const char*)g.Bt + (size_t)cur.pn * tstep + (size_t)cur.k0 * kstep;
    if constexpr (SP2) {
        PG8_STAGE(PG8_SB(0, 0), cB, voffB); PG8_STAGE(PG8_SB(0, 1), cB + hstep, voffB); PG8_STAGE(PG8_SA(0, 0), cA, voffA); PG8_STAGE(PG8_SA(0, 1), cA + hstepA, voffA);
        if (wr == 1) PG8_BAR;
        PG8_WAIT_V(2); PG8_BAR;
        PG8_STAGE(PG8_SB(1, 0), cB + kstep, voffB); PG8_STAGE(PG8_SA(1, 0), cA + kstepA, voffA); PG8_STAGE(PG8_SB(1, 1), cB + hstep + kstep, voffB);
        PG8_WAIT_V(6); PG8_BAR;
    } else {
        PG8_STAGE(PG8_SB(0, 0), cB, voffB); PG8_STAGE(PG8_SA(0, 0), cA, voffA); PG8_STAGE(PG8_SB(0, 1), cB + hstep, voffB); PG8_STAGE(PG8_SA(0, 1), cA + hstepA, voffA);
        if (wr == 1) PG8_BAR;
        PG8_WAIT_V(4); PG8_BAR;
        PG8_STAGE(PG8_SB(1, 0), cB + kstep, voffB); PG8_STAGE(PG8_SA(1, 0), cA + kstepA, voffA); PG8_STAGE(PG8_SB(1, 1), cB + hstep + kstep, voffB);
        PG8_WAIT_V(6); PG8_BAR;
    }
    for (;;) {
        const bool has_next = S.next(ui + 1, nxt);
        const char* nA = has_next ? (const char*)g.A + (size_t)nxt.pm * tstepA + (size_t)nxt.k0 * kstepA : cA; const char* nB = has_next ? (const char*)g.Bt + (size_t)nxt.pn * tstep + (size_t)nxt.k0 * kstep : cB;
        const int nt = cur.nt;
        for (int t = 0; t < nt; t += 2) {
            const bool last = (t == nt - 2);
            const char* a1 = cA + (size_t)(t + 1) * kstepA;
            const char* a2 = last ? nA : cA + (size_t)(t + 2) * kstepA; const char* b2 = last ? nB : cB + (size_t)(t + 2) * kstep;
            const char* a3 = a2 + kstepA; const char* b3 = b2 + kstep;
            if constexpr (SP2) {
            PG8_LDB(B0, 0, 0); PG8_LDB(B1, 0, 1); PG8_SCHED; PG8_LDA(At, 0, 0); PG8_STAGE(PG8_SA(1, 1), a1 + hstepA, voffA);
            PG8_WAIT_V(8); PG8_WAIT_L(0); PG8_BAR; PG8_MMA(0, 0, At, B0); PG8_MMA(0, 1, At, B1); PG8_BAR; PG8_SCHED;
            PG8_LDA(At, 0, 1); PG8_STAGE(PG8_SB(0, 0), b2, voffB); PG8_STAGE(PG8_SB(0, 1), b2 + hstep, voffB); PG8_STAGE(PG8_SA(0, 0), a2, voffA);
            PG8_WAIT_V(8); PG8_WAIT_L(0); PG8_BAR; PG8_MMA(1, 0, At, B0); PG8_MMA(1, 1, At, B1); PG8_BAR; PG8_SCHED;
            PG8_LDB(B0, 1, 0); PG8_LDB(B1, 1, 1); PG8_SCHED; PG8_LDA(At, 1, 0); PG8_STAGE(PG8_SA(0, 1), a2 + hstepA, voffA);
            PG8_WAIT_V(8); PG8_WAIT_L(0); PG8_BAR; PG8_MMA(0, 0, At, B0); PG8_MMA(0, 1, At, B1); PG8_BAR; PG8_SCHED;
            PG8_LDA(At, 1, 1); PG8_STAGE(PG8_SB(1, 0), b3, voffB); PG8_STAGE(PG8_SB(1, 1), b3 + hstep, voffB); PG8_STAGE(PG8_SA(1, 0), a3, voffA);
            PG8_WAIT_V(8); PG8_WAIT_L(0); PG8_BAR; PG8_MMA(1, 0, At, B0); PG8_MMA(1, 1, At, B1); PG8_BAR; PG8_SCHED;
            } else {
            PG8_LDB(B0, 0, 0); PG8_SCHED; PG8_LDA(At, 0, 0); PG8_STAGE(PG8_SA(1, 1), a1 + hstepA, voffA);
            PG8_WAIT_L(8); PG8_BAR; PG8_WAIT_L(0); PG8_MMA(0, 0, At, B0); PG8_BAR; PG8_SCHED;
            PG8_LDB(B1, 0, 1); PG8_STAGE(PG8_SB(0, 0), b2, voffB);
            PG8_BAR; PG8_WAIT_L(0); PG8_MMA(0, 1, At, B1); PG8_BAR;
            PG8_LDA(At, 0, 1); PG8_STAGE(PG8_SA(0, 0), a2, voffA);
            PG8_BAR; PG8_WAIT_L(0); PG8_MMA(1, 0, At, B0); PG8_BAR; PG8_SCHED;
            PG8_STAGE(PG8_SB(0, 1), b2 + hstep, voffB);
            PG8_WAIT_V(6); PG8_BAR; PG8_MMA(1, 1, At, B1); PG8_BAR;
            PG8_LDB(B0, 1, 0); PG8_SCHED; PG8_LDA(At, 1, 0); PG8_STAGE(PG8_SA(0, 1), a2 + hstepA, voffA);
            PG8_WAIT_L(8); PG8_BAR; PG8_WAIT_L(0); PG8_MMA(0, 0, At, B0); PG8_BAR; PG8_SCHED;
            PG8_LDB(B1, 1, 1); PG8_STAGE(PG8_SB(1, 0), b3, voffB);
            PG8_BAR; PG8_WAIT_L(0); PG8_MMA(0, 1, At, B1); PG8_BAR;
            PG8_LDA(At, 1, 1); PG8_STAGE(PG8_SA(1, 0), a3, voffA);
            PG8_BAR; PG8_WAIT_L(0); PG8_MMA(1, 0, At, B0); PG8_BAR; PG8_SCHED;
            PG8_STAGE(PG8_SB(1, 1), b3 + hstep, voffB);
            PG8_WAIT_V(6); PG8_BAR; PG8_MMA(1, 1, At, B1); PG8_BAR;
            }
        }
        if constexpr (ALIGN_EPI) { if (wr == 0) PG8_BAR; }
        if (cur.kind == 1) {
            float* sb = slab + (size_t)cur.slot * 65536;
#pragma unroll
            for (int a = 0; a < 2; ++a)
#pragma unroll
                for (int m = 0; m < 4; ++m) {
                    if (a * HALF + wr * 64 + m * 16 >= SLICE_ROWS) continue;
                    int lrow = a * HALF + wr * 64 + m * 16 + fr; asm volatile("" : "+v"(lrow));
                    float* rp = sb + (size_t)lrow * 256 + wc * 32 + (Epi::PERM ? 8 : 4) * fq;
#pragma unroll
                    for (int b = 0; b < 2; ++b)
#pragma unroll
                        for (int n = 0; n < 2; ++n) *(f32x4*)(rp + b * HALF + n * (Epi::PERM ? 4 : 16)) = acc[a][b][m][n];
                }
        } else {
            E(acc, cur, wr, wc, fr, fq);
            if (done_cnt != nullptr && cur.pm == done_pm) {
                PG8_WAIT_V(0); PG8_BAR;
                if (tid == 0) { __builtin_amdgcn_fence(__ATOMIC_RELEASE, "agent"); PG8_WAIT_V(0); (void)__hip_atomic_fetch_add(done_cnt, 1u, __ATOMIC_RELAXED, __HIP_MEMORY_SCOPE_AGENT); }
            }
        }
        if (!has_next) break;
#pragma unroll
        for (int a = 0; a < 2; ++a)
#pragma unroll
            for (int b = 0; b < 2; ++b)
#pragma unroll
                for (int m = 0; m < 4; ++m)
#pragma unroll
                    for (int n = 0; n < 2; ++n) acc[a][b][m][n] = (f32x4){0.f, 0.f, 0.f, 0.f};
        cur = nxt; cA = nA; cB = nB; ++ui;
        if constexpr (ALIGN_EPI) { if (wr == 1) PG8_BAR; }
    }
    PG8_WAIT_V(0);
    if constexpr (!ALIGN_EPI) { if (wr == 0) PG8_BAR; }
    PG8_BAR;
#undef PG8_LANE_OFFSETS
#undef PG8_SA
#undef PG8_SB
#undef PG8_STAGE
#undef PG8_LDA
#undef PG8_LDB
#undef PG8_MMA
#undef PG8_WAIT_V
#undef PG8_WAIT_L
#undef PG8_BAR
#undef PG8_SCHED
}
}
constexpr int NWAVES = 8;
constexpr int D = 1024, NBATCH = 8, SEQ = 2048, NMETA = 16, NSMP = 128, FF = 2816;
constexpr int MP = NBATCH * SEQ;
constexpr int ROW_META = MP, ROW_SMP = MP + NMETA;
constexpr int M = 16640;
constexpr int NIN = 3592, NINP = 3840;
constexpr int LDH = 0;
constexpr int CH = 64, NCH = SEQ / CH;
constexpr float EPS = 1e-6f;
constexpr size_t O_YP = 0, O_YS = O_YP + (size_t)MP * D, O_HGP = O_YS + (size_t)NSMP * D, O_SSP = O_HGP + (size_t)NBATCH * 4 * 128 * 128, O_CVP = O_SSP + (size_t)NBATCH * 8 * 64 * 128,
                 O_HGS = O_CVP + (size_t)NBATCH * 3 * 1024, O_SSS = O_HGS + (size_t)NSMP * 4 * 128 * 128, O_CVS = O_SSS + (size_t)NSMP * 8 * 64 * 128, O_END = O_CVS + (size_t)NSMP * 3 * 1024;
constexpr size_t KiB = 1024, MiB = 1u << 20;
constexpr size_t WS_CTL = 0, CTL_ZERO_BYTES = 1 * MiB;
constexpr size_t WS_WGU1 = 1 * MiB, WS_WD1 = 12 * MiB, WS_WIN = 17 * MiB + 512 * KiB, WS_WOUT = 25 * MiB, WS_WGU2 = 27 * MiB, WS_WD2 = 38 * MiB;
constexpr size_t WS_HB = 44 * MiB;
constexpr size_t WS_R = 77 * MiB;
constexpr size_t WS_H = WS_R;
constexpr size_t WS_QZ = 77 * MiB;
constexpr size_t WS_FZ = 110 * MiB;
constexpr size_t WS_VB = 143 * MiB;
constexpr size_t WS_GB = 160 * MiB;
constexpr size_t WS_XBC = 177 * MiB;
constexpr size_t WS_UM = 210 * MiB;
constexpr size_t WS_DT = 243 * MiB;
constexpr size_t WS_ER = 244 * MiB, WS_EL = 245 * MiB;
constexpr size_t WS_DCY = 246 * MiB;
constexpr size_t WS_LB = 246 * MiB + 512 * KiB;
constexpr size_t WS_HX0 = 247 * MiB, WS_HX = 248 * MiB;
constexpr size_t WS_SS1 = 249 * MiB, WS_SS2 = 250 * MiB + 256 * KiB, WS_SS3 = 251 * MiB + 512 * KiB, WS_SS4 = 252 * MiB + 768 * KiB;
constexpr size_t WS_CVS = 254 * MiB;
constexpr size_t WS_END = 256 * MiB;
constexpr size_t UTH_ENT = 128 * 128;
constexpr size_t UM_ENT = 64 * 128;
static_assert(WS_HB + (size_t)M * 1024 * 2 <= WS_R && (1024 + 4) * UTH_ENT * 2 <= (size_t)MP * D * 4, "hb / UTH (in the y_prompt output region)");
static_assert(WS_H + (size_t)M * FF * 2 <= WS_XBC && WS_QZ + (size_t)M * 2048 <= WS_FZ && WS_FZ + (size_t)M * 2048 <= WS_VB && WS_VB + (size_t)M * 1024 <= WS_GB && WS_GB + (size_t)M * 1024 <= WS_XBC, "map 1");
static_assert(WS_XBC + (size_t)M * 2048 <= WS_UM && WS_UM + (2048 + 8) * UM_ENT * 2 <= WS_DT && WS_DT + (size_t)M * 32 <= WS_ER && WS_SS4 + (size_t)M * 64 <= WS_END, "map 2");
constexpr int CW_BAR = 4096;
constexpr int RING_BYTES = 131072, LDSCTL_OFF = RING_BYTES, MISC_OFF = LDSCTL_OFF + 320, LDS_BYTES = 147456;

#define GAS __attribute__((address_space(1)))
#define LAS __attribute__((address_space(3)))
typedef unsigned short bf16;
typedef unsigned v4u __attribute__((ext_vector_type(4)));
typedef float f32x4 __attribute__((ext_vector_type(4)));
typedef float f32x16 __attribute__((ext_vector_type(16)));
typedef short bf16x8 __attribute__((ext_vector_type(8)));
typedef GAS unsigned gu32;
#define RLX_AGENT __ATOMIC_RELAXED, __HIP_MEMORY_SCOPE_AGENT
#define LDS_WAIT() asm volatile("s_waitcnt lgkmcnt(0)" ::: "memory")
#define VM_WAIT() asm volatile("s_waitcnt vmcnt(0)" ::: "memory")
typedef __bf16 bf16x2_t __attribute__((ext_vector_type(2)));
__device__ __forceinline__ unsigned pk2(float lo, float hi) { bf16x2_t v; v.x = (__bf16)lo; v.y = (__bf16)hi; return __builtin_bit_cast(unsigned, v); }
__device__ __forceinline__ unsigned f2bf(float f) { return (unsigned)__builtin_bit_cast(unsigned short, (__bf16)f); }
__device__ __forceinline__ float bf2f(unsigned short b) { return __builtin_bit_cast(float, (unsigned)b << 16); }
__device__ __forceinline__ float sigm(float x) { return __builtin_amdgcn_rcpf(1.0f + __expf(-x)); }
__device__ __forceinline__ float silu(float x) { return x * __builtin_amdgcn_rcpf(1.0f + __expf(-x)); }
#define XB_TMO      128
#define XB_XCNT(j)  (256  + 64 * (j))
#define XB_XSUB(j)  (1280 + 64 * (j))
#define XB_XGEN(j)  (2304 + 64 * (j))
#define XB_TOP      3328
#define XB_TOPGEN   3392
#define XB_EXIT     3456
#define XB_T64      3520
#define XB_WD2      3584
#define XB_T64A     3648
#define XB_WD1      3712
#define XCD_BAR_WORDS 3776
#ifndef SELF_CLEAN
#define SELF_CLEAN 1
#endif
#if SELF_CLEAN
__device__ unsigned g_xbar[XCD_BAR_WORDS];
#endif
#define XB_SPIN_CAP (1u << 18)

__device__ __forceinline__ unsigned xb_ld(unsigned* p)              { return __hip_atomic_load(p, __ATOMIC_RELAXED, __HIP_MEMORY_SCOPE_AGENT); }
__device__ __forceinline__ unsigned xb_add(unsigned* p, unsigned v) { return __hip_atomic_fetch_add(p, v, __ATOMIC_RELAXED, __HIP_MEMORY_SCOPE_AGENT); }
__device__ __forceinline__ unsigned xb_xcc_id() { return (unsigned)__builtin_amdgcn_s_getreg((3 << 11) | 20) & 0xFu; }
#define XB_SPIN(cond, bar) do { unsigned _sp = 0; while (cond) { __builtin_amdgcn_s_sleep(1); \
    if ((++_sp & 255u) == 0u) { if (xb_ld(&(bar)[XB_TMO])) break; if (_sp > XB_SPIN_CAP) { atomicAdd(&(bar)[XB_TMO], 1u); break; } } } } while (0)

struct XcdBarrier {
    unsigned* bar; unsigned x;
    volatile LAS unsigned* st;
};

__device__ __forceinline__ XcdBarrier xcd_barrier_post(unsigned* bar, volatile LAS unsigned* st) {
    XcdBarrier b; b.bar = bar; b.x = xb_xcc_id(); b.st = st;
    if (threadIdx.x == 0) (void)xb_add(&bar[XB_XCNT(b.x)], 1u);
    return b;
}
__device__ __forceinline__ void xcd_barrier_complete(unsigned* bar, unsigned x, unsigned& nloc, unsigned& nx) {
    const unsigned G = gridDim.x * gridDim.y * gridDim.z;
    unsigned sum, cnt, mine, sp = 0u;
    for (;;) {
        sum = 0u; cnt = 0u; mine = 0u;
#pragma unroll
        for (unsigned j = 0; j < 16; ++j) { const unsigned c = xb_ld(&bar[XB_XCNT(j)]); sum += c; cnt += (c > 0u) ? 1u : 0u; mine = (j == x) ? c : mine; }
        if (sum == G) break;
        __builtin_amdgcn_s_sleep(1);
        if ((++sp & 255u) == 0u) { if (xb_ld(&bar[XB_TMO])) break; if (sp > XB_SPIN_CAP) { atomicAdd(&bar[XB_TMO], 1u); break; } }
    }
    nloc = mine > 0u ? mine : 1u; nx = cnt > 0u ? cnt : 1u;
}

__device__ __forceinline__ void xcd_barrier(const XcdBarrier& b) {
    asm volatile("s_waitcnt vmcnt(0)" ::: "memory");
    __syncthreads();
    if (threadIdx.x == 0) {
        unsigned* bar = b.bar;
        __builtin_amdgcn_s_waitcnt(0);
        unsigned nloc = b.st[0], nx = b.st[1];
        if (nloc == 0u) { xcd_barrier_complete(bar, b.x, nloc, nx); b.st[0] = nloc; b.st[1] = nx; }
        const unsigned old = xb_add(&bar[XB_XSUB(b.x)], 1u);
        const unsigned gen = old / nloc;
        if (old + 1u == (gen + 1u) * nloc) {
            __builtin_amdgcn_fence(__ATOMIC_RELEASE, "agent");
            asm volatile("s_waitcnt vmcnt(0)" ::: "memory");
            const unsigned og = xb_add(&bar[XB_TOP], 1u);
            const unsigned tg = og / nx;
            if (og + 1u == (tg + 1u) * nx) xb_add(&bar[XB_TOPGEN], 1u);
            else XB_SPIN(xb_ld(&bar[XB_TOPGEN]) == tg, bar);
            xb_add(&bar[XB_XGEN(b.x)], 1u);
            __builtin_amdgcn_fence(__ATOMIC_ACQUIRE, "agent");
            asm volatile("s_waitcnt vmcnt(0)" ::: "memory");
        } else {
            XB_SPIN(xb_ld(&bar[XB_XGEN(b.x)]) == gen, bar);
            __builtin_amdgcn_fence(__ATOMIC_ACQUIRE, "agent");
            asm volatile("s_waitcnt vmcnt(0)" ::: "memory");
        }
    }
    __syncthreads();
}
struct Frame {
    LAS unsigned char* lds;
    volatile LAS unsigned* MISC;
    gu32* ctl;
    int tid, lane, wave, vcu, G;
    GAS float* out; GAS unsigned char* ws;
};
#define WSP(T, off) ((T*)(F.ws + (off)))
#define OUTP(off) ((float*)(F.out + (off)))
#define UTHP ((bf16*)OUTP(O_YP))
constexpr int TAB_OFF = MISC_OFF + 256;
__device__ __forceinline__ const float* inp(const Frame& F, int k) {
    const unsigned long long v = ((const LAS unsigned long long*)(F.lds + TAB_OFF))[k];
    const unsigned lo = __builtin_amdgcn_readfirstlane((unsigned)v), hi = __builtin_amdgcn_readfirstlane((unsigned)(v >> 32));
    return (const float*)(const GAS float*)(((unsigned long long)hi << 32) | lo);
}
__device__ __forceinline__ float wave_sum(float v) {
#pragma unroll
    for (int o = 1; o < 64; o <<= 1) v += __shfl_xor(v, o);
    return v;
}
__device__ __forceinline__ float half_sum32(float v) {
#pragma unroll
    for (int o = 1; o < 32; o <<= 1) v += __shfl_xor(v, o);
    return v;
}
__device__ __forceinline__ float rowsum16(const float (&v)[16], int lane, int& rsel) {
    const bool b4 = (lane & 16) != 0, b3 = (lane & 8) != 0, b2 = (lane & 4) != 0, b1 = (lane & 2) != 0;
    float a[8], b[4], c2[2];
#pragma unroll
    for (int j = 0; j < 8; ++j) { const float t = __shfl_xor(b4 ? v[j] : v[j + 8], 16); a[j] = (b4 ? v[j + 8] : v[j]) + t; }
#pragma unroll
    for (int j = 0; j < 4; ++j) { const float t = __shfl_xor(b3 ? a[j] : a[j + 4], 8); b[j] = (b3 ? a[j + 4] : a[j]) + t; }
#pragma unroll
    for (int j = 0; j < 2; ++j) { const float t = __shfl_xor(b2 ? b[j] : b[j + 2], 4); c2[j] = (b2 ? b[j + 2] : b[j]) + t; }
    float d = (b1 ? c2[1] : c2[0]) + __shfl_xor(b1 ? c2[0] : c2[1], 2);
    d += __shfl_xor(d, 1);
    rsel = (b4 ? 8 : 0) + (b3 ? 4 : 0) + (b2 ? 2 : 0) + (b1 ? 1 : 0);
    return d;
}
__device__ __forceinline__ void tr_item(const float* W, int N, int K, int k0, int n0, const float* nw, bf16* dst, LAS float* scr, int lane) {
    float v[32];
    const int n = n0 + (lane & 31);
#pragma unroll
    for (int i = 0; i < 32; ++i) { const int kk = 2 * i + (lane >> 5); v[i] = (n < N) ? W[(size_t)(k0 + kk) * N + n] : 0.f; }
    if (nw) {
#pragma unroll
        for (int i = 0; i < 32; ++i) v[i] *= nw[k0 + 2 * i + (lane >> 5)];
    }
#pragma unroll
    for (int i = 0; i < 32; ++i) scr[(2 * i + (lane >> 5)) * 33 + (lane & 31)] = v[i];
    LDS_WAIT(); asm volatile("" ::: "memory");
    const int c = lane & 7;
#pragma unroll
    for (int j = 0; j < 4; ++j) { const int nn = (lane >> 3) + 8 * j; const LAS float* s = scr + (8 * c) * 33 + nn;
        v4u o; o.x = pk2(s[0 * 33], s[1 * 33]); o.y = pk2(s[2 * 33], s[3 * 33]); o.z = pk2(s[4 * 33], s[5 * 33]); o.w = pk2(s[6 * 33], s[7 * 33]);
        *(GAS v4u*)(dst + (size_t)nn * K + k0 + 8 * c) = o; }
    LDS_WAIT(); asm volatile("" ::: "memory");
}
constexpr int P0_I_GU = 16 * 88, P0_I_IN = 16 * 120, P0_I_OUT = 16 * 32, P0_NITEMS = 6 * P0_I_GU + P0_I_IN + P0_I_OUT, P0_ITEMS_FIRST = 2 * P0_I_GU;
__device__ __forceinline__ void p0_weight_items(Frame& F, int lo, int hi, int iw, int nw_) {
    LAS float* scr = (LAS float*)(F.lds + F.wave * 16384);
    const int lane = F.lane;
    constexpr int I_GU = P0_I_GU, I_DN = 44 * 32, I_IN = P0_I_IN;
    static_assert(I_DN == I_GU, "items");
    for (int it = lo + iw; it < hi; it += nw_) {
        int r = it;
        if (r < 6 * I_GU) {
            const int which = r / I_GU; r -= which * I_GU;
            const int ffn = which / 3, kind = which % 3;
            if (kind < 2) {
                const int kb = r / 88, nb = r % 88, n0 = 32 * nb, k0 = 64 * kb;
                const float* W = ffn ? (kind ? inp(F, 23) : inp(F, 22)) : (kind ? inp(F, 9) : inp(F, 8)); const float* nw = ffn ? inp(F, 21) : inp(F, 7);
                bf16* base = WSP(bf16, ffn ? WS_WGU2 : WS_WGU1);
                const int drow = 256 * (n0 >> 7) + (n0 & 127) + 128 * kind;
                tr_item(W, FF, 1024, k0, n0, nw, base + (size_t)drow * 1024, scr, lane);
            } else {
                const int kb = r / 32, nb = r % 32, n0 = 32 * nb, k0 = 64 * kb;
                const float* W = ffn ? inp(F, 24) : inp(F, 10);
                bf16* base = WSP(bf16, ffn ? WS_WD2 : WS_WD1);
                tr_item(W, 1024, FF, k0, n0, nullptr, base + (size_t)n0 * FF, scr, lane);
            }
            continue;
        }
        r -= 6 * I_GU;
        if (r < I_IN) { const int kb = r / 120, nb = r % 120, n0 = 32 * nb, k0 = 64 * kb;
            tr_item(inp(F, 12), NIN, 1024, k0, n0, inp(F, 11), WSP(bf16, WS_WIN) + (size_t)n0 * 1024, scr, lane); continue; }
        r -= I_IN;
        { const int kb = r / 32, nb = r % 32, n0 = 32 * nb, k0 = 64 * kb;
          tr_item(inp(F, 20), 1024, 1024, k0, n0, nullptr, WSP(bf16, WS_WOUT) + (size_t)n0 * 1024, scr, lane); }
    }
}
__device__ __forceinline__ void p0_prologue(Frame& F, int defer) {
    const int gw = F.vcu * NWAVES + F.wave, NGW = F.G * NWAVES, lane = F.lane;
    p0_weight_items(F, 0, defer ? P0_ITEMS_FIRST : P0_NITEMS, gw, NGW);
    bf16* HB = WSP(bf16, WS_HB); float* RS1 = WSP(float, WS_SS1); float* HX0 = WSP(float, WS_HX0);
    {
        const float* x0 = inp(F, 0); const float* xm = inp(F, 5); const float* xs = inp(F, 1);
#define ROWSRC(m) ((m) < MP ? x0 + (size_t)(m) * D : (m) < ROW_SMP ? xm + (size_t)((m) - ROW_META) * D : (m) < ROW_SMP + NSMP ? xs + (size_t)((m) - ROW_SMP) * D : nullptr)
        f32x4 nx[4];
        { const float* src = gw < M ? ROWSRC(gw) : nullptr;
#pragma unroll
          for (int j = 0; j < 4; ++j) nx[j] = src ? ((const GAS f32x4*)src)[lane + 64 * j] : (f32x4){0.f, 0.f, 0.f, 0.f}; }
        for (int m = gw; m < M; m += NGW) {
            f32x4 v[4]; float s = 0.f;
#pragma unroll
            for (int j = 0; j < 4; ++j) v[j] = nx[j];
            { const int mn = m + NGW; const float* src = mn < M ? ROWSRC(mn) : nullptr;
#pragma unroll
              for (int j = 0; j < 4; ++j) nx[j] = src ? ((const GAS f32x4*)src)[lane + 64 * j] : (f32x4){0.f, 0.f, 0.f, 0.f}; }
#pragma unroll
            for (int j = 0; j < 4; ++j) s += (v[j][0] * v[j][0] + v[j][1] * v[j][1]) + (v[j][2] * v[j][2] + v[j][3] * v[j][3]);
            s = wave_sum(s);
            GAS unsigned long long* o8 = (GAS unsigned long long*)(HB + (size_t)m * D) + lane;
#pragma unroll
            for (int j = 0; j < 4; ++j) o8[64 * j] = (unsigned long long)pk2(v[j][0], v[j][1]) | ((unsigned long long)pk2(v[j][2], v[j][3]) << 32);
            if (lane == 0) RS1[m] = 1.0f / sqrtf(s * (1.0f / 1024.0f) + EPS);
            if (m >= MP) {
#pragma unroll
                for (int j = 0; j < 4; ++j) ((GAS f32x4*)(HX0 + (size_t)(m - MP) * D))[lane + 64 * j] = v[j];
            }
        }
#undef ROWSRC
    }
    if (gw >= NGW - 8) { float* LB = WSP(float, WS_LB); const float* l = inp(F, 6);
        const int c = (gw - (NGW - 8)) * 64 + lane; LB[c] = 1.0f / (1.0f + __expf(l[512 + c] - l[c])); }
}
template <int ppu> __device__ __forceinline__ void fix_extra(Frame& F, int split, const float* slab, const float* RX, float* DX, bf16* HB, const float* SS, float* RSTD, float scale) {
    const int lane = F.lane;
    {   const int nrows = split ? MP : M;
        for (int r0 = F.vcu * 64; r0 < nrows; r0 += F.G * 64) { const int r = r0 + lane; if (F.wave == NWAVES - 1 && r < nrows) RSTD[r] = pg8::row_rstd(SS, r); } }
    if (split) {
        LAS float* red = (LAS float*)F.lds;
        for (int lr = F.vcu; lr < 256; lr += F.G) {
            if (F.wave < 4) {
                const int j = F.wave;
                const float* sp = slab + (size_t)j * ppu * 65536 + (size_t)lr * 256 + 4 * lane; f32x4 sum = (f32x4){0.f, 0.f, 0.f, 0.f};
                f32x4 v = (f32x4){0.f, 0.f, 0.f, 0.f};
                if (lr < pg8::SLICE_ROWS) {
#pragma unroll
                for (int p = 0; p < ppu; ++p) sum = sum + *(const GAS f32x4*)(sp + (size_t)p * 65536);
                v = ((const GAS f32x4*)(RX + (size_t)lr * 1024))[lane + 64 * j] + sum * scale; }
                const float ss = wave_sum((v[0] * v[0] + v[1] * v[1]) + (v[2] * v[2] + v[3] * v[3]));
                ((GAS f32x4*)(DX + (size_t)lr * 1024))[lane + 64 * j] = v;
                ((GAS unsigned long long*)(HB + (size_t)(MP + lr) * 1024))[lane + 64 * j] = (unsigned long long)pk2(v[0], v[1]) | ((unsigned long long)pk2(v[2], v[3]) << 32);
                if (lane == 0) red[j] = ss;
            }
            __syncthreads();
            if (F.tid == 0) RSTD[MP + lr] = 1.0f / sqrtf(((red[0] + red[1]) + (red[2] + red[3])) * (1.0f / 1024.0f) + EPS);
            __syncthreads();
        }
    }

}
template <int ppu> __device__ __forceinline__ void p8_final(Frame& F, int split, const float* slab) {
    const int gw = F.vcu * NWAVES + F.wave, NGW = F.G * NWAVES, lane = F.lane;
    const float* SS4 = WSP(float, WS_SS4); const float* nf = inp(F, 25);
    f32x4 w[4];
#pragma unroll
    for (int j = 0; j < 4; ++j) w[j] = ((const GAS f32x4*)nf)[lane + 64 * j];
    if (split && F.G >= NSMP) {
        const int s = (int)blockIdx.x;
        if (s < NSMP) {
            const int lr = NMETA + s, j = F.wave & 3, hf = F.wave >> 2;
            LAS f32x4* part = (LAS f32x4*)F.lds; LAS float* red = (LAS float*)(F.lds + 8192);
            const float* sp = slab + (size_t)j * ppu * 65536 + (size_t)lr * 256 + 4 * lane; f32x4 sum = (f32x4){0.f, 0.f, 0.f, 0.f};
            constexpr int ph = (ppu + 1) / 2;
#pragma unroll
            for (int p = 0; p < ph; ++p) { const int pp = hf * ph + p; if (pp < ppu) sum = sum + *(const GAS f32x4*)(sp + (size_t)pp * 65536); }
            part[F.wave * 64 + lane] = sum;
            __syncthreads();
            f32x4 v = (f32x4){0.f, 0.f, 0.f, 0.f};
            if (hf == 0) { v = ((const GAS f32x4*)(WSP(float, WS_HX) + (size_t)lr * D))[lane + 64 * j] + (part[j * 64 + lane] + part[(j + 4) * 64 + lane]) * 0.5f;
                const float ss = wave_sum((v[0] * v[0] + v[1] * v[1]) + (v[2] * v[2] + v[3] * v[3])); if (lane == 0) red[j] = ss; }
            __syncthreads();
            if (hf == 0) { const float rs = __builtin_amdgcn_rsqf(((red[0] + red[1]) + (red[2] + red[3])) * (1.0f / 1024.0f) + EPS);
                ((GAS f32x4*)(OUTP(O_YS) + (size_t)s * D))[lane + 64 * j] = v * rs * w[j]; }
        }
        return;
    }
    for (int m = split ? MP + gw : gw; m < MP + NSMP; m += NGW) {
        if (m < MP) {
            float* p = OUTP(O_YP) + (size_t)m * D;
            const float rs = pg8::row_rstd(SS4, m);
#pragma unroll
            for (int j = 0; j < 4; ++j) { f32x4 v = ((const GAS f32x4*)p)[lane + 64 * j]; v = v * rs * w[j]; ((GAS f32x4*)p)[lane + 64 * j] = v; }
        } else {
            const int s = m - MP, lr = NMETA + s; const float* src = WSP(float, WS_HX) + (size_t)lr * D; float* dst = OUTP(O_YS) + (size_t)s * D;
            f32x4 v[4]; float ss = 0.f;
#pragma unroll
            for (int j = 0; j < 4; ++j) { v[j] = ((const GAS f32x4*)src)[lane + 64 * j];
                if (split) { const float* sp = slab + (size_t)j * ppu * 65536 + (size_t)lr * 256 + 4 * lane; f32x4 sum = (f32x4){0.f, 0.f, 0.f, 0.f};
#pragma unroll
                    for (int p = 0; p < ppu; ++p) sum = sum + *(const GAS f32x4*)(sp + (size_t)p * 65536);
                    v[j] = v[j] + sum * 0.5f; }
                ss += (v[j][0] * v[j][0] + v[j][1] * v[j][1]) + (v[j][2] * v[j][2] + v[j][3] * v[j][3]); }
            const float rs = split ? 1.0f / sqrtf(wave_sum(ss) * (1.0f / 1024.0f) + EPS) : pg8::row_rstd(SS4, ROW_SMP + s);
#pragma unroll
            for (int j = 0; j < 4; ++j) ((GAS f32x4*)dst)[lane + 64 * j] = v[j] * rs * w[j];
        }
    }
}
__device__ __forceinline__ int rowreg(int reg, int lane) { return (reg & 3) + 8 * (reg >> 2) + 4 * (lane >> 5); }
template <int K> __device__ __forceinline__ void mma32_ll(f32x16& acc, const LAS bf16* A, int lda, const LAS bf16* B, int ldb, int lane) {
    const LAS bf16* pa = A + (lane & 31) * lda + 8 * (lane >> 5); const LAS bf16* pb = B + (lane & 31) * ldb + 8 * (lane >> 5);
#pragma unroll
    for (int k0 = 0; k0 < K; k0 += 16) { const bf16x8 a = *(const LAS bf16x8*)(pa + k0); const bf16x8 b = *(const LAS bf16x8*)(pb + k0); acc = __builtin_amdgcn_mfma_f32_32x32x16_bf16(a, b, acc, 0, 0, 0); }
}
template <int K> __device__ __forceinline__ void mma32_lg(f32x16& acc, const LAS bf16* A, int lda, const bf16* Bg, int ldb, int lane) {
    const LAS bf16* pa = A + (lane & 31) * lda + 8 * (lane >> 5); const bf16* pb = Bg + (size_t)(lane & 31) * ldb + 8 * (lane >> 5);
#pragma unroll
    for (int kc = 0; kc < K; kc += 64) {
        bf16x8 b[4];
#pragma unroll
        for (int k = 0; k < 4; ++k) b[k] = *(const GAS bf16x8*)(pb + kc + 16 * k);
#pragma unroll
        for (int k = 0; k < 4; ++k) { const bf16x8 a = *(const LAS bf16x8*)(pa + kc + 16 * k); acc = __builtin_amdgcn_mfma_f32_32x32x16_bf16(a, b[k], acc, 0, 0, 0); }
        asm volatile("" ::: "memory");
    }
}
__device__ __forceinline__ void load_frags8(const bf16* Bg, int ldb, int lane, bf16x8 (&b)[8]) {
    const bf16* pb = Bg + (size_t)(lane & 31) * ldb + 8 * (lane >> 5);
#pragma unroll
    for (int k = 0; k < 8; ++k) b[k] = *(const GAS bf16x8*)(pb + 16 * k);
}
__device__ __forceinline__ void mma32_lf8(f32x16& acc, const LAS bf16* A, int lda, const bf16x8 (&b)[8], int lane) {
    const LAS bf16* pa = A + (lane & 31) * lda + 8 * (lane >> 5);
#pragma unroll
    for (int k = 0; k < 8; ++k) { const bf16x8 a = *(const LAS bf16x8*)(pa + 16 * k); acc = __builtin_amdgcn_mfma_f32_32x32x16_bf16(a, b[k], acc, 0, 0, 0); }
}
#define ZERO16 ((f32x16){0.f,0.f,0.f,0.f,0.f,0.f,0.f,0.f,0.f,0.f,0.f,0.f,0.f,0.f,0.f,0.f})

struct HgP { int rowbase, h, nvalid, ent, eidx; };
__device__ __forceinline__ HgP hg_params(int i) {
    HgP p;
    if (i < 1024) { const int b = i >> 7, h = (i >> 5) & 3, c = i & 31; p.rowbase = b * SEQ + c * CH; p.h = h; p.nvalid = CH; p.ent = (b * 4 + h) * 32 + c; p.eidx = b * 32 + c; }
    else { const int h = i - 1024; p.rowbase = ROW_META; p.h = h; p.nvalid = NMETA; p.ent = 1024 + h; p.eidx = 256; }
    return p;
}
struct HgRaw { v4u fz[2]; v4u vb[2]; v4u qz[2]; v4u gb[2]; };
template <int PASS> __device__ __forceinline__ void hg_load(Frame& F, const HgP& p, HgRaw& r) {
    const int tid = F.tid;
    const bf16* FZ = WSP(bf16, WS_FZ) + (size_t)p.rowbase * 512 + 128 * p.h;
#pragma unroll
    for (int i = 0; i < 2; ++i) { const int idx = tid + 512 * i; r.fz[i] = *(const GAS v4u*)(FZ + (size_t)(idx >> 4) * 512 + (idx & 15) * 8); }
    const bf16* VB = WSP(bf16, WS_VB) + (size_t)p.rowbase * 512 + 128 * p.h;
#pragma unroll
    for (int i = 0; i < 2; ++i) { const int idx = tid + 512 * i; r.vb[i] = *(const GAS v4u*)(VB + (size_t)(idx >> 4) * 512 + (idx & 15) * 8); }
    if (PASS == 3) { const bf16* QZ = WSP(bf16, WS_QZ) + (size_t)p.rowbase * 1024 + 128 * p.h;
#pragma unroll
        for (int i = 0; i < 2; ++i) { const int idx = tid + 512 * i; r.qz[i] = *(const GAS v4u*)(QZ + (size_t)(idx >> 4) * 1024 + (idx & 15) * 8); }
        const bf16* GB = WSP(bf16, WS_GB) + (size_t)p.rowbase * 512 + 128 * p.h;
#pragma unroll
        for (int i = 0; i < 2; ++i) { const int idx = tid + 512 * i; r.gb[i] = *(const GAS v4u*)(GB + (size_t)(idx >> 4) * 512 + (idx & 15) * 8); } }
}
template <int PASS> __device__ __forceinline__ void hgrn_item(Frame& F, const HgP p, HgRaw& raw, bool has_next, const HgP pn) {
    LAS unsigned char* L = F.lds;
    LAS float* TOT = (LAS float*)L;
    LAS float* FZL = (LAS float*)(L + 2048);
    LAS bf16* VL = (LAS bf16*)(L + 35840);
    LAS bf16* QN = (LAS bf16*)(L + 53248);
    LAS bf16* KN = (LAS bf16*)(L + 70656);
    LAS bf16* VT = (LAS bf16*)(L + 88064);
    LAS bf16* KT = (LAS bf16*)(L + 106496);
    LAS bf16* PP = (LAS bf16*)(L + 106496);
    LAS float* PART = (LAS float*)(L + 124928);
    LAS float* RS = (LAS float*)(L + 125952);
    const int tid = F.tid, lane = F.lane, w = F.wave, c = tid & 127, rg = tid >> 7;
    const int rowbase = p.rowbase, h = p.h;
#pragma unroll
    for (int i = 0; i < 2; ++i) { const int idx = tid + 512 * i; const v4u u = raw.fz[i]; LAS float* d = FZL + (idx >> 4) * 132 + (idx & 15) * 8;
        *(LAS f32x4*)d = (f32x4){__builtin_bit_cast(float, u.x << 16), __builtin_bit_cast(float, u.x & 0xffff0000u), __builtin_bit_cast(float, u.y << 16), __builtin_bit_cast(float, u.y & 0xffff0000u)};
        *(LAS f32x4*)(d + 4) = (f32x4){__builtin_bit_cast(float, u.z << 16), __builtin_bit_cast(float, u.z & 0xffff0000u), __builtin_bit_cast(float, u.w << 16), __builtin_bit_cast(float, u.w & 0xffff0000u)}; }
#pragma unroll
    for (int i = 0; i < 2; ++i) { const int idx = tid + 512 * i; *(LAS v4u*)(VL + (idx >> 4) * 136 + (idx & 15) * 8) = raw.vb[i]; if (PASS == 3) *(LAS v4u*)(QN + (idx >> 4) * 136 + (idx & 15) * 8) = raw.qz[i]; }
    v4u gbr[2]; if (PASS == 3) { gbr[0] = raw.gb[0]; gbr[1] = raw.gb[1]; }
    if (has_next) hg_load<PASS>(F, pn, raw);
    const float lbc = WSP(float, WS_LB)[128 * h + c];
    __syncthreads();
    float bl[16], kk[16], run = 0.f;
#pragma unroll
    for (int i = 0; i < 16; ++i) {
        const int t = rg * 16 + i; const float fz = FZL[t * 132 + c];
        const float sg = sigm(fz), f = lbc + (1.0f - lbc) * sg; float lf = __logf(f), k = (1.0f - lbc) * (1.0f - sg);
        if (t >= p.nvalid) { lf = 0.f; k = 0.f; }
        run += lf; bl[i] = run; kk[i] = k;
    }
    TOT[rg * 128 + c] = run;
    __syncthreads();
    const float t0 = TOT[c], t1 = TOT[128 + c], t2 = TOT[256 + c], t3 = TOT[384 + c];
    const float pre = rg == 0 ? 0.f : rg == 1 ? t0 : rg == 2 ? t0 + t1 : (t0 + t1) + t2;
    const float r = t0 + t1, blast = (t0 + t1) + (t2 + t3);
    unsigned pvv[8];
#pragma unroll
    for (int i = 0; i < 16; i += 2) pvv[i >> 1] = (unsigned)VL[(rg * 16 + i) * 136 + c] | ((unsigned)VL[(rg * 16 + i + 1) * 136 + c] << 16);
    *(LAS v4u*)(VT + c * 72 + rg * 16) = (v4u){pvv[0], pvv[1], pvv[2], pvv[3]}; *(LAS v4u*)(VT + c * 72 + rg * 16 + 8) = (v4u){pvv[4], pvv[5], pvv[6], pvv[7]};
    if (PASS == 1) {
        unsigned pkk[8];
#pragma unroll
        for (int i = 0; i < 16; i += 2) pkk[i >> 1] = pk2(kk[i] * __expf(r - (pre + bl[i])), kk[i + 1] * __expf(r - (pre + bl[i + 1])));
        *(LAS v4u*)(KT + c * 72 + rg * 16) = (v4u){pkk[0], pkk[1], pkk[2], pkk[3]}; *(LAS v4u*)(KT + c * 72 + rg * 16 + 8) = (v4u){pkk[4], pkk[5], pkk[6], pkk[7]};
        if (rg == 0) { WSP(float, WS_ER)[(size_t)p.eidx * 512 + 128 * h + c] = __expf(r); WSP(float, WS_EL)[(size_t)p.eidx * 512 + 128 * h + c] = __expf(blast - r); }
        __syncthreads();
        bf16* UT = UTHP + (size_t)p.ent * UTH_ENT;
        LAS bf16* OUT = (LAS bf16*)(L + 2048);
        const int vt = w >> 1;
#pragma unroll
        for (int q = 0; q < 2; ++q) {
            const int kt = (w & 1) * 2 + q;
            f32x16 acc = ZERO16;
            mma32_ll<64>(acc, VT + vt * 32 * 72, 72, KT + kt * 32 * 72, 72, lane);
#pragma unroll
            for (int reg = 0; reg < 16; ++reg) OUT[(vt * 32 + rowreg(reg, lane)) * 136 + kt * 32 + (lane & 31)] = (bf16)f2bf(acc[reg]);
        }
        __syncthreads();
#pragma unroll
        for (int i = 0; i < 4; ++i) { const int idx = tid + 512 * i, row = idx >> 4, pc = idx & 15; *(GAS v4u*)(UT + (size_t)row * 128 + pc * 8) = *(const LAS v4u*)(OUT + row * 136 + pc * 8); }
        __syncthreads();
    } else {
#pragma unroll
        for (int i = 0; i < 2; ++i) { const int idx = tid + 512 * i; *(LAS v4u*)((LAS bf16*)(L + 2048) + (idx >> 4) * 136 + (idx & 15) * 8) = gbr[i]; }
#pragma unroll
        for (int i = 0; i < 16; ++i) {
            const int t = rg * 16 + i; const float b = pre + bl[i];
            QN[t * 136 + c] = (bf16)f2bf(bf2f(QN[t * 136 + c]) * __expf(b - r));
            KN[t * 136 + c] = (bf16)f2bf(kk[i] * __expf(r - b));
        }
        __syncthreads();
        bf16x8 sfr[8];
        load_frags8(UTHP + (size_t)p.ent * UTH_ENT + (size_t)(w & 3) * 32 * 128, 128, lane, sfr);
        if (w < 4) {
            const int tm = w >> 1, sn = w & 1;
            f32x16 acc = ZERO16;
            if (!(tm == 0 && sn == 1)) mma32_ll<128>(acc, QN + tm * 32 * 136, 136, KN + sn * 32 * 136, 136, lane);
#pragma unroll
            for (int reg = 0; reg < 16; ++reg) { const int t = tm * 32 + rowreg(reg, lane), s = sn * 32 + (lane & 31);
                PP[t * 72 + s] = (s <= t) ? (bf16)f2bf(acc[reg]) : (bf16)0; }
        }
        __syncthreads();
        const int tm = w >> 2, vn = w & 3;
        f32x16 acc = ZERO16;
        mma32_ll<64>(acc, PP + tm * 32 * 72, 72, VT + vn * 32 * 72, 72, lane);
        mma32_lf8(acc, QN + tm * 32 * 136, 136, sfr, lane);
        { float sqv[16]; int rsel;
#pragma unroll
          for (int reg = 0; reg < 16; ++reg) sqv[reg] = acc[reg] * acc[reg];
          const float sq = rowsum16(sqv, lane, rsel); if ((lane & 1) == 0) PART[(tm * 32 + rowreg(rsel, lane)) * 4 + vn] = sq; }
        __syncthreads();
        if (tid < 64) RS[tid] = 1.0f / sqrtf(((PART[tid * 4] + PART[tid * 4 + 1]) + (PART[tid * 4 + 2] + PART[tid * 4 + 3])) * (1.0f / 128.0f) + EPS);
        __syncthreads();
        bf16* QZ = WSP(bf16, WS_QZ);
        LAS bf16* OUT = (LAS bf16*)(L + 2048);
#pragma unroll
        for (int reg = 0; reg < 16; ++reg) { const int t = tm * 32 + rowreg(reg, lane), v = vn * 32 + (lane & 31);
            OUT[t * 136 + v] = (bf16)f2bf(acc[reg] * RS[t] * bf2f(OUT[t * 136 + v])); }
        __syncthreads();
#pragma unroll
        for (int i = 0; i < 2; ++i) { const int idx = tid + 512 * i, row = idx >> 4, pc = idx & 15; *(GAS v4u*)(QZ + (size_t)(rowbase + row) * 1024 + 128 * h + pc * 8) = *(const LAS v4u*)(OUT + row * 136 + pc * 8); }
        __syncthreads();
    }
}

struct MbP { int rowbase, g, nvalid, ent0, estride; const bf16* prev; };
__device__ __forceinline__ bool mb_valid(int o, bool with_meta) { return o < 512 || (with_meta && o >= 516 && o < 518); }
__device__ __forceinline__ MbP mb_params(Frame& F, int j) {
    MbP p; const bf16* XBC = WSP(bf16, WS_XBC);
    if (j < 512) { const int b = j >> 6, g = (j >> 5) & 1, c = j & 31, rb = b * SEQ + c * CH; p.rowbase = rb; p.g = g; p.nvalid = CH; p.ent0 = (b * 8 + 4 * g) * 32 + c; p.estride = 32;
        p.prev = c > 0 ? XBC + (size_t)(rb - 3) * 1024 : XBC + (size_t)(ROW_META + 13) * 1024; }
    else { const int g = j - 516; p.rowbase = ROW_META; p.g = g; p.nvalid = NMETA; p.ent0 = 2048 + 4 * g; p.estride = 1; p.prev = nullptr; }
    return p;
}
struct MbRaw { v4u rx[4]; v4u halo; float dt; };
__device__ __forceinline__ int mb_bccol(int g, int pc) { return pc < 16 ? 512 + 128 * g + pc * 8 : 768 + 128 * g + (pc - 16) * 8; }
template <int PASS> __device__ __forceinline__ void mb_load(Frame& F, const MbP& p, MbRaw& r) {
    const int tid = F.tid; const bf16* X = WSP(bf16, WS_XBC) + (size_t)p.rowbase * 1024;
#pragma unroll
    for (int i = 0; i < 4; ++i) { const int idx = tid + 512 * i, row = idx >> 5, pc = idx & 31;
        r.rx[i] = *(const GAS v4u*)(X + (size_t)row * 1024 + 256 * p.g + pc * 8); }
    r.halo = (v4u){0u, 0u, 0u, 0u};
    if (p.prev && tid < 192) { const int hr = tid >> 6, pc = tid & 63; r.halo = *(const GAS v4u*)(p.prev + (size_t)hr * 1024 + (pc < 32 ? 256 * p.g + pc * 8 : mb_bccol(p.g, pc - 32))); }
    r.dt = 0.f;
    if (tid < 256) { const int t = tid & 63; if (t < p.nvalid) r.dt = WSP(float, WS_DT)[(size_t)(p.rowbase + t) * 8 + 4 * p.g + (tid >> 6)]; }
}
template <int PASS> __device__ __forceinline__ void mamba_item(Frame& F, const MbP p, MbRaw& raw, bool has_next, const MbP pn) {
    LAS unsigned char* L = F.lds;
    LAS float* CUM = (LAS float*)L;
    LAS float* DTV = (LAS float*)(L + 1024);
    LAS bf16* XT = (LAS bf16*)(L + 2048);
    LAS bf16* BT = (LAS bf16*)(L + 38912);
    LAS bf16* BN = (LAS bf16*)(L + 38912);
    LAS bf16* CN = (LAS bf16*)(L + 56320);
    LAS bf16* RAW = (LAS bf16*)(L + 73728);
    const int tid = F.tid, lane = F.lane, w = F.wave, g = p.g, rowbase = p.rowbase;
    if (w < 4) {
        const int head = 4 * g + w;
        const float dt = raw.dt;
        const float A = -__expf(inp(F, 17)[head]);
        float cum = dt * A;
#pragma unroll
        for (int o = 1; o < 64; o <<= 1) { const float n = __shfl_up(cum, o); if (lane >= o) cum += n; }
        const float last = __builtin_bit_cast(float, __builtin_amdgcn_readlane(__builtin_bit_cast(int, cum), 63));
        if (PASS == 1) { CUM[w * 64 + lane] = dt * __expf(last - cum); if (lane == 0) WSP(float, WS_DCY)[p.ent0 + w * p.estride] = __expf(last); }
        else { CUM[w * 64 + lane] = cum; DTV[w * 64 + lane] = dt; }
    }
#pragma unroll
    for (int i = 0; i < 4; ++i) { const int idx = tid + 512 * i; *(LAS v4u*)(RAW + ((idx >> 5) + 3) * 256 + (idx & 31) * 8) = raw.rx[i]; }
    if (tid < 192 && (tid & 63) < 32) *(LAS v4u*)(RAW + (tid >> 6) * 256 + (tid & 63) * 8) = raw.halo;
    __syncthreads();
    v4u rbc[4];
    {   const bf16* X = WSP(bf16, WS_XBC) + (size_t)rowbase * 1024;
#pragma unroll
        for (int i = 0; i < 4; ++i) { const int idx = tid + 512 * i, row = idx >> 5, pc = idx & 31;
            rbc[i] = (PASS == 3 || pc < 16) ? *(const GAS v4u*)(X + (size_t)row * 1024 + mb_bccol(g, pc)) : (v4u){0u, 0u, 0u, 0u}; } }
    const int ch = tid & 255, half = tid >> 8;
    const float* cw = inp(F, 14); const float* cbp = inp(F, 15);
    {
        const int col = 256 * g + ch;
        const float w0 = cw[col], w1 = cw[1024 + col], w2 = cw[2048 + col], w3 = cw[3072 + col], cb = cbp[col];
        float r0 = bf2f(RAW[(half * 32 + 0) * 256 + ch]), r1 = bf2f(RAW[(half * 32 + 1) * 256 + ch]), r2 = bf2f(RAW[(half * 32 + 2) * 256 + ch]);
        unsigned pk[16];
#pragma unroll
        for (int i = 0; i < 32; i += 2) {
            const int t = half * 32 + i;
            const float r3 = bf2f(RAW[(t + 3) * 256 + ch]), r4 = bf2f(RAW[(t + 4) * 256 + ch]);
            float a0 = silu(cb + w0 * r0 + w1 * r1 + w2 * r2 + w3 * r3), a1 = silu(cb + w0 * r1 + w1 * r2 + w2 * r3 + w3 * r4);
            if (PASS == 1) { a0 *= CUM[(ch >> 6) * 64 + t]; a1 *= CUM[(ch >> 6) * 64 + t + 1]; }
            pk[i >> 1] = pk2(a0, a1); r0 = r2; r1 = r3; r2 = r4;
        }
        LAS v4u* d = (LAS v4u*)(XT + ch * 72 + half * 32);
        d[0] = (v4u){pk[0], pk[1], pk[2], pk[3]}; d[1] = (v4u){pk[4], pk[5], pk[6], pk[7]}; d[2] = (v4u){pk[8], pk[9], pk[10], pk[11]}; d[3] = (v4u){pk[12], pk[13], pk[14], pk[15]};
    }
    __syncthreads();
#pragma unroll
    for (int i = 0; i < 4; ++i) { const int idx = tid + 512 * i; *(LAS v4u*)(RAW + ((idx >> 5) + 3) * 256 + (idx & 31) * 8) = rbc[i]; }
    if (tid < 192 && (tid & 63) >= 32) *(LAS v4u*)(RAW + (tid >> 6) * 256 + ((tid & 63) - 32) * 8) = raw.halo;
    if (has_next) mb_load<PASS>(F, pn, raw);
    __syncthreads();
    if (PASS == 3 || ch < 128) {
        const int col = ch < 128 ? 512 + 128 * g + ch : 768 + 128 * g + (ch - 128);
        const float w0 = cw[col], w1 = cw[1024 + col], w2 = cw[2048 + col], w3 = cw[3072 + col], cb = cbp[col];
        float r0 = bf2f(RAW[(half * 32 + 0) * 256 + ch]), r1 = bf2f(RAW[(half * 32 + 1) * 256 + ch]), r2 = bf2f(RAW[(half * 32 + 2) * 256 + ch]);
        unsigned pk[16];
#pragma unroll
        for (int i = 0; i < 32; i += 2) {
            const int t = half * 32 + i;
            const float r3 = bf2f(RAW[(t + 3) * 256 + ch]), r4 = bf2f(RAW[(t + 4) * 256 + ch]);
            const float a0 = silu(cb + w0 * r0 + w1 * r1 + w2 * r2 + w3 * r3), a1 = silu(cb + w0 * r1 + w1 * r2 + w2 * r3 + w3 * r4);
            if (PASS == 1) pk[i >> 1] = pk2(a0, a1);
            else { LAS bf16* dst = ch < 128 ? BN + ch : CN + (ch - 128); dst[t * 136] = (bf16)f2bf(a0); dst[(t + 1) * 136] = (bf16)f2bf(a1); }
            r0 = r2; r1 = r3; r2 = r4;
        }
        if (PASS == 1) { LAS v4u* d = (LAS v4u*)(BT + ch * 72 + half * 32);
            d[0] = (v4u){pk[0], pk[1], pk[2], pk[3]}; d[1] = (v4u){pk[4], pk[5], pk[6], pk[7]}; d[2] = (v4u){pk[8], pk[9], pk[10], pk[11]}; d[3] = (v4u){pk[12], pk[13], pk[14], pk[15]}; }
    }
    __syncthreads();
    bf16* UM = WSP(bf16, WS_UM);
    if (PASS == 1) {
        LAS bf16* OUT = (LAS bf16*)(L + 73728);
#pragma unroll
        for (int r = 0; r < 2; ++r) {
            const int hl = w >> 2, hd = 2 * r + hl, pt = (w >> 1) & 1;
#pragma unroll
            for (int q = 0; q < 2; ++q) {
                const int nt = (w & 1) * 2 + q;
                f32x16 acc = ZERO16;
                mma32_ll<64>(acc, XT + (hd * 64 + pt * 32) * 72, 72, BT + nt * 32 * 72, 72, lane);
#pragma unroll
                for (int reg = 0; reg < 16; ++reg) OUT[(hl * 64 + pt * 32 + rowreg(reg, lane)) * 136 + nt * 32 + (lane & 31)] = (bf16)f2bf(acc[reg]);
            }
            __syncthreads();
#pragma unroll
            for (int i = 0; i < 4; ++i) { const int idx = tid + 512 * i, hh = idx >> 10, row = (idx >> 4) & 63, pc = idx & 15;
                *(GAS v4u*)(UM + (size_t)(p.ent0 + (2 * r + hh) * p.estride) * UM_ENT + (size_t)row * 128 + pc * 8) = *(const LAS v4u*)(OUT + (hh * 64 + row) * 136 + pc * 8); }
            __syncthreads();
        }
    } else {
        LAS float* CB = (LAS float*)(L + 73728);
        LAS bf16* WW = (LAS bf16*)(L + 90624);
        LAS float* PART = (LAS float*)(L + 127488);
        LAS float* RS = (LAS float*)(L + 129536);
        bf16x8 hfr[8];
        load_frags8(UM + (size_t)(p.ent0 + (w >> 1) * p.estride) * UM_ENT + (size_t)(w & 1) * 32 * 128, 128, lane, hfr);
        v4u zr[4];
        { const bf16* Zg = WSP(bf16, WS_QZ) + (size_t)rowbase * 1024 + 512 + 256 * g;
#pragma unroll
          for (int i = 0; i < 4; ++i) { const int idx = tid + 512 * i; zr[i] = *(const GAS v4u*)(Zg + (size_t)(idx >> 5) * 1024 + (idx & 31) * 8); } }
        if (w < 4) {
            const int tm = w >> 1, sn = w & 1;
            if (!(tm == 0 && sn == 1)) {
                f32x16 acc = ZERO16;
                mma32_ll<128>(acc, CN + tm * 32 * 136, 136, BN + sn * 32 * 136, 136, lane);
#pragma unroll
                for (int reg = 0; reg < 16; ++reg) CB[(tm * 32 + rowreg(reg, lane)) * 66 + sn * 32 + (lane & 31)] = acc[reg];
            }
        }
        __syncthreads();
        {
            const int hd = tid >> 7, rem = tid & 127, t = rem >> 1, s0 = (rem & 1) * 32;
            const float ct = CUM[hd * 64 + t];
            unsigned pw[16];
#pragma unroll
            for (int j = 0; j < 32; j += 2) {
                const int s = s0 + j;
                const float a = (s <= t) ? CB[t * 66 + s] * __expf(ct - CUM[hd * 64 + s]) * DTV[hd * 64 + s] : 0.f;
                const float b = (s + 1 <= t) ? CB[t * 66 + s + 1] * __expf(ct - CUM[hd * 64 + s + 1]) * DTV[hd * 64 + s + 1] : 0.f;
                pw[j >> 1] = pk2(a, b);
            }
            __syncthreads();
#pragma unroll
            for (int i = 0; i < 4; ++i) { const int idx = tid + 512 * i, zt = idx >> 5, pc = idx & 31;
                *(LAS v4u*)((zt < 32 ? (LAS bf16*)(L + 38912) + zt * 264 : (LAS bf16*)(L + 73728) + (zt - 32) * 264) + pc * 8) = zr[i]; }
            LAS v4u* d = (LAS v4u*)(WW + (hd * 64 + t) * 72 + s0);
            d[0] = (v4u){pw[0], pw[1], pw[2], pw[3]}; d[1] = (v4u){pw[4], pw[5], pw[6], pw[7]}; d[2] = (v4u){pw[8], pw[9], pw[10], pw[11]}; d[3] = (v4u){pw[12], pw[13], pw[14], pw[15]};
        }
        __syncthreads();
        const int hd = w >> 1, pnn = w & 1, head = 4 * g + hd;
        const float Dk = inp(F, 18)[head];
        bf16* QZ = WSP(bf16, WS_QZ);
        const int chn = hd * 64 + pnn * 32 + (lane & 31);
        unsigned yzp[2][8];
#pragma unroll
        for (int tm = 0; tm < 2; ++tm) {
            const LAS bf16* ZL = tm == 0 ? (const LAS bf16*)(L + 38912) : (const LAS bf16*)(L + 73728);
            float sqv[16];
            f32x16 acc = ZERO16;
            mma32_lf8(acc, CN + tm * 32 * 136, 136, hfr, lane);
#pragma unroll
            for (int reg = 0; reg < 16; ++reg) acc[reg] *= __expf(CUM[hd * 64 + tm * 32 + rowreg(reg, lane)]);
            mma32_ll<64>(acc, WW + (hd * 64 + tm * 32) * 72, 72, XT + (hd * 64 + pnn * 32) * 72, 72, lane);
#pragma unroll
            for (int reg = 0; reg < 16; ++reg) {
                const int t = tm * 32 + rowreg(reg, lane);
                const float y = acc[reg] + Dk * bf2f(XT[chn * 72 + t]);
                const float v = y * bf2f(ZL[rowreg(reg, lane) * 264 + chn]);
                if (reg & 1) yzp[tm][reg >> 1] |= f2bf(v) << 16; else yzp[tm][reg >> 1] = f2bf(v);
                sqv[reg] = v * v;
            }
            { int rsel; const float sq = rowsum16(sqv, lane, rsel); if ((lane & 1) == 0) PART[(tm * 32 + rowreg(rsel, lane)) * 8 + w] = sq; }
            asm volatile("" ::: "memory");
        }
        __syncthreads();
        if (tid < 64) { float s = 0.f;
#pragma unroll
            for (int j = 0; j < 8; ++j) s += PART[tid * 8 + j];
            RS[tid] = 1.0f / sqrtf(s * (1.0f / 256.0f) + EPS); }
        __syncthreads();
        const float nw = inp(F, 19)[256 * g + chn];
        LAS bf16* OUT = (LAS bf16*)(L + 2048);
#pragma unroll
        for (int tm = 0; tm < 2; ++tm)
#pragma unroll
            for (int reg = 0; reg < 16; ++reg) { const int t = tm * 32 + rowreg(reg, lane);
                const float v = bf2f((unsigned short)((reg & 1) ? (yzp[tm][reg >> 1] >> 16) : (yzp[tm][reg >> 1] & 0xffffu)));
                OUT[t * 264 + chn] = (bf16)f2bf(v * RS[t] * nw); }
        __syncthreads();
#pragma unroll
        for (int i = 0; i < 4; ++i) { const int idx = tid + 512 * i, row = idx >> 5, pc = idx & 31; *(GAS v4u*)(QZ + (size_t)(rowbase + row) * 1024 + 512 + 256 * g + pc * 8) = *(const LAS v4u*)(OUT + row * 264 + pc * 8); }
        __syncthreads();
    }
}
__device__ __forceinline__ void unpack8(const v4u u, float (&f)[8]) {
    f[0] = bf2f((unsigned short)(u.x & 0xffffu)); f[1] = bf2f((unsigned short)(u.x >> 16)); f[2] = bf2f((unsigned short)(u.y & 0xffffu)); f[3] = bf2f((unsigned short)(u.y >> 16));
    f[4] = bf2f((unsigned short)(u.z & 0xffffu)); f[5] = bf2f((unsigned short)(u.z >> 16)); f[6] = bf2f((unsigned short)(u.w & 0xffffu)); f[7] = bf2f((unsigned short)(u.w >> 16));
}
__device__ __forceinline__ void p4b_scan(Frame& F) {
    const int gt0 = F.vcu * (NWAVES * 64) + F.tid, NT = F.G * NWAVES * 64;
    const float* ER = WSP(float, WS_ER); const float* EL = WSP(float, WS_EL); const float* DCY = WSP(float, WS_DCY);
    for (int gt = gt0; gt < 131072; gt += NT) {
        const int idx = (NT == 131072) ? ((F.wave < 4 ? 0 : 65536) + (gt >> 9) * 256 + (gt & 255)) : gt;
        float S[8];
#pragma unroll
        for (int j = 0; j < 8; ++j) S[j] = 0.f;
        if (idx < 65536) {
            const int bh = idx >> 11, rem = idx & 2047, v = rem >> 4, kd8 = (rem & 15) * 8, b = bh >> 2, h = bh & 3;
            bf16* UTH = UTHP + (size_t)v * 128 + kd8;
            {
                float uu[8]; unpack8(*(const GAS v4u*)(UTH + (size_t)(1024 + h) * UTH_ENT), uu);
                const float* el = EL + (size_t)256 * 512 + 128 * h + kd8;
#pragma unroll
                for (int j = 0; j < 8; ++j) S[j] = el[j] * uu[j];
            }
            for (int c0 = 0; c0 < NCH; c0 += 4) {
                v4u u[4]; f32x4 er[4][2], el[4][2];
#pragma unroll
                for (int q = 0; q < 4; ++q) { const size_t e = (size_t)(b * 32 + c0 + q);
                    u[q] = *(const GAS v4u*)(UTH + (size_t)(bh * 32 + c0 + q) * UTH_ENT);
                    er[q][0] = *(const GAS f32x4*)(ER + e * 512 + 128 * h + kd8); er[q][1] = *(const GAS f32x4*)(ER + e * 512 + 128 * h + kd8 + 4);
                    el[q][0] = *(const GAS f32x4*)(EL + e * 512 + 128 * h + kd8); el[q][1] = *(const GAS f32x4*)(EL + e * 512 + 128 * h + kd8 + 4); }
#pragma unroll
                for (int q = 0; q < 4; ++q) { float uu[8], sp[8]; unpack8(u[q], uu);
#pragma unroll
                    for (int j = 0; j < 8; ++j) { sp[j] = er[q][j >> 2][j & 3] * S[j]; S[j] = el[q][j >> 2][j & 3] * (sp[j] + uu[j]); }
                    *(GAS v4u*)(UTH + (size_t)(bh * 32 + c0 + q) * UTH_ENT) = (v4u){pk2(sp[0], sp[1]), pk2(sp[2], sp[3]), pk2(sp[4], sp[5]), pk2(sp[6], sp[7])}; }
            }
            float* o = OUTP(O_HGP) + ((size_t)bh * 128 + kd8) * 128 + v;
#pragma unroll
            for (int j = 0; j < 8; ++j) o[(size_t)j * 128] = S[j];
        } else {
            const int i2 = idx - 65536, bhd = i2 >> 10, rem = i2 & 1023, p_ = rem >> 4, n8 = (rem & 15) * 8, head = bhd & 7;
            bf16* UM = WSP(bf16, WS_UM) + (size_t)p_ * 128 + n8;
            {   float uu[8]; unpack8(*(const GAS v4u*)(UM + (size_t)(2048 + head) * UM_ENT), uu);
#pragma unroll
                for (int j = 0; j < 8; ++j) S[j] = uu[j]; }
            for (int c0 = 0; c0 < NCH; c0 += 4) {
                v4u u[4]; float d[4];
#pragma unroll
                for (int q = 0; q < 4; ++q) { u[q] = *(const GAS v4u*)(UM + (size_t)(bhd * 32 + c0 + q) * UM_ENT); d[q] = DCY[bhd * 32 + c0 + q]; }
#pragma unroll
                for (int q = 0; q < 4; ++q) { float uu[8], sp[8]; unpack8(u[q], uu);
#pragma unroll
                    for (int j = 0; j < 8; ++j) { sp[j] = S[j]; S[j] = d[q] * S[j] + uu[j]; }
                    *(GAS v4u*)(UM + (size_t)(bhd * 32 + c0 + q) * UM_ENT) = (v4u){pk2(sp[0], sp[1]), pk2(sp[2], sp[3]), pk2(sp[4], sp[5]), pk2(sp[6], sp[7])}; }
            }
            float* o = OUTP(O_SSP) + ((size_t)bhd * 64 + p_) * 128 + n8;
            *(GAS f32x4*)o = (f32x4){S[0], S[1], S[2], S[3]}; *(GAS f32x4*)(o + 4) = (f32x4){S[4], S[5], S[6], S[7]};
        }
    }
}
__device__ __forceinline__ void hgrn_decode(Frame& F, int smp, int h) {
    LAS float* OS = (LAS float*)F.lds;
    LAS float* RED = (LAS float*)(F.lds + 8192);
    const int tid = F.tid, row = ROW_SMP + smp, v4 = (tid & 31) * 4, kg = tid >> 5;
    const bf16* FZ = WSP(bf16, WS_FZ); const bf16* VB = WSP(bf16, WS_VB); bf16* QZ = WSP(bf16, WS_QZ); const float* LB = WSP(float, WS_LB);
    const float* Sin = inp(F, 2) + (size_t)(smp * 4 + h) * 16384; float* Sout = OUTP(O_HGS) + (size_t)(smp * 4 + h) * 16384;
    f32x4 vv; { const unsigned long long raw = *(const GAS unsigned long long*)(VB + (size_t)row * 512 + 128 * h + v4);
        vv = (f32x4){bf2f((unsigned short)raw), bf2f((unsigned short)(raw >> 16)), bf2f((unsigned short)(raw >> 32)), bf2f((unsigned short)(raw >> 48))}; }
    f32x4 o = (f32x4){0.f, 0.f, 0.f, 0.f};
    f32x4 st[8]; float fzv[8], lbv[8], qv[8];
#pragma unroll
    for (int j = 0; j < 8; ++j) { const int kd = kg * 8 + j;
        st[j] = *(const GAS f32x4*)(Sin + (size_t)kd * 128 + v4);
        fzv[j] = bf2f(FZ[(size_t)row * 512 + 128 * h + kd]); lbv[j] = LB[128 * h + kd]; qv[j] = bf2f(QZ[(size_t)row * 1024 + 128 * h + kd]); }
#pragma unroll
    for (int j = 0; j < 8; ++j) {
        const int kd = kg * 8 + j;
        const float sg = sigm(fzv[j]), f = lbv[j] + (1.0f - lbv[j]) * sg, k = (1.0f - lbv[j]) * (1.0f - sg);
        const f32x4 sn = st[j] * f + vv * k;
        *(GAS f32x4*)(Sout + (size_t)kd * 128 + v4) = sn;
        o = o + sn * qv[j];
    }
    *(LAS f32x4*)(OS + kg * 128 + v4) = o;
    __syncthreads();
    float ov = 0.f;
    if (tid < 128) {
#pragma unroll
        for (int j = 0; j < 16; ++j) ov += OS[j * 128 + tid];
        const float sq = wave_sum(ov * ov); if (F.lane == 0) RED[F.wave] = sq;
    }
    __syncthreads();
    if (tid < 128) {
        const float rs = 1.0f / sqrtf((RED[0] + RED[1]) * (1.0f / 128.0f) + EPS);
        const float g = bf2f(WSP(bf16, WS_GB)[(size_t)row * 512 + 128 * h + tid]);
        QZ[(size_t)row * 1024 + 128 * h + tid] = (bf16)f2bf(ov * rs * g);
    }
    __syncthreads();
}
__device__ __forceinline__ void mamba_decode(Frame& F, int smp, int g) {
    LAS float* XS = (LAS float*)F.lds;
    LAS float* YS = (LAS float*)(F.lds + 2048);
    LAS float* RED = (LAS float*)(F.lds + 3072);
    const int tid = F.tid, row = ROW_SMP + smp;
    const bf16* XBC = WSP(bf16, WS_XBC); bf16* QZ = WSP(bf16, WS_QZ);
    {
        const int ch = tid, col = ch < 256 ? 256 * g + ch : ch < 384 ? 512 + 128 * g + (ch - 256) : 768 + 128 * g + (ch - 384);
        const float* cw = inp(F, 14); const float* sc = inp(F, 4) + (size_t)smp * 3 * 1024;
        const float s0 = sc[col], s1 = sc[1024 + col], s2 = sc[2048 + col], cur = bf2f(XBC[(size_t)row * 1024 + col]);
        XS[ch] = silu(inp(F, 15)[col] + cw[col] * s0 + cw[1024 + col] * s1 + cw[2048 + col] * s2 + cw[3072 + col] * cur);
        float* cs = OUTP(O_CVS) + (size_t)smp * 3 * 1024; cs[col] = s1; cs[1024 + col] = s2;
    }
    __syncthreads();
    {
        const int hd = tid >> 7, r = tid & 127, n4 = (r & 31) * 4, pg = r >> 5, head = 4 * g + hd;
        const float dt = WSP(float, WS_DT)[(size_t)row * 8 + head], dA = __expf(-dt * __expf(inp(F, 17)[head])), Dk = inp(F, 18)[head];
        const f32x4 Bv = *(const LAS f32x4*)(XS + 256 + n4), Cv = *(const LAS f32x4*)(XS + 384 + n4);
        const float* Sin = inp(F, 3) + (size_t)(smp * 8 + head) * 8192; float* Sout = OUTP(O_SSS) + (size_t)(smp * 8 + head) * 8192;
        float yv[16]; f32x4 st[16];
#pragma unroll
        for (int j = 0; j < 16; ++j) st[j] = *(const GAS f32x4*)(Sin + (size_t)(pg * 16 + j) * 128 + n4);
#pragma unroll
        for (int j = 0; j < 16; ++j) {
            const int p = pg * 16 + j; const float x = XS[hd * 64 + p];
            const f32x4 sn = st[j] * dA + Bv * (dt * x);
            *(GAS f32x4*)(Sout + (size_t)p * 128 + n4) = sn;
            yv[j] = (sn[0] * Cv[0] + sn[1] * Cv[1]) + (sn[2] * Cv[2] + sn[3] * Cv[3]);
        }
        { int rsel; const float y = rowsum16(yv, F.lane, rsel); if ((r & 1) == 0) { const int p = pg * 16 + rsel; YS[hd * 64 + p] = y + Dk * XS[hd * 64 + p]; } }
    }
    __syncthreads();
    float yz = 0.f;
    if (tid < 256) {
        yz = YS[tid] * bf2f(QZ[(size_t)row * 1024 + 512 + 256 * g + tid]);
        const float sq = wave_sum(yz * yz); if (F.lane == 0) RED[F.wave] = sq;
    }
    __syncthreads();
    if (tid < 256) {
        const float rs = 1.0f / sqrtf(((RED[0] + RED[1]) + (RED[2] + RED[3])) * (1.0f / 256.0f) + EPS);
        QZ[(size_t)row * 1024 + 512 + 256 * g + tid] = (bf16)f2bf(yz * rs * inp(F, 19)[256 * g + tid]);
    }
    __syncthreads();
}
#define PHASE_LOCAL_F(F) asm volatile("" : "+s"(F.ws), "+s"(F.out), "+v"(F.tid), "+v"(F.lane), "+s"(F.wave), "+s"(F.vcu), "+s"(F.G))
__device__ __forceinline__ void p4a_decode(Frame& F) {
    if (F.G == 256) {
        const int v = F.vcu;
        if (v >= 4) { hgrn_decode(F, v >> 2, v & 3); hgrn_decode(F, (v + 256) >> 2, (v + 256) & 3); }
        if (v >= 8 && v < 16) { const int j = v < 12 ? v - 8 : 256 + (v - 12); hgrn_decode(F, j >> 2, j & 3); }
        if (v != 4 && v != 5) mamba_decode(F, v >> 1, v & 1);
        if (v == 6 || v == 7) mamba_decode(F, (v - 2) >> 1, (v - 2) & 1);
    } else {
        for (int j = F.vcu; j < 512; j += F.G) hgrn_decode(F, j >> 2, j & 3);
        for (int j = F.vcu; j < 256; j += F.G) mamba_decode(F, j >> 1, j & 1);
    }
}
__device__ __forceinline__ void p4a_hg(Frame& F) {
    HgRaw raw; int i = F.vcu; if (i < 1028) { const HgP p0 = hg_params(i); hg_load<1>(F, p0, raw); }
    for (; i < 1028; i += F.G) { const int in = i + F.G; hgrn_item<1>(F, hg_params(i), raw, in < 1028, hg_params(in < 1028 ? in : i)); }
}
__device__ __forceinline__ void p4a_mb(Frame& F) {
    MbRaw raw; int j = F.vcu; if (mb_valid(j, true)) { const MbP p0 = mb_params(F, j); mb_load<1>(F, p0, raw); }
    for (; mb_valid(j, true); j += F.G) { const int jn = j + F.G; const bool hn = mb_valid(jn, true); mamba_item<1>(F, mb_params(F, j), raw, hn, mb_params(F, hn ? jn : j)); }
}
__device__ __forceinline__ void p4a_pass1(Frame& F) {
    if ((F.vcu >> 3) & 1) { p4a_mb(F); __syncthreads(); PHASE_LOCAL_F(F); p4a_hg(F); }
    else { p4a_hg(F); __syncthreads(); PHASE_LOCAL_F(F); p4a_mb(F); }
}
__device__ __forceinline__ void p4a(Frame& F, bool decode) {
    if (decode) p4a_decode(F);
    p4a_pass1(F);
}
__device__ __forceinline__ void p4c_hg(Frame& F) {
    HgRaw raw; int i = F.vcu; if (i < 1024) { const HgP p0 = hg_params(i); hg_load<3>(F, p0, raw); }
    for (; i < 1024; i += F.G) { const int in = i + F.G; hgrn_item<3>(F, hg_params(i), raw, in < 1024, hg_params(in < 1024 ? in : i)); }
}
__device__ __forceinline__ void p4c_mb(Frame& F) {
    MbRaw raw; int j = F.vcu; if (j < 512) { const MbP p0 = mb_params(F, j); mb_load<3>(F, p0, raw); }
    for (; j < 512; j += F.G) { const int jn = j + F.G; mamba_item<3>(F, mb_params(F, j), raw, jn < 512, mb_params(F, jn < 512 ? jn : j)); }
}
__device__ __forceinline__ void p4c(Frame& F) {
    if ((F.vcu >> 3) & 1) { p4c_mb(F); __syncthreads(); PHASE_LOCAL_F(F); p4c_hg(F); }
    else { p4c_hg(F); __syncthreads(); PHASE_LOCAL_F(F); p4c_mb(F); }
}
#ifndef MK_PER_PHASE
#define MK_PER_PHASE 0
#endif
#ifndef GP_ALIGN
#define GP_ALIGN true
#endif
#ifndef GP_SP2
#define GP_SP2 true
#endif
#ifndef GP_SP2_FINAL
#define GP_SP2_FINAL false
#endif
#ifndef WGM_GU
#define WGM_GU 4
#endif
#ifndef WGM_IN
#define WGM_IN 4
#endif
#ifndef WGM_DN
#define WGM_DN 4
#endif
constexpr int N_PHASES = 13;
struct Args { const float* in[26]; float* out; unsigned char* ws; int ph_lo, ph_hi; };
static_assert(sizeof(Args) == 26 * 8 + 8 + 8 + 8, "Args has no padding");
template <bool SPLIT> __global__ void __launch_bounds__(NWAVES * 64, 2) hymba_fwd(Args args) {
    extern __shared__ __attribute__((aligned(16))) unsigned char lds[];
    Frame F;
    F.lds = (LAS unsigned char*)lds;
    F.MISC = (volatile LAS unsigned*)(F.lds + MISC_OFF);
    F.tid = threadIdx.x; F.lane = F.tid & 63; F.wave = __builtin_amdgcn_readfirstlane(F.tid >> 6);
    F.G = gridDim.x; { const int bx = blockIdx.x; F.vcu = (F.G % 8 == 0) ? (bx % 8) * (F.G / 8) + bx / 8 : bx; }
    F.ws = (GAS unsigned char*)args.ws; F.out = (GAS float*)args.out; F.ctl = (gu32*)(args.ws + WS_CTL);
    for (int u = F.tid; u < (LDS_BYTES - LDSCTL_OFF) / 4; u += NWAVES * 64) ((LAS unsigned*)(F.lds + LDSCTL_OFF))[u] = 0u;
    __syncthreads();
    if (F.tid < 26) ((LAS unsigned long long*)(F.lds + TAB_OFF))[F.tid] = (unsigned long long)args.in[F.tid];
    __syncthreads();
#if SELF_CLEAN
    unsigned* const barw = g_xbar;
#else
    unsigned* const barw = (unsigned*)(F.ctl + CW_BAR);
#endif
    XcdBarrier bar; bar.bar = barw; bar.x = 0; bar.st = nullptr;
    if (!MK_PER_PHASE) bar = xcd_barrier_post(barw, F.MISC + 8);
    const int lo = args.ph_lo, hi = args.ph_hi;
#ifndef PH_MASK
#define PH_MASK 0x1fff
#endif
#define IN(k) (((PH_MASK >> (k)) & 1) && lo <= (k) && (k) < hi)
#ifndef PH_REPEAT
#define PH_REPEAT 0
#endif
#define SEAM(k) do { if (IN(k) && IN((k) + 1)) xcd_barrier(bar); } while (0)
#define PHASE_LOCAL() asm volatile("" : "+s"(F.ws), "+s"(F.out), "+v"(F.tid), "+v"(F.lane), "+s"(F.wave), "+s"(F.vcu), "+s"(F.G))
#define REP(k) for (int rep_ = 0; rep_ < 1 + ((PH_REPEAT >> (k)) & 1); ++rep_)
#ifndef SKEW_TICKS
#define SKEW_TICKS 1200
#endif
#define HB WSP(bf16, WS_HB)
#define HH WSP(bf16, WS_H)
#define QZ WSP(bf16, WS_QZ)
#define SS1 WSP(float, WS_SS1)
#define SS2 WSP(float, WS_SS2)
#define SS3 WSP(float, WS_SS3)
#define SS4 WSP(float, WS_SS4)
#define RS2 (WSP(float, WS_SS1) + 32768)
#define RS3 (WSP(float, WS_SS1) + 65536)
#define YP (OUTP(O_YP))
#define HX0 WSP(float, WS_HX0)
#define HX WSP(float, WS_HX)

    constexpr int split = SPLIT ? 1 : 0;
#define SLABS WSP(float, WS_XBC)
    if (IN(0)) REP(0) { if (rep_ == 1) xcd_barrier(bar); PHASE_LOCAL(); p0_prologue(F, split); } SEAM(0);
    if (IN(1)) REP(1) { if (rep_ == 1) xcd_barrier(bar); PHASE_LOCAL();
        pg8::Gemm g{HB, WSP(bf16, WS_WGU1), M, 2 * FF, D, D}; pg8::MixOrder S; S.init(65, 2 * FF, D, F.G, (int)blockIdx.x, 0, WGM_GU);
        pg8::EpiSwiglu E{HH, SS1, LDH, FF / 64};
        if constexpr (SPLIT && SELF_CLEAN && !MK_PER_PHASE) {
            S.sp_lo = 152;
            const int idle0 = 1430 - 5 * 256;
            if ((int)blockIdx.x >= idle0) { const int iw = ((int)blockIdx.x - idle0) * NWAVES + F.wave, nw_ = (256 - idle0) * NWAVES;
                p0_weight_items(F, 2 * P0_I_GU, 3 * P0_I_GU, iw, nw_);
                asm volatile("s_waitcnt vmcnt(0)" ::: "memory"); __syncthreads();
                if (F.tid == 0) { __builtin_amdgcn_fence(__ATOMIC_RELEASE, "agent"); asm volatile("s_waitcnt vmcnt(0)" ::: "memory"); (void)xb_add(&barw[XB_WD1], 1u); }
                __syncthreads(); }
            pg8::gemm_phase<pg8::EpiSwiglu, pg8::MixOrder, GP_ALIGN, GP_SP2>(F.lds, g, S, E, nullptr, &barw[XB_T64A], 64);
            const int piece = (int)blockIdx.x - idle0;
            if (piece >= 0 && piece < 4 * (FF / 128)) {
                if (F.tid == 0) { XB_SPIN(xb_ld(&barw[XB_T64A]) < (unsigned)(2 * FF / 256) || xb_ld(&barw[XB_WD1]) < (unsigned)(256 - idle0), barw);
                    __builtin_amdgcn_fence(__ATOMIC_ACQUIRE, "agent"); asm volatile("s_waitcnt vmcnt(0)" ::: "memory"); }
                __syncthreads();
                pg8::Gemm g2{HH, WSP(bf16, WS_WD1), M, D, FF, LDH}; pg8::SliceOrder S2{64, FF / 128, piece};
                pg8::EpiResid E2{HB, nullptr, HX0, HX, HB, SS2, 0.5f, nullptr};
                pg8::gemm_phase<pg8::EpiResid, pg8::SliceOrder, GP_ALIGN, GP_SP2>(F.lds, g2, S2, E2, SLABS);
            }
            if ((int)blockIdx.x >= idle0) {
                __syncthreads();
                constexpr int W_ALL = 2 * (256 - (1430 - 5 * 256)) * NWAVES;
                p0_weight_items(F, 6 * P0_I_GU, 6 * P0_I_GU + W_ALL, ((int)blockIdx.x - idle0) * NWAVES + F.wave, (256 - idle0) * NWAVES);
                const int ns0 = idle0 + 4 * (FF / 128);
                if ((int)blockIdx.x >= ns0) p0_weight_items(F, 6 * P0_I_GU + W_ALL, 6 * P0_I_GU + P0_I_IN, ((int)blockIdx.x - ns0) * NWAVES + F.wave, (256 - ns0) * NWAVES);
            }
        } else {
        if (split && rep_ == 0) {
            const int idle0 = 1430 - 5 * 256;
            if ((int)blockIdx.x >= idle0) { const int iw = ((int)blockIdx.x - idle0) * NWAVES + F.wave, nw_ = (256 - idle0) * NWAVES;
                p0_weight_items(F, 2 * P0_I_GU, 3 * P0_I_GU, iw, nw_);
                p0_weight_items(F, 6 * P0_I_GU, 6 * P0_I_GU + P0_I_IN, iw, nw_); __syncthreads(); }
        }
        pg8::gemm_phase<pg8::EpiSwiglu, pg8::MixOrder, GP_ALIGN, GP_SP2>(F.lds, g, S, E, nullptr);
        }
    } SEAM(1);
    if (IN(2)) REP(2) { if (rep_ == 1) xcd_barrier(bar); PHASE_LOCAL();
        constexpr bool HANDOFF = SPLIT && SELF_CLEAN && !MK_PER_PHASE;
        pg8::Gemm g{HH, WSP(bf16, WS_WD1), M, D, FF, LDH}; pg8::MixOrder S; S.init(split ? 64 : 65, D, FF, F.G, (int)blockIdx.x, HANDOFF ? 0 : split, WGM_DN);
        pg8::EpiResid E{HB, nullptr, HX0, HX, HB, SS2, 0.5f, nullptr};
        pg8::gemm_phase<pg8::EpiResid, pg8::MixOrder, GP_ALIGN, GP_SP2>(F.lds, g, S, E, SLABS);
        if (!HANDOFF && split && rep_ == 0 && (int)blockIdx.x >= 4 * (FF / 128)) {
            __syncthreads(); const int iw = ((int)blockIdx.x - 4 * (FF / 128)) * NWAVES + F.wave, nw_ = (256 - 4 * (FF / 128)) * NWAVES;
            p0_weight_items(F, 6 * P0_I_GU + P0_I_IN, P0_NITEMS, iw, nw_);
            p0_weight_items(F, 3 * P0_I_GU, 3 * P0_I_GU + P0_I_GU / 2, iw, nw_); }
    } SEAM(2);
    if (IN(3)) REP(3) { if (rep_ == 1) xcd_barrier(bar); PHASE_LOCAL(); fix_extra<FF / 128>(F, split, SLABS, HX0, HX, HB, SS2, RS2, 0.5f);
    } SEAM(3);
    if (IN(4)) REP(4) { if (rep_ == 1) xcd_barrier(bar); PHASE_LOCAL();
        pg8::Gemm g{HB, WSP(bf16, WS_WIN), M, NINP, D, D}; pg8::MixOrder S; S.init(65, NINP, D, F.G, (int)blockIdx.x, 0, WGM_IN);
        pg8::EpiInproj E{RS2, QZ, WSP(bf16, WS_FZ), WSP(bf16, WS_VB), WSP(bf16, WS_GB), WSP(bf16, WS_XBC), WSP(float, WS_DT), inp(F, 13), inp(F, 16), OUTP(O_CVP), WSP(float, WS_CVS)};
        if (split && rep_ == 0) {
            const int idle0 = 975 - 3 * 256;
            if ((int)blockIdx.x >= idle0) { const int iw = ((int)blockIdx.x - idle0) * NWAVES + F.wave, nw_ = (256 - idle0) * NWAVES;
                if constexpr (SPLIT && SELF_CLEAN && !MK_PER_PHASE) { p0_weight_items(F, 6 * P0_I_GU + P0_I_IN, P0_NITEMS, iw, nw_); p0_weight_items(F, 3 * P0_I_GU, 3 * P0_I_GU + P0_I_GU / 2, iw, nw_); }
                p0_weight_items(F, 3 * P0_I_GU + P0_I_GU / 2, 4 * P0_I_GU, iw, nw_); __syncthreads(); }
        }
        pg8::gemm_phase<pg8::EpiInproj, pg8::MixOrder, GP_ALIGN, GP_SP2>(F.lds, g, S, E, nullptr);
    } SEAM(4);
    if (IN(5)) REP(5) { if (rep_ == 1) xcd_barrier(bar); PHASE_LOCAL();
        for (int r = F.vcu; r < NSMP; r += F.G) if (F.tid < 256)
            *(GAS f32x4*)(OUTP(O_CVS) + ((size_t)r * 3 + 2) * 1024 + 4 * F.tid) = *(const GAS f32x4*)(WSP(float, WS_CVS) + (size_t)r * pg8::CVS_PITCH + 4 * F.tid);
        p4a(F, rep_ == 0); } SEAM(5);
    if (IN(6)) REP(6) { if (rep_ == 1) xcd_barrier(bar); PHASE_LOCAL(); p4b_scan(F); } SEAM(6);
    if (IN(7)) REP(7) { if (rep_ == 1) xcd_barrier(bar); PHASE_LOCAL(); p4c(F); } SEAM(7);
    if (IN(8)) REP(8) { if (rep_ == 1) xcd_barrier(bar); PHASE_LOCAL();
        pg8::Gemm g{QZ, WSP(bf16, WS_WOUT), M, D, D, D}; pg8::MixOrder S; S.init(split ? 64 : 65, D, D, F.G, (int)blockIdx.x, split, WGM_DN);
        pg8::EpiResid E{HB, nullptr, HX, HX, HB, SS3, 1.0f, nullptr};
        pg8::gemm_phase<pg8::EpiResid, pg8::MixOrder, GP_ALIGN, GP_SP2>(F.lds, g, S, E, SLABS);
        if (split && rep_ == 0 && (int)blockIdx.x >= 4 * (D / 128)) {
            __syncthreads(); const int iw = ((int)blockIdx.x - 4 * (D / 128)) * NWAVES + F.wave, nw_ = (256 - 4 * (D / 128)) * NWAVES;
            p0_weight_items(F, 4 * P0_I_GU, 5 * P0_I_GU, iw, nw_); }
    } SEAM(8);
    if (IN(9)) REP(9) { if (rep_ == 1) xcd_barrier(bar); PHASE_LOCAL(); fix_extra<D / 128>(F, split, SLABS, HX, HX, HB, SS3, RS3, 1.0f);
        if (split) { GAS v4u* z = (GAS v4u*)(F.ws + WS_UM); for (int i = F.vcu * (NWAVES * 64) + F.tid; i < 131072; i += F.G * NWAVES * 64) z[i] = (v4u){0u, 0u, 0u, 0u}; } }
    SEAM(9);
    if (IN(10)) REP(10) { if (rep_ == 1) xcd_barrier(bar); PHASE_LOCAL();
        pg8::Gemm g{HB, WSP(bf16, WS_WGU2), M, 2 * FF, D, D}; pg8::MixOrder S; S.init(65, 2 * FF, D, F.G, (int)blockIdx.x, 0, WGM_GU);
        pg8::EpiSwiglu E{HH, RS3, LDH, FF / 64};
        if constexpr (SPLIT && SELF_CLEAN && !MK_PER_PHASE) {
            S.sp_lo = 152;
            const int idle0 = 1430 - 5 * 256;
            if ((int)blockIdx.x >= idle0) { const int iw = ((int)blockIdx.x - idle0) * NWAVES + F.wave, nw_ = (256 - idle0) * NWAVES;
                p0_weight_items(F, 5 * P0_I_GU, 6 * P0_I_GU, iw, nw_);
                asm volatile("s_waitcnt vmcnt(0)" ::: "memory"); __syncthreads();
                if (F.tid == 0) { __builtin_amdgcn_fence(__ATOMIC_RELEASE, "agent"); asm volatile("s_waitcnt vmcnt(0)" ::: "memory"); (void)xb_add(&barw[XB_WD2], 1u); } }
            pg8::gemm_phase<pg8::EpiSwiglu, pg8::MixOrder, GP_ALIGN, GP_SP2>(F.lds, g, S, E, nullptr, &barw[XB_T64], 64);
            const int piece = (int)blockIdx.x - idle0;
            if (piece >= 0 && piece < 4 * (FF / 128)) {
                if (F.tid == 0) { XB_SPIN(xb_ld(&barw[XB_T64]) < (unsigned)(2 * FF / 256) || xb_ld(&barw[XB_WD2]) < (unsigned)(256 - idle0), barw);
                    __builtin_amdgcn_fence(__ATOMIC_ACQUIRE, "agent"); asm volatile("s_waitcnt vmcnt(0)" ::: "memory"); }
                __syncthreads();
                pg8::Gemm g2{HH, WSP(bf16, WS_WD2), M, D, FF, LDH}; pg8::SliceOrder S2{64, FF / 128, piece};
                pg8::EpiResid E2{HB, nullptr, HX, HX, HB, SS4, 0.5f, nullptr};
                pg8::gemm_phase<pg8::EpiResid, pg8::SliceOrder, GP_ALIGN, GP_SP2>(F.lds, g2, S2, E2, SLABS);
            }
        } else {
        if (split && rep_ == 0 && (int)blockIdx.x >= 1430 - 5 * 256) {
            const int idle0 = 1430 - 5 * 256; const int iw = ((int)blockIdx.x - idle0) * NWAVES + F.wave, nw_ = (256 - idle0) * NWAVES;
            p0_weight_items(F, 5 * P0_I_GU, 6 * P0_I_GU, iw, nw_); __syncthreads(); }
        pg8::gemm_phase<pg8::EpiSwiglu, pg8::MixOrder, GP_ALIGN, GP_SP2>(F.lds, g, S, E, nullptr);
        }
    } SEAM(10);
    if (IN(11)) REP(11) { if (rep_ == 1) xcd_barrier(bar); PHASE_LOCAL();
        pg8::Gemm g{HH, WSP(bf16, WS_WD2), M, D, FF, LDH}; pg8::MixOrder S; S.init(split ? 64 : 65, D, FF, F.G, (int)blockIdx.x, (SPLIT && SELF_CLEAN && !MK_PER_PHASE) ? 0 : split, WGM_DN);
        if constexpr (SPLIT) {
            pg8::EpiResid E{HB, nullptr, HX, HX, HB, SS4, 0.5f, (unsigned long long*)(F.ws + WS_UM)};
            pg8::gemm_phase<pg8::EpiResid, pg8::MixOrder, GP_ALIGN, GP_SP2>(F.lds, g, S, E, SLABS);
            if constexpr (SELF_CLEAN && !MK_PER_PHASE) {
                PHASE_LOCAL(); p8_final<FF / 128>(F, split, SLABS); PHASE_LOCAL(); }
            pg8::Unit u; S.next(0, u);
            VM_WAIT(); __syncthreads();
            unsigned long long* gp = (unsigned long long*)(F.ws + WS_UM) + (size_t)u.pm * 256 * 16;
            const bf16* hb = HB + (size_t)u.pm * 256 * 1024 + u.pn * 256 + 4 * F.lane;
            float* yb = YP + (size_t)u.pm * 256 * 1024 + u.pn * 256 + 4 * F.lane;
            const f32x4 w = *(const GAS f32x4*)(inp(F, 25) + u.pn * 256 + 4 * F.lane);
            float tot[8];
            { unsigned long long x[8]; unsigned spins = 0;
              for (;;) { bool ok = true;
#pragma unroll
                  for (int j = 0; j < 8; ++j) { x[j] = __hip_atomic_load(gp + (size_t)F.wave * 512 + F.lane + 64 * j, __ATOMIC_RELAXED, __HIP_MEMORY_SCOPE_AGENT); ok = ok && ((unsigned)(x[j] >> 32) == 1u); }
                  if (__all(ok) || ++spins > (1u << 18)) break; __builtin_amdgcn_s_sleep(4); }
#pragma unroll
              for (int j = 0; j < 8; ++j) { float v = __builtin_bit_cast(float, (unsigned)x[j]); v += __shfl_xor(v, 1); v += __shfl_xor(v, 2); v += __shfl_xor(v, 4); v += __shfl_xor(v, 8); tot[j] = v; } }
            unsigned long long o[32];
#pragma unroll
            for (int i = 0; i < 32; ++i) o[i] = *(const GAS unsigned long long*)(hb + (size_t)(F.wave * 32 + i) * 1024);
#pragma unroll
            for (int r = 0; r < 32; ++r) { const float rs = __builtin_amdgcn_rsqf(__builtin_bit_cast(float, __builtin_amdgcn_readlane(__builtin_bit_cast(int, tot[r >> 2]), (r & 3) * 16)) * (1.0f / 1024.0f) + EPS);
                const unsigned lo = (unsigned)o[r], hi = (unsigned)(o[r] >> 32);
                const f32x4 v = (f32x4){__builtin_bit_cast(float, lo << 16), __builtin_bit_cast(float, lo & 0xffff0000u), __builtin_bit_cast(float, hi << 16), __builtin_bit_cast(float, hi & 0xffff0000u)};
                *(GAS f32x4*)(yb + (size_t)(F.wave * 32 + r) * 1024) = v * rs * w; }
        } else {
            pg8::EpiResid E{HB, YP, HX, HX, nullptr, SS4, 0.5f, nullptr};
            pg8::gemm_phase<pg8::EpiResid, pg8::MixOrder, GP_ALIGN, GP_SP2>(F.lds, g, S, E, SLABS);
        }
    }
    if constexpr (!(SPLIT && SELF_CLEAN && !MK_PER_PHASE)) {
    SEAM(11);
    if (IN(12)) REP(12) { if (rep_ == 1) xcd_barrier(bar); PHASE_LOCAL(); p8_final<FF / 128>(F, split, SLABS); }
    }
#if SELF_CLEAN
    if (!MK_PER_PHASE) { __syncthreads();
        if (F.tid < 64) { unsigned last = 0u;
            if (F.tid == 0) last = (xb_add(&barw[XB_EXIT], 1u) + 1u == (unsigned)F.G) ? 1u : 0u;
            last = (unsigned)__builtin_amdgcn_readfirstlane((int)last);
            if (last) { const int l = F.tid;
                const int w = l < 16 ? XB_XCNT(l) : l < 32 ? XB_XSUB(l - 16) : l < 48 ? XB_XGEN(l - 32) : l == 48 ? XB_TOP : l == 49 ? XB_TOPGEN : l == 50 ? XB_TMO : l == 51 ? XB_EXIT : l == 52 ? XB_T64 : l == 53 ? XB_WD2 : l == 54 ? XB_T64A : XB_WD1;
                if (l < 56) __hip_atomic_store(&barw[w], 0u, __ATOMIC_RELAXED, __HIP_MEMORY_SCOPE_AGENT); } } }
#endif
#undef SLABS
#undef IN
#undef SEAM
#undef HB
#undef HH
#undef QZ
#undef SS1
#undef SS2
#undef SS3
#undef SS4
#undef RS2
#undef RS3
#undef YP
#undef HX0
#undef HX
}

extern "C" void kernel_launch(void* const* d_in, const int* in_sizes, int n_in, void* d_out, int out_size, void* d_ws, size_t ws_size, hipStream_t stream) {
    static int grid = 0;
    if (grid == 0) {
        if (n_in != 26 || in_sizes[0] != MP * D || (size_t)out_size != O_END || ws_size < WS_END) {
            fprintf(stderr, "kernel_launch: unexpected shapes: n_in %d in0 %d out %d ws %zu; nothing launched\n", n_in, n_in > 0 ? in_sizes[0] : -1, out_size, ws_size); grid = -1; return; }
        int dev = 0, cus = 0, per_cu = 0;
        if (hipGetDevice(&dev) != hipSuccess || hipDeviceGetAttribute(&cus, hipDeviceAttributeMultiprocessorCount, dev) != hipSuccess) { fprintf(stderr, "kernel_launch: device query failed\n"); grid = -1; return; }
        if (hipFuncSetAttribute((const void*)hymba_fwd<true>, hipFuncAttributeMaxDynamicSharedMemorySize, LDS_BYTES) != hipSuccess || hipFuncSetAttribute((const void*)hymba_fwd<false>, hipFuncAttributeMaxDynamicSharedMemorySize, LDS_BYTES) != hipSuccess) { fprintf(stderr, "kernel_launch: hipFuncSetAttribute failed\n"); grid = -1; return; }
        if (hipOccupancyMaxActiveBlocksPerMultiprocessor(&per_cu, cus == 256 ? (const void*)hymba_fwd<true> : (const void*)hymba_fwd<false>, NWAVES * 64, LDS_BYTES) != hipSuccess || per_cu < 1)
            fprintf(stderr, "kernel_launch: note: occupancy query reports %d workgroups per CU\n", per_cu);
        (void)hipGetLastError();
        grid = cus;
    }
    if (grid < 0) return;
#if !SELF_CLEAN || MK_PER_PHASE
    if (hipMemsetAsync((char*)d_ws + WS_CTL, 0, CTL_ZERO_BYTES, stream) != hipSuccess) { fprintf(stderr, "kernel_launch: memset failed\n"); return; }
#endif
    Args a{};
    for (int i = 0; i < 26; ++i) a.in[i] = (const float*)d_in[i];
    a.out = (float*)d_out; a.ws = (unsigned char*)d_ws;
#if MK_PER_PHASE
    for (int p = 0; p < N_PHASES; ++p) { a.ph_lo = p; a.ph_hi = p + 1; if (grid == 256) hipLaunchKernelGGL(hymba_fwd<true>, dim3(grid), dim3(NWAVES * 64), LDS_BYTES, stream, a); else hipLaunchKernelGGL(hymba_fwd<false>, dim3(grid), dim3(NWAVES * 64), LDS_BYTES, stream, a); }
#else
    a.ph_lo = 0; a.ph_hi = N_PHASES;
    if (grid == 256) hipLaunchKernelGGL(hymba_fwd<true>, dim3(grid), dim3(NWAVES * 64), LDS_BYTES, stream, a);
    else hipLaunchKernelGGL(hymba_fwd<false>, dim3(grid), dim3(NWAVES * 64), LDS_BYTES, stream, a);
#endif
    const hipError_t le = hipPeekAtLastError();
    if (le != hipSuccess) fprintf(stderr, "kernel_launch: launch failed: %s\n", hipGetErrorName(le));
}
```
